# Optimizing an MI355X kernel written in HIP

```python
import math
import jax, jax.numpy as jnp
from jax import lax
import numpy as np

D_MODEL = 2048
BATCH = 2
SEQ = 16384
DEPTH = 2

N_MIXERS = 4
GROUP_W = D_MODEL // N_MIXERS
MIX_W = N_MIXERS * GROUP_W
CHUNK = 64
Q_BLOCK = 128
HG_DK = 128
HG_HEADS = GROUP_W // HG_DK
HG_DV = GROUP_W // HG_HEADS
NSA_HEAD_DIM = 64
NSA_HEADS = GROUP_W // NSA_HEAD_DIM
NSA_KV = 2
NSA_GROUP = NSA_HEADS // NSA_KV
NSA_CMP_BLOCK = 32
NSA_CMP_STRIDE = 16
NSA_SLC_BLOCK = 64
NSA_TOP_N = 16
NSA_WINDOW = 512
NSA_KVW = NSA_KV * NSA_HEAD_DIM
NSA_CMP_HIDDEN = 256
SSM_HEAD_DIM = 64
SSM_HEADS = GROUP_W // SSM_HEAD_DIM
SSM_GROUPS = 2
SSM_STATE = 128
SSM_CONV = 4
SSM_CONV_DIM = GROUP_W + 2 * SSM_GROUPS * SSM_STATE
RET_HEADS = 4
RET_DK = GROUP_W // RET_HEADS
REL_BUCKETS = 32
REL_EXACT = REL_BUCKETS // 2
REL_MAX_DIST = 2048
D_FF = 5632
DEEPNORM_ALPHA = (2 * DEPTH) ** 0.25
DEEPNORM_BETA = (8 * DEPTH) ** -0.25

IN_SIZES = ((GROUP_W,) * 4
            + (GROUP_W,) + (NSA_KVW,) * 6 + (3 * NSA_HEADS,)
            + (GROUP_W, SSM_CONV_DIM, SSM_HEADS)
            + (GROUP_W,) * 4)
D_IN = sum(IN_SIZES)
IN_SPLITS = tuple(int(v) for v in np.cumsum(IN_SIZES)[:-1])

kernel_name = 'hybrid_parallel_groups_hgrn2_nsa_ssd_retention'


def layer_norm(x, g, b, eps=1e-5):
    xf = x.astype(jnp.float32)
    mu = jnp.mean(xf, axis=-1, keepdims=True)
    var = jnp.mean(jnp.square(xf - mu), axis=-1, keepdims=True)
    return ((xf - mu) * lax.rsqrt(var + eps) * g + b).astype(x.dtype)


def rms_normalize(x, eps=1e-6):
    xf = x.astype(jnp.float32)
    return xf * lax.rsqrt(jnp.mean(jnp.square(xf), axis=-1, keepdims=True) + eps)


def swiglu(h, w1, w3, w2):
    return (jax.nn.silu(h @ w1) * (h @ w3)) @ w2


def t5_bucket(dist):
    n = jnp.maximum(dist, 0)
    nf = jnp.maximum(n, 1).astype(jnp.float32)
    large = REL_EXACT + (jnp.log(nf / REL_EXACT) / math.log(REL_MAX_DIST / REL_EXACT)
                         * (REL_BUCKETS - REL_EXACT)).astype(jnp.int32)
    return jnp.where(n < REL_EXACT, n, jnp.minimum(large, REL_BUCKETS - 1))


def masked_softmax(s, mask):
    p = jax.nn.softmax(jnp.where(mask, s.astype(jnp.float32), -1e30), axis=-1)
    return jnp.where(mask, p, 0.0)


def causal_depthwise_conv(x, w, b):
    out = lax.conv_general_dilated(x, w[:, None, :], window_strides=(1,),
                                   padding=[(SSM_CONV - 1, 0)],
                                   dimension_numbers=('NWC', 'WIO', 'NWC'),
                                   feature_group_count=x.shape[-1])
    return out + b


def rotary(t, pos):
    half = t.shape[-1] // 2
    theta = 1.0 / (10000.0 ** jnp.linspace(0.0, 1.0, half, dtype=jnp.float32))
    ang = pos[:, None] * theta[None, :]
    cos, sin = jnp.cos(ang)[None, :, None, :], jnp.sin(ang)[None, :, None, :]
    t1, t2 = t[..., 0::2], t[..., 1::2]
    return jnp.stack([t1 * cos - t2 * sin, t1 * sin + t2 * cos], axis=-1).reshape(t.shape)


def chunked_scalar_decay(q, k, v, log_a):
    B_, S_, H, dk = q.shape
    dv = v.shape[-1]
    nc = S_ // CHUNK
    qc = q.reshape(B_, nc, CHUNK, H, dk)
    kc = k.reshape(B_, nc, CHUNK, H, dk)
    vc = v.reshape(B_, nc, CHUNK, H, dv)
    b = jnp.cumsum(log_a.reshape(B_, nc, CHUNK, H), axis=2)
    bh = b.transpose(0, 1, 3, 2)
    causal = jnp.tril(jnp.ones((CHUNK, CHUNK), bool))
    decay = jnp.exp(jnp.where(causal, bh[..., :, None] - bh[..., None, :], -jnp.inf))
    scores = jnp.einsum('bcihk,bcjhk->bchij', qc, kc) * decay
    y_intra = jnp.einsum('bchij,bcjhv->bcihv', scores, vc)
    b_last = b[:, :, -1]
    chunk_state = jnp.einsum('bcjhk,bcjh,bcjhv->bchkv', kc, jnp.exp(b_last[:, :, None, :] - b), vc)

    def step(state, inp):
        a, r = inp
        return a[..., None, None] * state + r, state

    _, s_prev = lax.scan(step, jnp.zeros((B_, H, dk, dv), jnp.float32),
                         (jnp.exp(b_last).transpose(1, 0, 2), chunk_state.transpose(1, 0, 2, 3, 4)))
    s_prev = s_prev.transpose(1, 0, 2, 3, 4)
    y_inter = jnp.einsum('bcihk,bchkv->bcihv', qc * jnp.exp(b)[..., None], s_prev)
    return (y_intra + y_inter).reshape(B_, S_, H, dv)


def hgrn2_chunked(q, k, v, log_f):
    B_, S_, H, dk = q.shape
    dv = v.shape[-1]
    nc = S_ // CHUNK

    def chunks(t):
        return t.reshape(B_, nc, CHUNK, H, t.shape[-1]).transpose(1, 0, 3, 2, 4)

    qc, kc, vc = chunks(q), chunks(k), chunks(v)
    bc = jnp.cumsum(chunks(log_f), axis=3)
    causal = jnp.tril(jnp.ones((CHUNK, CHUNK), bool))[:, :, None]

    def step(state, inp):
        qi, ki, vi, bi = inp
        dec = jnp.exp(jnp.where(causal, bi[:, :, :, None, :] - bi[:, :, None, :, :], -jnp.inf))
        a = jnp.einsum('bhid,bhjd,bhijd->bhij', qi, ki, dec)
        o = (jnp.einsum('bhij,bhjv->bhiv', a, vi)
             + jnp.einsum('bhid,bhdv->bhiv', qi * jnp.exp(bi), state))
        b_last = bi[:, :, -1:, :]
        state = (jnp.exp(b_last[:, :, 0, :])[..., None] * state
                 + jnp.einsum('bhjd,bhjv->bhdv', ki * jnp.exp(b_last - bi), vi))
        return state, o

    _, o = lax.scan(step, jnp.zeros((B_, H, dk, dv), jnp.float32), (qc, kc, vc, bc))
    return o.transpose(1, 0, 3, 2, 4).reshape(B_, S_, H, dv)


def hgrn2_mixer(q, f_logit, i_in, g, lb, norm_g):
    B_, S_, _ = q.shape
    f32 = jnp.float32
    q = jax.nn.silu(q.astype(f32)).reshape(B_, S_, HG_HEADS, HG_DK)
    z = f_logit.astype(f32).reshape(B_, S_, HG_HEADS, HG_DK)
    lb = lb.astype(f32).reshape(HG_HEADS, HG_DK)
    log_f = jnp.logaddexp(jnp.log(lb), jnp.log1p(-lb) + jax.nn.log_sigmoid(z))
    k = (1.0 - lb) * jax.nn.sigmoid(-z)
    v = i_in.astype(f32).reshape(B_, S_, HG_HEADS, HG_DV)
    o = rms_normalize(hgrn2_chunked(q, k, v, log_f)).reshape(B_, S_, GROUP_W) * norm_g
    return o * jax.nn.silu(g.astype(f32))


def compress_kv(t, pe, w1, w2):
    B_, S_ = t.shape[:2]
    blk = t.reshape(B_, S_ // NSA_CMP_STRIDE, NSA_CMP_STRIDE, NSA_KV, NSA_HEAD_DIM)
    blk = jnp.concatenate([blk[:, :-1], blk[:, 1:]], axis=2) + pe[None, None, :, None, :]
    flat = blk.transpose(0, 1, 3, 2, 4).reshape(B_, blk.shape[1], NSA_KV, NSA_CMP_BLOCK * NSA_HEAD_DIM)
    return jax.nn.silu(flat @ w1) @ w2


def cmp_to_slc(p, n_slc):
    r = NSA_SLC_BLOCK // NSA_CMP_STRIDE
    pad_r = r * n_slc + r - (p.shape[-1] + 1)
    pp = jnp.pad(p, [(0, 0)] * (p.ndim - 1) + [(1, pad_r)])
    lead = p.shape[:-1]
    a = pp[..., : r * n_slc].reshape(*lead, n_slc, r)
    e = pp[..., r: r * n_slc + r].reshape(*lead, n_slc, r)[..., 0]
    return 0.5 * a[..., 0] + a[..., 1:].sum(-1) + 0.5 * e


def nsa_mixer(q, k_c, v_c, k_s, v_s, k_w, v_w, gate, pe_k, w1_k, w2_k, pe_v, w1_v, w2_v,
              rel_bias, norm_g):
    B_, S_, _ = q.shape
    f32 = jnp.float32

    def kvh(t):
        return t.astype(f32).reshape(B_, S_, NSA_KV, NSA_HEAD_DIM)

    k_c, v_c, k_s, v_s, k_w, v_w = kvh(k_c), kvh(v_c), kvh(k_s), kvh(v_s), kvh(k_w), kvh(v_w)
    k_cmp = compress_kv(k_c, pe_k, w1_k, w2_k)
    v_cmp = compress_kv(v_c, pe_v, w1_v, w2_v)
    n_cmp = k_cmp.shape[1]
    n_slc = S_ // NSA_SLC_BLOCK
    n_top = min(NSA_TOP_N, n_slc)
    k_blk = k_s.reshape(B_, n_slc, NSA_SLC_BLOCK, NSA_KV, NSA_HEAD_DIM).transpose(0, 3, 1, 2, 4)
    v_blk = v_s.reshape(B_, n_slc, NSA_SLC_BLOCK, NSA_KV, NSA_HEAD_DIM).transpose(0, 3, 1, 2, 4)
    pad = ((0, 0), (NSA_WINDOW, 0), (0, 0), (0, 0))
    k_wp, v_wp = jnp.pad(k_w, pad), jnp.pad(v_w, pad)
    table = rel_bias.astype(f32)
    table_kv = table.reshape(REL_BUCKETS, NSA_KV, NSA_GROUP).transpose(1, 0, 2)
    cmp_end = jnp.arange(n_cmp) * NSA_CMP_STRIDE + NSA_CMP_BLOCK - 1
    n_qb = S_ // Q_BLOCK
    qs = (q.astype(f32) * NSA_HEAD_DIM ** -0.5).reshape(
        B_, n_qb, Q_BLOCK, NSA_KV, NSA_GROUP, NSA_HEAD_DIM).transpose(1, 0, 2, 3, 4, 5)
    take = jax.vmap(jax.vmap(lambda blk, ix: blk[ix]))

    def head_bias(dist):
        return table[t5_bucket(dist)].transpose(2, 0, 1).reshape(NSA_KV, NSA_GROUP, *dist.shape)

    def block(args):
        bi, qb = args
        q0 = bi * Q_BLOCK
        qpos = q0 + jnp.arange(Q_BLOCK)
        dist_c = qpos[:, None] - cmp_end[None, :]
        s_c = jnp.einsum('bqkgd,bmkd->bkgqm', qb, k_cmp) + head_bias(dist_c)
        p_c = masked_softmax(s_c, dist_c >= 0)
        o_c = jnp.einsum('bkgqm,bmkd->bqkgd', p_c, v_cmp)
        imp = cmp_to_slc(p_c.sum(axis=2), n_slc)
        j = jnp.arange(n_slc)[None, :]
        cur = (qpos // NSA_SLC_BLOCK)[:, None]
        forced = (j == 0) | (j == cur) | (j == cur - 1)
        score = jnp.where(j > cur, -1.0, jnp.where(forced, NSA_GROUP + 1.0, imp))
        _, idx = lax.top_k(score, n_top)
        kg = take(k_blk, idx).reshape(B_, NSA_KV, Q_BLOCK, n_top * NSA_SLC_BLOCK, NSA_HEAD_DIM)
        vg = take(v_blk, idx).reshape(B_, NSA_KV, Q_BLOCK, n_top * NSA_SLC_BLOCK, NSA_HEAD_DIM)
        pos = (idx[..., None] * NSA_SLC_BLOCK + jnp.arange(NSA_SLC_BLOCK)).reshape(
            B_, NSA_KV, Q_BLOCK, n_top * NSA_SLC_BLOCK)
        dist_s = qpos[None, None, :, None] - pos
        bias_s = jax.vmap(lambda t, bk: t[bk], in_axes=(0, 1), out_axes=1)(table_kv, t5_bucket(dist_s))
        s_s = jnp.einsum('bqkgd,bkqnd->bkgqn', qb, kg) + bias_s.transpose(0, 1, 4, 2, 3)
        p_s = masked_softmax(s_s, (dist_s >= 0)[:, :, None])
        o_s = jnp.einsum('bkgqn,bkqnd->bqkgd', p_s, vg)
        kw = lax.dynamic_slice_in_dim(k_wp, q0, Q_BLOCK + NSA_WINDOW, axis=1)
        vw = lax.dynamic_slice_in_dim(v_wp, q0, Q_BLOCK + NSA_WINDOW, axis=1)
        kpos = q0 - NSA_WINDOW + jnp.arange(Q_BLOCK + NSA_WINDOW)
        dist_w = qpos[:, None] - kpos[None, :]
        mask_w = (dist_w >= 0) & (dist_w < NSA_WINDOW) & (kpos[None, :] >= 0)
        s_w = jnp.einsum('bqkgd,bwkd->bkgqw', qb, kw) + head_bias(dist_w)
        p_w = masked_softmax(s_w, mask_w)
        o_w = jnp.einsum('bkgqw,bwkd->bqkgd', p_w, vw)
        return o_c, o_s, o_w

    o_c, o_s, o_w = lax.map(block, (jnp.arange(n_qb), qs))

    def unblock(t):
        return t.transpose(1, 0, 2, 3, 4, 5).reshape(B_, S_, NSA_HEADS, NSA_HEAD_DIM)

    gates = jax.nn.sigmoid(gate.astype(f32)).reshape(B_, S_, NSA_HEADS, 3)
    o = (gates[..., 0:1] * unblock(o_c) + gates[..., 1:2] * unblock(o_s)
         + gates[..., 2:3] * unblock(o_w))
    return rms_normalize(o.reshape(B_, S_, GROUP_W)) * norm_g


def ssd_mixer(z, xbc, dt, conv_w, conv_b, dt_bias, a_log, d_skip, norm_g):
    B_, S_, _ = z.shape
    f32 = jnp.float32
    xbc = jax.nn.silu(causal_depthwise_conv(xbc.astype(f32), conv_w.astype(f32), conv_b.astype(f32)))
    xs, bm, cm = jnp.split(xbc, [GROUP_W, GROUP_W + SSM_GROUPS * SSM_STATE], axis=-1)
    xs = xs.reshape(B_, S_, SSM_HEADS, SSM_HEAD_DIM)
    rep = SSM_HEADS // SSM_GROUPS
    bm = jnp.repeat(bm.reshape(B_, S_, SSM_GROUPS, SSM_STATE), rep, axis=2)
    cm = jnp.repeat(cm.reshape(B_, S_, SSM_GROUPS, SSM_STATE), rep, axis=2)
    dt = jax.nn.softplus(dt.astype(f32) + dt_bias)
    log_a = dt * (-jnp.exp(a_log.astype(f32)))
    y = chunked_scalar_decay(cm, bm, xs * dt[..., None], log_a) + d_skip[:, None] * xs
    y = y.reshape(B_, S_, GROUP_W) * jax.nn.silu(z.astype(f32))
    y = rms_normalize(y.reshape(B_, S_, SSM_GROUPS, GROUP_W // SSM_GROUPS)).reshape(B_, S_, GROUP_W)
    return y * norm_g


def retention_mixer(q, k, v, g):
    B_, S_, _ = q.shape
    f32 = jnp.float32
    pos = jnp.arange(S_, dtype=f32)
    q = rotary(q.astype(f32).reshape(B_, S_, RET_HEADS, RET_DK), pos)
    k = rotary(k.astype(f32).reshape(B_, S_, RET_HEADS, RET_DK), pos) * RET_DK ** -0.5
    v = v.astype(f32).reshape(B_, S_, RET_HEADS, RET_DK)
    log_gamma = jnp.log(1.0 - 2.0 ** (-5.0 - jnp.arange(RET_HEADS, dtype=f32)))
    y = chunked_scalar_decay(q, k, v, jnp.broadcast_to(log_gamma, (B_, S_, RET_HEADS)))
    mu = jnp.mean(y, axis=-1, keepdims=True)
    y = (y - mu) * lax.rsqrt(jnp.mean(jnp.square(y - mu), axis=-1, keepdims=True) + 1e-5)
    return jax.nn.silu(g.astype(f32)) * y.reshape(B_, S_, GROUP_W)


def hybrid_mixer(h, w_in, w_out, lb, hg_norm_g, pe_k, w1_k, w2_k, pe_v, w1_v, w2_v, nsa_norm_g,
                 rel_bias, conv_w, conv_b, dt_bias, a_log, d_skip, ssm_norm_g):
    (hq, hf, hi, hg, nq, nkc, nvc, nks, nvs, nkw, nvw, ngate,
     sz, sxbc, sdt, rq, rk, rv, rg) = jnp.split(h @ w_in, IN_SPLITS, axis=-1)
    o_a = hgrn2_mixer(hq, hf, hi, hg, lb, hg_norm_g)
    o_b = nsa_mixer(nq, nkc, nvc, nks, nvs, nkw, nvw, ngate, pe_k, w1_k, w2_k, pe_v, w1_v, w2_v,
                    rel_bias, nsa_norm_g)
    o_c = ssd_mixer(sz, sxbc, sdt, conv_w, conv_b, dt_bias, a_log, d_skip, ssm_norm_g)
    o_d = retention_mixer(rq, rk, rv, rg)
    mixed = jnp.concatenate([o_a, o_b, o_c, o_d], axis=-1)
    return (mixed.astype(w_out.dtype) @ w_out).astype(h.dtype)


def setup_inputs(seed: int = 0) -> dict:
    key = jax.random.key(seed)
    keys = iter(jax.random.split(key, 40))
    L = DEPTH

    def normal(shape, scale):
        return jax.random.normal(next(keys), shape, jnp.float32) * scale

    def gain(shape):
        return 1.0 + normal(shape, 0.02)

    w_in_s = D_MODEL ** -0.5
    ffn_out_s = D_FF ** -0.5 * DEEPNORM_BETA
    return {
        'x': normal((BATCH, SEQ, D_MODEL), 1.0),
        'ln1_g': gain((L, D_MODEL)),
        'ln1_b': normal((L, D_MODEL), 0.02),
        'ffn1_w1': normal((L, D_MODEL, D_FF), w_in_s),
        'ffn1_w3': normal((L, D_MODEL, D_FF), w_in_s),
        'ffn1_w2': normal((L, D_FF, D_MODEL), ffn_out_s),
        'ln2_g': gain((L, D_MODEL)),
        'ln2_b': normal((L, D_MODEL), 0.02),
        'w_in': normal((L, D_MODEL, D_IN), w_in_s),
        'w_out': normal((L, MIX_W, D_MODEL), MIX_W ** -0.5 * DEEPNORM_BETA),
        'hgrn_lb_logits': normal((L, HG_HEADS * HG_DK), 0.5),
        'hgrn_norm_g': gain((L, GROUP_W)),
        'nsa_pe_k': normal((L, NSA_CMP_BLOCK, NSA_HEAD_DIM), 0.1),
        'nsa_w1_k': normal((L, NSA_CMP_BLOCK * NSA_HEAD_DIM, NSA_CMP_HIDDEN), (NSA_CMP_BLOCK * NSA_HEAD_DIM) ** -0.5),
        'nsa_w2_k': normal((L, NSA_CMP_HIDDEN, NSA_HEAD_DIM), NSA_CMP_HIDDEN ** -0.5),
        'nsa_pe_v': normal((L, NSA_CMP_BLOCK, NSA_HEAD_DIM), 0.1),
        'nsa_w1_v': normal((L, NSA_CMP_BLOCK * NSA_HEAD_DIM, NSA_CMP_HIDDEN), (NSA_CMP_BLOCK * NSA_HEAD_DIM) ** -0.5),
        'nsa_w2_v': normal((L, NSA_CMP_HIDDEN, NSA_HEAD_DIM), NSA_CMP_HIDDEN ** -0.5),
        'nsa_norm_g': gain((L, GROUP_W)),
        'rel_bias': normal((REL_BUCKETS, NSA_HEADS), 0.2),
        'ssm_conv_w': normal((L, SSM_CONV, SSM_CONV_DIM), 0.5),
        'ssm_conv_b': normal((L, SSM_CONV_DIM), 0.02),
        'ssm_dt_bias': (lambda dt: dt + jnp.log(-jnp.expm1(-dt)))(jnp.exp(jax.random.uniform(
            next(keys), (L, SSM_HEADS), jnp.float32, math.log(1e-3), math.log(1e-1)))),
        'ssm_a_log': jnp.log(jax.random.uniform(next(keys), (L, SSM_HEADS), jnp.float32, 1.0, 16.0)),
        'ssm_d': gain((L, SSM_HEADS)),
        'ssm_norm_g': gain((L, GROUP_W)),
        'ln3_g': gain((L, D_MODEL)),
        'ln3_b': normal((L, D_MODEL), 0.02),
        'ffn2_w1': normal((L, D_MODEL, D_FF), w_in_s),
        'ffn2_w3': normal((L, D_MODEL, D_FF), w_in_s),
        'ffn2_w2': normal((L, D_FF, D_MODEL), ffn_out_s),
    }


def reference(x, ln1_g, ln1_b, ffn1_w1, ffn1_w3, ffn1_w2, ln2_g, ln2_b, w_in, w_out,
              hgrn_lb_logits, hgrn_norm_g, nsa_pe_k, nsa_w1_k, nsa_w2_k, nsa_pe_v, nsa_w1_v,
              nsa_w2_v, nsa_norm_g, rel_bias, ssm_conv_w, ssm_conv_b, ssm_dt_bias, ssm_a_log,
              ssm_d, ssm_norm_g, ln3_g, ln3_b, ffn2_w1, ffn2_w3, ffn2_w2):
    cum = jnp.cumsum(jax.nn.softmax(hgrn_lb_logits.astype(jnp.float32), axis=0), axis=0)
    lower_bounds = cum - cum[:1]
    for l in range(DEPTH):
        x = layer_norm(DEEPNORM_ALPHA * x + 0.5 * swiglu(x, ffn1_w1[l], ffn1_w3[l], ffn1_w2[l]),
                       ln1_g[l], ln1_b[l])
        mix = hybrid_mixer(x, w_in[l], w_out[l], lower_bounds[l], hgrn_norm_g[l],
                           nsa_pe_k[l], nsa_w1_k[l], nsa_w2_k[l], nsa_pe_v[l], nsa_w1_v[l],
                           nsa_w2_v[l], nsa_norm_g[l], rel_bias, ssm_conv_w[l], ssm_conv_b[l],
                           ssm_dt_bias[l], ssm_a_log[l], ssm_d[l], ssm_norm_g[l])
        x = layer_norm(DEEPNORM_ALPHA * x + mix, ln2_g[l], ln2_b[l])
        x = layer_norm(DEEPNORM_ALPHA * x + 0.5 * swiglu(x, ffn2_w1[l], ffn2_w3[l], ffn2_w2[l]),
                       ln3_g[l], ln3_b[l])
    return x
```

```cpp
#include <hip/hip_runtime.h>
#include <hip/hip_cooperative_groups.h>
#include <cstdio>
namespace cg = cooperative_groups;
namespace pg8 {
#define PG8_LAS __attribute__((address_space(3)))
typedef unsigned short bf16_t;
typedef short bf16x8 __attribute__((ext_vector_type(8)));
typedef float f32x4 __attribute__((ext_vector_type(4)));
typedef unsigned u32x4 __attribute__((ext_vector_type(4)));
constexpr int BM = 256, BK = 64, HALF = 128, HTB = HALF * BK * 2  , STAGE_BYTES = 8 * HTB, NXCD = 8, WGM = 8;

__host__ __device__ __forceinline__ int lds_byte(int r, int c) { const int st = (r >> 4) * 2 + (c >> 5), rr = r & 15, cc = c & 31, ob = rr * 64 + cc * 2; return st * 1024 + (ob ^ (((ob >> 9) & 1) << 5)); }
__host__ __device__ __forceinline__ void stage_rc(int b, int& R, int& C) { const int st = b / 1024, sb = b % 1024, swz = sb ^ (((sb >> 9) & 1) << 5); R = (st >> 1) * 16 + swz / 64; C = (st & 1) * 32 + (swz % 64) / 2; }
__host__ __device__ __forceinline__ int perm32(int rho) { const int n = rho >> 4, i = rho & 15; return 8 * (i >> 2) + 4 * n + (i & 3); }

struct Unit { int pm, pn; };
struct Gemm { const bf16_t* A; const bf16_t* Bt; int M, N, K; };

struct StaticOrder {
    int nM, nN, nwg, G, c;
    __host__ __device__ void init(int M, int N, int G_, int c_) { nM = M / BM; nN = N / BM; nwg = nM * nN; G = G_; c = c_; }
    __host__ __device__ bool next(int i, Unit& u) const {
        const long L = (long)i * G + c; if (L >= nwg) return false;
        int wgid = (int)L; { const int q = nwg / NXCD, r = nwg % NXCD, xcd = wgid % NXCD, off = wgid / NXCD; wgid = (xcd < r ? xcd * (q + 1) : r * (q + 1) + (xcd - r) * q) + off; }
        const int nig = WGM * nN, gid = wgid / nig, fm = gid * WGM, gsz = (nM - fm) < WGM ? (nM - fm) : WGM;
        u.pm = fm + ((wgid % nig) % gsz); u.pn = (wgid % nig) / gsz; return true;
    }
    __device__ __forceinline__ void a_ready(const Unit&) const {}
    __device__ __forceinline__ void done(const Unit&) const {}
};
struct CountedOrder : StaticOrder {
    const unsigned* ready; unsigned need; unsigned* tmo;
    __device__ __forceinline__ void a_ready(const Unit& u) const {
        if (threadIdx.x < 64) {
            const unsigned long long t0 = __builtin_amdgcn_s_memrealtime(); unsigned polls = 0;
            while ((unsigned)__builtin_amdgcn_readfirstlane(__hip_atomic_load(ready + 64 * u.pm, __ATOMIC_RELAXED, __HIP_MEMORY_SCOPE_AGENT)) < need) {
                if ((++polls & 255u) == 0u && __builtin_amdgcn_readfirstlane(__hip_atomic_load(tmo, __ATOMIC_RELAXED, __HIP_MEMORY_SCOPE_AGENT)) != 0u) break;
                if (__builtin_amdgcn_s_memrealtime() - t0 > 2000000ull) {
                    if (threadIdx.x == 0) { unsigned expect = 0u; __hip_atomic_compare_exchange_strong(tmo + 1, &expect, 0x600u | (unsigned)(u.pm & 0xff), __ATOMIC_RELAXED, __ATOMIC_RELAXED, __HIP_MEMORY_SCOPE_AGENT); __hip_atomic_store(tmo, 1u, __ATOMIC_RELAXED, __HIP_MEMORY_SCOPE_AGENT); }
                    break; }
                __builtin_amdgcn_s_sleep(2); }
            __builtin_amdgcn_fence(__ATOMIC_ACQUIRE, "agent");
            asm volatile("s_waitcnt vmcnt(0)" ::: "memory");
        }
#if !defined(BROKEN_HOOK_NO_BARRIER)
        asm volatile("" ::: "memory"); __builtin_amdgcn_s_barrier(); asm volatile("" ::: "memory");
#endif
    }
};

__device__ __forceinline__ unsigned cvt_pk_bf16(float lo, float hi) { unsigned r; asm volatile("v_cvt_pk_bf16_f32 %0, %1, %2" : "=v"(r) : "v"(lo), "v"(hi)); return r; }
typedef float f32x2 __attribute__((ext_vector_type(2)));
__device__ __forceinline__ f32x2 gelu_pk(f32x2 v) {
    const f32x2 av = __builtin_elementwise_abs(v), d = av * 0.2316418882f + 1.0f;
    f32x2 t; t.x = __builtin_amdgcn_rcpf(d.x); t.y = __builtin_amdgcn_rcpf(d.y);
    f32x2 q = t * 0.5307027145f + (-0.7265760135f); q = q * t + 0.7107068705f; q = q * t + (-0.142248368f); q = q * t + 0.127414796f; q = q * t;
    const f32x2 s = (v * v) * (-0.72134752044f);
    f32x2 e; e.x = __builtin_amdgcn_exp2f(s.x); e.y = __builtin_amdgcn_exp2f(s.y);
    const f32x2 m = v * (q * e), r = v - m;
    f32x2 o; o.x = v.x < 0.f ? m.x : r.x; o.y = v.y < 0.f ? m.y : r.y; return o;
}

struct EpiF32 {
    static constexpr bool PERM = false, AFTER_DRAIN = false;
    float* C; int ldc; const float* bias;
    __device__ __forceinline__ void operator()(const f32x4 (&acc)[2][2][4][2], const Unit& u, int wr, int wc, int fr, int fq) const {
        const int row0 = u.pm * BM + wr * 64 + fr, col0 = u.pn * BM + wc * 32 + 4 * fq;
        f32x4 bv[2][2];
#pragma unroll
        for (int bj = 0; bj < 2; ++bj)
#pragma unroll
            for (int n = 0; n < 2; ++n) bv[bj][n] = bias ? *(const f32x4*)(bias + col0 + bj * HALF + n * 16) : (f32x4){0.f, 0.f, 0.f, 0.f};
#pragma unroll
        for (int ai = 0; ai < 2; ++ai)
#pragma unroll
            for (int m = 0; m < 4; ++m) { float* rowp = C + (size_t)(row0 + ai * HALF + m * 16) * ldc + col0;
#pragma unroll
                for (int bj = 0; bj < 2; ++bj)
#pragma unroll
                    for (int n = 0; n < 2; ++n) *(f32x4*)(rowp + bj * HALF + n * 16) = acc[ai][bj][m][n] + bv[bj][n]; }
    }
};
template <int ACT  > struct EpiBf16 {
    static constexpr bool PERM = true, AFTER_DRAIN = false;
    bf16_t* O; int ldc; const float* bias; int split_cols; size_t split_stride;
    __device__ __forceinline__ void operator()(const f32x4 (&acc)[2][2][4][2], const Unit& u, int wr, int wc, int fr, int fq) const {
        const int row0 = u.pm * BM + wr * 64 + fr; int colt = u.pn * BM; bf16_t* base = O;
        if (split_cols) { const int t = colt / split_cols; base += (size_t)t * split_stride; colt -= t * split_cols; }
        const int col0 = colt + wc * 32 + 8 * fq, bcol0 = u.pn * BM + wc * 32 + 8 * fq;
        f32x4 bv[2][2];
#pragma unroll
        for (int bj = 0; bj < 2; ++bj)
#pragma unroll
            for (int n = 0; n < 2; ++n) bv[bj][n] = bias ? *(const f32x4*)(bias + bcol0 + bj * HALF + 4 * n) : (f32x4){0.f, 0.f, 0.f, 0.f};
#pragma unroll
        for (int ai = 0; ai < 2; ++ai)
#pragma unroll
            for (int m = 0; m < 4; ++m) { bf16_t* rowp = base + (size_t)(row0 + ai * HALF + m * 16) * ldc + col0;
#pragma unroll
                for (int bj = 0; bj < 2; ++bj) { f32x4 v0 = acc[ai][bj][m][0] + bv[bj][0], v1 = acc[ai][bj][m][1] + bv[bj][1];
                    if (ACT == 1) { f32x2 a = gelu_pk((f32x2){v0[0], v0[1]}), b = gelu_pk((f32x2){v0[2], v0[3]}), c = gelu_pk((f32x2){v1[0], v1[1]}), d = gelu_pk((f32x2){v1[2], v1[3]});
                        v0 = (f32x4){a.x, a.y, b.x, b.y}; v1 = (f32x4){c.x, c.y, d.x, d.y}; }
                    if (ACT == 2) {
#pragma unroll
                        for (int j = 0; j < 4; ++j) { v0[j] = 0.5f * v0[j] * (1.0f + erff(v0[j] * 0.70710678f)); v1[j] = 0.5f * v1[j] * (1.0f + erff(v1[j] * 0.70710678f)); } }
                    u32x4 w; w.x = cvt_pk_bf16(v0[0], v0[1]); w.y = cvt_pk_bf16(v0[2], v0[3]); w.z = cvt_pk_bf16(v1[0], v1[1]); w.w = cvt_pk_bf16(v1[2], v1[3]);
                    *(u32x4*)(rowp + bj * HALF) = w; } }
    }
};
template <class Epi, class Sched, bool STAMP = false>
__device__ __forceinline__ void gemm_phase(PG8_LAS unsigned char* lds, const Gemm g, const Sched& S, const Epi& E, unsigned long long* stamps) {
    const int tid = threadIdx.x, wid = __builtin_amdgcn_readfirstlane(tid >> 6), lane = tid & 63, wr = wid >> 2, wc = wid & 3, fr = lane & 15, fq = lane >> 4;
    const int K = g.K, nt = K / BK;
    int ts_lo = 0, ts_hi = 0, nts = 0; const unsigned long long rt_entry = STAMP ? (unsigned long long)wall_clock64() : 0ull;
#define PG8_STAMP() do { if (STAMP && wid == 0 && nts < 64) { const unsigned long long _c = (unsigned long long)clock64(); \
        ts_lo = (lane == nts) ? (int)(unsigned)_c : ts_lo; ts_hi = (lane == nts) ? (int)(unsigned)(_c >> 32) : ts_hi; ++nts; } } while (0)
    PG8_STAMP();
    unsigned voffA[2], voffB[2];
#pragma unroll
    for (int i = 0; i < 2; ++i) { int R, C; stage_rc(tid * 16 + i * 8192, R, C); const int Rb = Epi::PERM ? ((R & ~31) + perm32(R & 31)) : R;
        voffA[i] = (unsigned)(R * K + C) * 2u; voffB[i] = (unsigned)(Rb * K + C) * 2u; }
    const size_t kstep = (size_t)(BK * 2);
    const size_t hstep = (size_t)HALF * K * 2;
    const size_t tstep = 2 * hstep;
    const unsigned ldsw = (unsigned)wid * 1024u;
    const int aoff = lds_byte(wr * 64 + fr, fq * 8), boff = lds_byte(wc * 32 + fr, fq * 8);
#define PG8_SA(b, h) (((b) * 2 + (h)) * HTB)
#define PG8_SB(b, h) ((4 + (b) * 2 + (h)) * HTB)
#define PG8_STAGE(bufoff, gbase, voff) do { _Pragma("unroll") for (int _i = 0; _i < 2; ++_i) \
        __builtin_amdgcn_global_load_lds((const unsigned*)((const char*)(gbase) + (voff)[_i]), (PG8_LAS unsigned*)(lds + (bufoff) + ldsw + _i * 8192), 16, 0, 0); } while (0)
#define PG8_LDA(dst, b, h) do { _Pragma("unroll") for (int m = 0; m < 4; ++m) _Pragma("unroll") for (int k = 0; k < 2; ++k) dst[m][k] = *(const PG8_LAS bf16x8*)(lds + PG8_SA(b, h) + aoff + m * 2048 + k * 1024); } while (0)
#define PG8_LDB(dst, b, h) do { _Pragma("unroll") for (int n = 0; n < 2; ++n) _Pragma("unroll") for (int k = 0; k < 2; ++k) dst[n][k] = *(const PG8_LAS bf16x8*)(lds + PG8_SB(b, h) + boff + n * 2048 + k * 1024); } while (0)
#define PG8_MMA(ai, bj, At, Bt) do { __builtin_amdgcn_s_setprio(1); _Pragma("unroll") for (int m = 0; m < 4; ++m) _Pragma("unroll") for (int n = 0; n < 2; ++n) _Pragma("unroll") for (int k = 0; k < 2; ++k) \
        acc[ai][bj][m][n] = __builtin_amdgcn_mfma_f32_16x16x32_bf16(Bt[n][k], At[m][k], acc[ai][bj][m][n], 0, 0, 0); __builtin_amdgcn_s_setprio(0); } while (0)
#define PG8_WAIT_V(n) asm volatile("s_waitcnt vmcnt(" #n ")" ::: "memory")
#define PG8_WAIT_L(n) asm volatile("s_waitcnt lgkmcnt(" #n ")" ::: "memory")
#define PG8_BAR __builtin_amdgcn_s_barrier()
#define PG8_SCHED __builtin_amdgcn_sched_barrier(0)
    Unit cur, nxt; int ui = 0;
    if (!S.next(0, cur)) return;
    f32x4 acc[2][2][4][2];
#pragma unroll
    for (int a = 0; a < 2; ++a)
#pragma unroll
        for (int b = 0; b < 2; ++b)
#pragma unroll
            for (int m = 0; m < 4; ++m)
#pragma unroll
                for (int n = 0; n < 2; ++n) acc[a][b][m][n] = (f32x4){0.f, 0.f, 0.f, 0.f};
    bf16x8 At[4][2], B0[2][2], B1[2][2];
    const char* cA = (const char*)g.A + (size_t)cur.pm * tstep; const char* cB = (const char*)g.Bt + (size_t)cur.pn * tstep;
    S.a_ready(cur);
    PG8_STAGE(PG8_SB(0, 0), cB, voffB); PG8_STAGE(PG8_SA(0, 0), cA, voffA); PG8_STAGE(PG8_SB(0, 1), cB + hstep, voffB); PG8_STAGE(PG8_SA(0, 1), cA + hstep, voffA);
    if (wr == 1) PG8_BAR;
    PG8_WAIT_V(4); PG8_BAR;
    PG8_STAGE(PG8_SB(1, 0), cB + kstep, voffB); PG8_STAGE(PG8_SA(1, 0), cA + kstep, voffA); PG8_STAGE(PG8_SB(1, 1), cB + hstep + kstep, voffB);
    PG8_WAIT_V(6); PG8_BAR;
    PG8_STAMP();
    for (;;) {
        const bool has_next = S.next(ui + 1, nxt);
        const char* nA = has_next ? (const char*)g.A + (size_t)nxt.pm * tstep : cA; const char* nB = has_next ? (const char*)g.Bt + (size_t)nxt.pn * tstep : cB;
        for (int t = 0; t < nt; t += 2) {
            const bool last = (t == nt - 2);
            const char* a1 = cA + (size_t)(t + 1) * kstep;
            const char* a2 = last ? nA : cA + (size_t)(t + 2) * kstep; const char* b2 = last ? nB : cB + (size_t)(t + 2) * kstep;
            const char* a3 = a2 + kstep; const char* b3 = b2 + kstep;
            if (last && has_next) S.a_ready(nxt);
            PG8_LDB(B0, 0, 0); PG8_SCHED; PG8_LDA(At, 0, 0); PG8_STAGE(PG8_SA(1, 1), a1 + hstep, voffA);
            PG8_WAIT_L(8); PG8_BAR; PG8_WAIT_L(0); PG8_MMA(0, 0, At, B0); PG8_BAR; PG8_SCHED;
            PG8_LDB(B1, 0, 1); PG8_STAGE(PG8_SB(0, 0), b2, voffB);
            PG8_BAR; PG8_WAIT_L(0); PG8_MMA(0, 1, At, B1); PG8_BAR;
            PG8_LDA(At, 0, 1); PG8_STAGE(PG8_SA(0, 0), a2, voffA);
            PG8_BAR; PG8_WAIT_L(0); PG8_MMA(1, 0, At, B0); PG8_BAR; PG8_SCHED;
            PG8_STAGE(PG8_SB(0, 1), b2 + hstep, voffB);
            PG8_WAIT_V(6); PG8_BAR; PG8_MMA(1, 1, At, B1); PG8_BAR;
            PG8_LDB(B0, 1, 0); PG8_SCHED; PG8_LDA(At, 1, 0); PG8_STAGE(PG8_SA(0, 1), a2 + hstep, voffA);
            PG8_WAIT_L(8); PG8_BAR; PG8_WAIT_L(0); PG8_MMA(0, 0, At, B0); PG8_BAR; PG8_SCHED;
            PG8_LDB(B1, 1, 1); PG8_STAGE(PG8_SB(1, 0), b3, voffB);
            PG8_BAR; PG8_WAIT_L(0); PG8_MMA(0, 1, At, B1); PG8_BAR;
            PG8_LDA(At, 1, 1); PG8_STAGE(PG8_SA(1, 0), a3, voffA);
            PG8_BAR; PG8_WAIT_L(0); PG8_MMA(1, 0, At, B0); PG8_BAR; PG8_SCHED;
            PG8_STAGE(PG8_SB(1, 1), b3 + hstep, voffB);
            PG8_WAIT_V(6); PG8_BAR; PG8_MMA(1, 1, At, B1); PG8_BAR;
        }
        PG8_STAMP();
        if constexpr (!Epi::AFTER_DRAIN) { E(acc, cur, wr, wc, fr, fq); S.done(cur); }
        PG8_STAMP();
        if (!has_next) break;
#pragma unroll
        for (int a = 0; a < 2; ++a)
#pragma unroll
            for (int b = 0; b < 2; ++b)
#pragma unroll
                for (int m = 0; m < 4; ++m)
#pragma unroll
                    for (int n = 0; n < 2; ++n) acc[a][b][m][n] = (f32x4){0.f, 0.f, 0.f, 0.f};
        cur = nxt; cA = nA; cB = nB; ++ui;
    }
    PG8_WAIT_V(0);
    if (wr == 0) PG8_BAR;
    PG8_BAR;
    if constexpr (Epi::AFTER_DRAIN) { E.fused(acc, cur, wr, wc, fr, fq, lds, wid, lane); S.done(cur); }
    PG8_STAMP();
    if (STAMP && wid == 0) { stamps[lane] = lane < nts ? (((unsigned long long)(unsigned)ts_hi << 32) | (unsigned)ts_lo) : 0ull;
        if (lane == 62) stamps[62] = rt_entry; if (lane == 63) stamps[63] = (unsigned long long)wall_clock64(); }
#undef PG8_STAMP
#undef PG8_SA
#undef PG8_SB
#undef PG8_STAGE
#undef PG8_LDA
#undef PG8_LDB
#undef PG8_MMA
#undef PG8_WAIT_V
#undef PG8_WAIT_L
#undef PG8_BAR
#undef PG8_SCHED
}
}
typedef unsigned short bf16_t;
typedef float f32x4 __attribute__((ext_vector_type(4)));
typedef unsigned u32x4 __attribute__((ext_vector_type(4)));
typedef unsigned u32x2 __attribute__((ext_vector_type(2)));
#define LAS __attribute__((address_space(3)))

constexpr int SEQ = 16384, NBATCH = 2, NTOK = 32768, DM = 2048, DFF = 5632, DIN = 6944, DINP = 7168, NLAYER = 2;
constexpr int C_HQ = 0, C_HF = 512, C_HI = 1024, C_HG = 1536, C_NQ = 2048, C_NKC = 2560, C_NVC = 2688, C_NKS = 2816, C_NVS = 2944,
              C_NKW = 3072, C_NVW = 3200, C_NGATE = 3328, C_SZ = 3352, C_SXBC = 3864, C_SDT = 4888, C_RQ = 4896, C_RK = 5408, C_RV = 5920, C_RG = 6432;
constexpr float ALPHA = 1.41421356237f;
constexpr int LDS_BYTES = 147456;
constexpr int NTHREADS = 512;

constexpr size_t WS_WA = 0;
constexpr size_t WS_WB = WS_WA + (size_t)11264 * 2048 * 2;
constexpr size_t WS_WC = WS_WB + (size_t)2048 * 5632 * 2;
constexpr size_t WS_WD = WS_WC + (size_t)7168 * 2048 * 2;
constexpr size_t WS_XB = WS_WD + (size_t)2048 * 2048 * 2;
constexpr size_t WS_HIN = WS_XB + (size_t)NTOK * 2048 * 2;
constexpr size_t WS_STH = WS_HIN + (size_t)NTOK * DINP * 2;
constexpr size_t WS_STS = WS_STH + (size_t)2048 * 16384 * 2;
constexpr size_t WS_STR = WS_STS + (size_t)4096 * 8192 * 2;
constexpr size_t WS_DECH = WS_STR + (size_t)2048 * 16384 * 2;
constexpr size_t WS_DECS = WS_DECH + (size_t)2048 * 128 * 4;
constexpr size_t WS_KCMP = WS_DECS + (size_t)4096 * 4;
constexpr size_t WS_VCMP = WS_KCMP + (size_t)4 * 1024 * 64 * 4;
constexpr size_t WS_END = WS_VCMP + (size_t)4 * 1024 * 64 * 4;

struct Params {
    const float* in[31];
    float* out;
    unsigned char* ws;
    int ph_lo, ph_hi;
};

__device__ __forceinline__ float bf2f(bf16_t v) { return __uint_as_float(((unsigned)v) << 16); }
__device__ __forceinline__ float bflo(unsigned w) { return __uint_as_float(w << 16); }
__device__ __forceinline__ float bfhi(unsigned w) { return __uint_as_float(w & 0xffff0000u); }
__device__ __forceinline__ unsigned pk2(float lo, float hi) { return pg8::cvt_pk_bf16(lo, hi); }
__device__ __forceinline__ float siluf(float x) { return x / (1.f + __expf(-x)); }
__device__ __forceinline__ float sigmf(float x) { return 1.f / (1.f + __expf(-x)); }
__device__ __forceinline__ float softplusf(float x) { return x > 20.f ? x : log1pf(__expf(x)); }

__device__ __forceinline__ void cvt_tile(const float* s0, const float* s1, bf16_t* dstp, int K, int N, int mode, int tile, float* tl) {
    const int nkb = K >> 6; const int rb = tile / nkb, kb = tile - rb * nkb;
    const int r0 = rb * 64; const float* src = s0; int col0 = r0;
    if (mode == 1) { const int pn = r0 >> 8, bj = (r0 >> 7) & 1, cc = r0 & 127; src = bj ? s1 : s0; col0 = pn * 128 + cc; }
    const int tid = threadIdx.x;
    { const int n = tid & 63, k0 = tid >> 6; const bool ok = (col0 + n) < N;
#pragma unroll
      for (int i = 0; i < 8; ++i) { const int k = k0 + 8 * i; tl[k * 65 + n] = ok ? src[(size_t)(kb * 64 + k) * N + col0 + n] : 0.f; } }
    __syncthreads();
    { const int kp = tid & 31, n0 = tid >> 5;
#pragma unroll
      for (int i = 0; i < 4; ++i) { const int n = n0 + 16 * i; const unsigned w = pk2(tl[(2 * kp) * 65 + n], tl[(2 * kp + 1) * 65 + n]);
          *(unsigned*)(dstp + (size_t)(r0 + n) * K + kb * 64 + 2 * kp) = w; } }
    __syncthreads();
}
__device__ void cvt_ffn(const Params& p, int l, int which  , float* tl) {
    const float* w1 = p.in[which ? 28 : 3] + (size_t)l * DM * DFF; const float* w3 = p.in[which ? 29 : 4] + (size_t)l * DM * DFF; const float* w2 = p.in[which ? 30 : 5] + (size_t)l * DFF * DM;
    constexpr int n0 = (11264 / 64) * (DM / 64), n1 = (DM / 64) * (DFF / 64);
    for (int g = blockIdx.x; g < n0 + n1; g += gridDim.x) { const bool f = g < n0;
        cvt_tile(f ? w1 : w2, w3, (bf16_t*)(p.ws + (f ? WS_WA : WS_WB)), f ? DM : DFF, f ? DFF : DM, f ? 1 : 0, f ? g : g - n0, tl); }
}
__device__ void cvt_mix(const Params& p, int l, float* tl) {
    constexpr int n0 = (DINP / 64) * (DM / 64), n1 = (DM / 64) * (DM / 64);
    for (int g = blockIdx.x; g < n0 + n1; g += gridDim.x) { const bool f = g < n0;
        cvt_tile(f ? p.in[8] + (size_t)l * DM * DIN : p.in[9] + (size_t)l * DM * DM, nullptr, (bf16_t*)(p.ws + (f ? WS_WC : WS_WD)), DM, f ? DIN : DM, 0, f ? g : g - n0, tl); }
}
__device__ void cvt_x(const Params& p) {
    const f32x4* x = (const f32x4*)p.in[0]; u32x2* xb = (u32x2*)(p.ws + WS_XB);
    for (size_t i = (size_t)blockIdx.x * NTHREADS + threadIdx.x; i < (size_t)NTOK * DM / 4; i += (size_t)gridDim.x * NTHREADS) {
        const f32x4 v = x[i]; u32x2 w; w.x = pk2(v[0], v[1]); w.y = pk2(v[2], v[3]); xb[i] = w; }
}

struct EpiUp {
    static constexpr bool PERM = true, AFTER_DRAIN = false;
    bf16_t* H;
    __device__ __forceinline__ void operator()(const pg8::f32x4 (&acc)[2][2][4][2], const pg8::Unit& u, int wr, int wc, int fr, int fq) const {
        const int row0 = u.pm * 256 + wr * 64 + fr, col0 = u.pn * 128 + wc * 32 + 8 * fq;
#pragma unroll
        for (int ai = 0; ai < 2; ++ai)
#pragma unroll
            for (int m = 0; m < 4; ++m) { bf16_t* rowp = H + (size_t)(row0 + ai * 128 + m * 16) * DFF + col0;
                const pg8::f32x4 a0 = acc[ai][0][m][0], a1 = acc[ai][0][m][1], b0 = acc[ai][1][m][0], b1 = acc[ai][1][m][1];
                float v0[4], v1[4];
#pragma unroll
                for (int j = 0; j < 4; ++j) { v0[j] = siluf(a0[j]) * b0[j]; v1[j] = siluf(a1[j]) * b1[j]; }
                pg8::u32x4 w; w.x = pk2(v0[0], v0[1]); w.y = pk2(v0[2], v0[3]); w.z = pk2(v1[0], v1[1]); w.w = pk2(v1[2], v1[3]);
                *(pg8::u32x4*)rowp = w; }
    }
};
struct EpiRes {
    static constexpr bool PERM = false, AFTER_DRAIN = false;
    const float* res; float* out; float alpha, scale;
    __device__ __forceinline__ void operator()(const pg8::f32x4 (&acc)[2][2][4][2], const pg8::Unit& u, int wr, int wc, int fr, int fq) const {
        const int row0 = u.pm * 256 + wr * 64 + fr, col0 = u.pn * 256 + wc * 32 + 4 * fq;
#pragma unroll
        for (int ai = 0; ai < 2; ++ai)
#pragma unroll
            for (int m = 0; m < 4; ++m) { const size_t off = (size_t)(row0 + ai * 128 + m * 16) * DM + col0;
#pragma unroll
                for (int bj = 0; bj < 2; ++bj)
#pragma unroll
                    for (int n = 0; n < 2; ++n) { const pg8::f32x4 r = *(const pg8::f32x4*)(res + off + bj * 128 + n * 16);
                        *(pg8::f32x4*)(out + off + bj * 128 + n * 16) = r * alpha + acc[ai][bj][m][n] * scale; } }
    }
};

__device__ void ln_rows(float* X, bf16_t* xb, const float* g, const float* b) {
    const int wid = threadIdx.x >> 6, lane = threadIdx.x & 63;
    for (int row = blockIdx.x * 8 + wid; row < NTOK; row += gridDim.x * 8) {
        float* xr = X + (size_t)row * DM; f32x4 v[8]; float s = 0.f;
#pragma unroll
        for (int i = 0; i < 8; ++i) { v[i] = *(const f32x4*)(xr + i * 256 + lane * 4); s += (v[i][0] + v[i][1]) + (v[i][2] + v[i][3]); }
#pragma unroll
        for (int o = 32; o >= 1; o >>= 1) s += __shfl_xor(s, o);
        const float mean = s * (1.f / DM); float q = 0.f;
#pragma unroll
        for (int i = 0; i < 8; ++i) { const f32x4 d = v[i] - mean; q += (d[0] * d[0] + d[1] * d[1]) + (d[2] * d[2] + d[3] * d[3]); }
#pragma unroll
        for (int o = 32; o >= 1; o >>= 1) q += __shfl_xor(q, o);
        const float rstd = rsqrtf(q * (1.f / DM) + 1e-5f);
#pragma unroll
        for (int i = 0; i < 8; ++i) { const int c = i * 256 + lane * 4; const f32x4 gg = *(const f32x4*)(g + c), bb = *(const f32x4*)(b + c);
            const f32x4 o = (v[i] - mean) * rstd * gg + bb; *(f32x4*)(xr + c) = o;
            u32x2 w; w.x = pk2(o[0], o[1]); w.y = pk2(o[2], o[3]); *(u32x2*)(xb + (size_t)row * DM + c) = w; }
    }
}
constexpr int LP = 132;
__device__ __forceinline__ float hg_lb(const Params& p, int l, int idx) {
    if (l == 0) return 0.f; const float a0 = p.in[10][idx], a1 = p.in[10][512 + idx]; return 1.f / (1.f + __expf(a0 - a1));
}
template <int DV> __device__ __forceinline__ void state_mm(const float* KD, const float* VV, bf16_t* dst) {
    const int tid = threadIdx.x, td = tid >> 4, tv = tid & 15;
    constexpr int NV = DV / 64;
    f32x4 acc[4][NV];
#pragma unroll
    for (int a = 0; a < 4; ++a)
#pragma unroll
        for (int n = 0; n < NV; ++n) acc[a][n] = (f32x4){0.f, 0.f, 0.f, 0.f};
    for (int j = 0; j < 64; ++j) {
        f32x4 v[NV];
#pragma unroll
        for (int n = 0; n < NV; ++n) v[n] = *(const f32x4*)(VV + j * LP + n * 64 + tv * 4);
#pragma unroll
        for (int a = 0; a < 4; ++a) { const float kd = KD[j * LP + td + 32 * a];
#pragma unroll
            for (int n = 0; n < NV; ++n) acc[a][n] += v[n] * kd; }
    }
#pragma unroll
    for (int a = 0; a < 4; ++a)
#pragma unroll
        for (int n = 0; n < NV; ++n) { u32x2 w; w.x = pk2(acc[a][n][0], acc[a][n][1]); w.y = pk2(acc[a][n][2], acc[a][n][3]);
            *(u32x2*)(dst + (size_t)(td + 32 * a) * DV + n * 64 + tv * 4) = w; }
}
__device__ __forceinline__ float ssd_conv(const bf16_t* hin, const float* cw, const float* cb, int b, int s, int ch) {
    float acc = cb[ch];
#pragma unroll
    for (int w = 0; w < 4; ++w) { const int sp = s - 3 + w; if (sp >= 0) acc += cw[w * 1024 + ch] * bf2f(hin[((size_t)b * SEQ + sp) * DINP + C_SXBC + ch]); }
    return siluf(acc);
}
__device__ __forceinline__ void load_rotary(const bf16_t* hin, size_t t0, int pos0, int col0, float scale, float* dst, const float* theta) {
    const int tid = threadIdx.x;
#pragma unroll
    for (int i = 0; i < 8; ++i) { const int e = tid + 512 * i; const int j = e >> 6, i2 = e & 63;
        const unsigned w = *(const unsigned*)(hin + (t0 + j) * DINP + col0 + 2 * i2);
        const float t1 = bflo(w), t2 = bfhi(w); const float ang = (float)(pos0 + j) * theta[i2];
        const float n = rintf(ang * 0.15915494309189535f); float r = fmaf(-n, 6.28125f, ang); r = fmaf(-n, 1.9353071795864769e-3f, r);
        const float sn = __sinf(r), cs = __cosf(r);
        dst[j * LP + 2 * i2] = (t1 * cs - t2 * sn) * scale; dst[j * LP + 2 * i2 + 1] = (t1 * sn + t2 * cs) * scale; }
}
__device__ __forceinline__ void fill_theta(float* theta) { if (threadIdx.x < 64) theta[threadIdx.x] = 1.0f / powf(10000.0f, (float)threadIdx.x * (1.0f / 63.0f)); }

__device__ void hg_state_item(const Params& p, int l, int item, float* lds) {
    const int c = item & 255, h = (item >> 8) & 3, b = item >> 10; const int tid = threadIdx.x;
    const bf16_t* hin = (const bf16_t*)(p.ws + WS_HIN); const size_t t0 = (size_t)b * SEQ + c * 64;
    float* KD = lds; float* VV = lds + 64 * LP; float* BB = lds + 2 * 64 * LP;
#pragma unroll 4
    for (int i = 0; i < 16; ++i) { const int e = tid + 512 * i, j = e >> 7, d = e & 127;
        const float z = bf2f(hin[(t0 + j) * DINP + C_HF + h * 128 + d]); const float lbv = hg_lb(p, l, h * 128 + d);
        const float sn = 1.f / (1.f + __expf(z)), sg = 1.f - sn; const float f = lbv + (1.f - lbv) * sg;
        BB[j * LP + d] = __logf(f); KD[j * LP + d] = (1.f - lbv) * sn;
        VV[j * LP + d] = bf2f(hin[(t0 + j) * DINP + C_HI + h * 128 + d]); }
    __syncthreads();
    if (tid < 128) { float a = 0.f; for (int j = 0; j < 64; ++j) { a += BB[j * LP + tid]; BB[j * LP + tid] = a; } }
    __syncthreads();
#pragma unroll 4
    for (int i = 0; i < 16; ++i) { const int e = tid + 512 * i, j = e >> 7, d = e & 127; KD[j * LP + d] *= __expf(BB[63 * LP + d] - BB[j * LP + d]); }
    if (tid < 128) ((float*)(p.ws + WS_DECH))[(size_t)item * 128 + tid] = __expf(BB[63 * LP + tid]);
    __syncthreads();
    state_mm<128>(KD, VV, (bf16_t*)(p.ws + WS_STH) + (size_t)item * 16384);
    __syncthreads();
}
__device__ void ssd_state_item(const Params& p, int l, int item, float* lds) {
    const int c = item & 255, h = (item >> 8) & 7, b = item >> 11, g = h >> 2; const int tid = threadIdx.x;
    const bf16_t* hin = (const bf16_t*)(p.ws + WS_HIN); const size_t t0 = (size_t)b * SEQ + c * 64;
    const float* cw = p.in[20] + l * 4096; const float* cbias = p.in[21] + l * 1024;
    float* KD = lds; float* VV = lds + 64 * LP; float* AUX = lds + 2 * 64 * LP;
    if (tid < 64) { const float dtv = softplusf(bf2f(hin[(t0 + tid) * DINP + C_SDT + h]) + p.in[22][l * 8 + h]);
        AUX[tid] = dtv; AUX[64 + tid] = -dtv * __expf(p.in[23][l * 8 + h]); }
    __syncthreads();
    if (tid < 64) { float a = 0.f; for (int j = 0; j <= tid; ++j) a += AUX[64 + j]; AUX[128 + tid] = a; }
    __syncthreads();
    const float cl = AUX[128 + 63];
#pragma unroll 4
    for (int i = 0; i < 16; ++i) { const int e = tid + 512 * i, j = e >> 7, n = e & 127;
        KD[j * LP + n] = ssd_conv(hin, cw, cbias, b, c * 64 + j, 512 + g * 128 + n) * __expf(cl - AUX[128 + j]); }
#pragma unroll 4
    for (int i = 0; i < 8; ++i) { const int e = tid + 512 * i, j = e >> 6, pc = e & 63;
        VV[j * LP + pc] = ssd_conv(hin, cw, cbias, b, c * 64 + j, h * 64 + pc) * AUX[j]; }
    if (tid == 0) ((float*)(p.ws + WS_DECS))[item] = __expf(cl);
    __syncthreads();
    state_mm<64>(KD, VV, (bf16_t*)(p.ws + WS_STS) + (size_t)item * 8192);
    __syncthreads();
}
__device__ __forceinline__ float ret_lg(int h) { return __logf(1.f - exp2f(-5.f - (float)h)); }
__device__ void ret_state_item(const Params& p, int l, int item, float* lds) {
    const int c = item & 255, h = (item >> 8) & 3, b = item >> 10; const int tid = threadIdx.x;
    const bf16_t* hin = (const bf16_t*)(p.ws + WS_HIN); const size_t t0 = (size_t)b * SEQ + c * 64;
    float* KD = lds; float* VV = lds + 64 * LP; float* TH = lds + 2 * 64 * LP;
    fill_theta(TH);
    __syncthreads();
    load_rotary(hin, t0, c * 64, C_RK + h * 128, 0.08838834764831845f, KD, TH);
#pragma unroll 4
    for (int i = 0; i < 16; ++i) { const int e = tid + 512 * i, j = e >> 7, d = e & 127; VV[j * LP + d] = bf2f(hin[(t0 + j) * DINP + C_RV + h * 128 + d]); }
    __syncthreads();
    const float lg = ret_lg(h);
#pragma unroll 4
    for (int i = 0; i < 16; ++i) { const int e = tid + 512 * i, j = e >> 7, d = e & 127; KD[j * LP + d] *= __expf(lg * (float)(63 - j)); }
    __syncthreads();
    state_mm<128>(KD, VV, (bf16_t*)(p.ws + WS_STR) + (size_t)item * 16384);
    __syncthreads();
}
__device__ void cmp_item(const Params& p, int l, int item, float* lds) {
    const int mb = item & 63, kv = (item >> 6) & 1, b = (item >> 7) & 1, which = item >> 8; const int tid = threadIdx.x;
    const bf16_t* hin = (const bf16_t*)(p.ws + WS_HIN);
    const float* pe = p.in[which ? 15 : 12] + l * 2048; const float* w1 = p.in[which ? 16 : 13] + (size_t)l * 2048 * 256; const float* w2 = p.in[which ? 17 : 14] + l * 256 * 64;
    float* dst = (float*)(p.ws + (which ? WS_VCMP : WS_KCMP)) + (size_t)(b * 2 + kv) * 1024 * 64;
    const int colx = (which ? C_NVC : C_NKC) + kv * 64;
    float* X = lds; float* PE = lds + 272 * 64; float* HID = PE + 2048;
    const int tok0 = mb * 256;
    for (int e = tid; e < 272 * 64; e += 512) { const int r = e >> 6, d = e & 63; const int s = tok0 + r; X[e] = s < SEQ ? bf2f(hin[((size_t)b * SEQ + s) * DINP + colx + d]) : 0.f; }
    for (int e = tid; e < 2048; e += 512) PE[e] = pe[e];
    __syncthreads();
    { const int n = tid & 255, rh = tid >> 8; float acc[8]; float accpe = 0.f;
#pragma unroll
      for (int r = 0; r < 8; ++r) acc[r] = 0.f;
#pragma unroll 2
      for (int k = 0; k < 2048; k += 4) {
          const float w0 = w1[(size_t)(k + 0) * 256 + n], w1v = w1[(size_t)(k + 1) * 256 + n], w2v = w1[(size_t)(k + 2) * 256 + n], w3v = w1[(size_t)(k + 3) * 256 + n];
          const f32x4 pe4 = *(const f32x4*)(PE + k); accpe += pe4[0] * w0 + pe4[1] * w1v + pe4[2] * w2v + pe4[3] * w3v;
          const int pos = k >> 6, dim = k & 63;
#pragma unroll
          for (int r = 0; r < 8; ++r) { const f32x4 x = *(const f32x4*)(X + (16 * (rh * 8 + r) + pos) * 64 + dim); acc[r] += x[0] * w0 + x[1] * w1v + x[2] * w2v + x[3] * w3v; }
      }
#pragma unroll
      for (int r = 0; r < 8; ++r) HID[(rh * 8 + r) * 256 + n] = siluf(acc[r] + accpe);
    }
    __syncthreads();
    { const int e = tid & 63, r0 = tid >> 6; float o0 = 0.f, o1 = 0.f;
      for (int nn = 0; nn < 256; ++nn) { const float w = w2[nn * 64 + e]; o0 += HID[r0 * 256 + nn] * w; o1 += HID[(r0 + 8) * 256 + nn] * w; }
      const int m0 = mb * 16 + r0; if (m0 < 1023) dst[(size_t)m0 * 64 + e] = o0; if (m0 + 8 < 1023) dst[(size_t)(m0 + 8) * 64 + e] = o1; }
    __syncthreads();
}
__device__ void mixer_phase_a(const Params& p, int l, float* lds) {
    for (int it = blockIdx.x; it < 8704; it += gridDim.x) {
        if (it < 512) cmp_item(p, l, it, lds);
        else if (it < 2560) hg_state_item(p, l, it - 512, lds);
        else if (it < 6656) ssd_state_item(p, l, it - 2560, lds);
        else ret_state_item(p, l, it - 6656, lds);
    }
}
__device__ void scan_phase(const Params& p) {
    for (int task = blockIdx.x * NTHREADS + threadIdx.x; task < 98304; task += gridDim.x * NTHREADS) {
        const int br = task >> 15, r = task & 32767;
        bf16_t* base; size_t cstride; const float* decp = nullptr; int dstride = 0; float dconst = 0.f;
        if (br == 0) { const int bh = r >> 12, e4 = r & 4095; base = (bf16_t*)(p.ws + WS_STH) + (size_t)bh * 256 * 16384 + e4 * 4; cstride = 16384;
            decp = (const float*)(p.ws + WS_DECH) + (size_t)bh * 256 * 128 + ((e4 * 4) >> 7); dstride = 128; }
        else if (br == 1) { const int bh = r >> 11, e4 = r & 2047; base = (bf16_t*)(p.ws + WS_STS) + (size_t)bh * 256 * 8192 + e4 * 4; cstride = 8192;
            decp = (const float*)(p.ws + WS_DECS) + (size_t)bh * 256; dstride = 1; }
        else { const int bh = r >> 12, e4 = r & 4095; base = (bf16_t*)(p.ws + WS_STR) + (size_t)bh * 256 * 16384 + e4 * 4; cstride = 16384; dconst = __expf(64.f * ret_lg(bh & 3)); }
        float s0 = 0.f, s1 = 0.f, s2 = 0.f, s3 = 0.f;
#pragma unroll 8
        for (int c = 0; c < 256; ++c) {
            u32x2* ptr = (u32x2*)(base + (size_t)c * cstride); const u32x2 w = *ptr; const float dec = decp ? decp[(size_t)c * dstride] : dconst;
            u32x2 o; o.x = pk2(s0, s1); o.y = pk2(s2, s3); *ptr = o;
            s0 = dec * s0 + bflo(w.x); s1 = dec * s1 + bfhi(w.x); s2 = dec * s2 + bflo(w.y); s3 = dec * s3 + bfhi(w.y);
        }
    }
}
constexpr int AP = 68;
__device__ __forceinline__ void scores_plain(const float* QS, const float* KS, float (&acc)[2][4]) {
    const int tid = threadIdx.x, ti = tid >> 4, tj = tid & 15;
#pragma unroll
    for (int a = 0; a < 2; ++a)
#pragma unroll
        for (int jj = 0; jj < 4; ++jj) acc[a][jj] = 0.f;
    for (int d = 0; d < 128; d += 4) {
        f32x4 q[2], k[4];
#pragma unroll
        for (int a = 0; a < 2; ++a) q[a] = *(const f32x4*)(QS + (ti + 32 * a) * LP + d);
#pragma unroll
        for (int jj = 0; jj < 4; ++jj) k[jj] = *(const f32x4*)(KS + (tj + 16 * jj) * LP + d);
#pragma unroll
        for (int a = 0; a < 2; ++a)
#pragma unroll
            for (int jj = 0; jj < 4; ++jj) acc[a][jj] += (q[a][0] * k[jj][0] + q[a][1] * k[jj][1]) + (q[a][2] * k[jj][2] + q[a][3] * k[jj][3]);
    }
}
__device__ __forceinline__ void scores_hg(const float* QS, const float* KS, const float* BB, float (&acc)[2][4]) {
    const int tid = threadIdx.x, ti = tid >> 4, tj = tid & 15;
#pragma unroll
    for (int a = 0; a < 2; ++a)
#pragma unroll
        for (int jj = 0; jj < 4; ++jj) acc[a][jj] = 0.f;
    for (int d = 0; d < 128; d += 4) {
        f32x4 q[2], bi[2], k[4], bj[4];
#pragma unroll
        for (int a = 0; a < 2; ++a) { q[a] = *(const f32x4*)(QS + (ti + 32 * a) * LP + d); bi[a] = *(const f32x4*)(BB + (ti + 32 * a) * LP + d); }
#pragma unroll
        for (int jj = 0; jj < 4; ++jj) { k[jj] = *(const f32x4*)(KS + (tj + 16 * jj) * LP + d); bj[jj] = *(const f32x4*)(BB + (tj + 16 * jj) * LP + d); }
#pragma unroll
        for (int a = 0; a < 2; ++a)
#pragma unroll
            for (int jj = 0; jj < 4; ++jj)
#pragma unroll
                for (int x = 0; x < 4; ++x) acc[a][jj] += q[a][x] * k[jj][x] * __expf(fminf(bi[a][x] - bj[jj][x], 0.f));
    }
}
template <int DV> __device__ __forceinline__ void load_sprev(const bf16_t* src, float* SP) {
    const int tid = threadIdx.x;
    for (int e = tid; e < 128 * DV / 4; e += 512) { const int d = e / (DV / 4), v4 = e % (DV / 4); const u32x2 w = *(const u32x2*)(src + (size_t)d * DV + v4 * 4);
        *(f32x4*)(SP + d * (DV + 4) + v4 * 4) = (f32x4){bflo(w.x), bfhi(w.x), bflo(w.y), bfhi(w.y)}; }
}
template <int DV, bool VBF> __device__ __forceinline__ void out_mm(const float* AA, const void* VVp, const float* QS, const float* SP, f32x4 (&intra)[2][DV / 64], f32x4 (&inter)[2][DV / 64]) {
    const int tid = threadIdx.x, ti = tid >> 4, tv = tid & 15; constexpr int NV = DV / 64;
#pragma unroll
    for (int a = 0; a < 2; ++a)
#pragma unroll
        for (int n = 0; n < NV; ++n) { intra[a][n] = (f32x4){0.f, 0.f, 0.f, 0.f}; inter[a][n] = (f32x4){0.f, 0.f, 0.f, 0.f}; }
    for (int j = 0; j < 64; j += 4) {
        f32x4 a4[2];
#pragma unroll
        for (int a = 0; a < 2; ++a) a4[a] = *(const f32x4*)(AA + (ti + 32 * a) * AP + j);
#pragma unroll
        for (int x = 0; x < 4; ++x)
#pragma unroll
            for (int n = 0; n < NV; ++n) { f32x4 v;
                if (VBF) { const u32x2 w = *(const u32x2*)((const bf16_t*)VVp + (j + x) * 136 + n * 64 + tv * 4); v = (f32x4){bflo(w.x), bfhi(w.x), bflo(w.y), bfhi(w.y)}; }
                else v = *(const f32x4*)((const float*)VVp + (j + x) * AP + n * 64 + tv * 4);
#pragma unroll
                for (int a = 0; a < 2; ++a) intra[a][n] += v * a4[a][x]; }
    }
    for (int d = 0; d < 128; d += 4) {
        f32x4 q4[2];
#pragma unroll
        for (int a = 0; a < 2; ++a) q4[a] = *(const f32x4*)(QS + (ti + 32 * a) * LP + d);
#pragma unroll
        for (int x = 0; x < 4; ++x)
#pragma unroll
            for (int n = 0; n < NV; ++n) { const f32x4 s = *(const f32x4*)(SP + (d + x) * (DV + 4) + n * 64 + tv * 4);
#pragma unroll
                for (int a = 0; a < 2; ++a) inter[a][n] += s * q4[a][x]; }
    }
}
__device__ __forceinline__ float red16(float v) { v += __shfl_xor(v, 1); v += __shfl_xor(v, 2); v += __shfl_xor(v, 4); v += __shfl_xor(v, 8); return v; }
__device__ __forceinline__ float max16(float v) { v = fmaxf(v, __shfl_xor(v, 1)); v = fmaxf(v, __shfl_xor(v, 2)); v = fmaxf(v, __shfl_xor(v, 4)); v = fmaxf(v, __shfl_xor(v, 8)); return v; }

__device__ void hg_out_item(const Params& p, int l, int item, float* lds) {
    const int c = item & 255, h = (item >> 8) & 3, b = item >> 10; const int tid = threadIdx.x, ti = tid >> 4, tj = tid & 15;
    const bf16_t* hin = (const bf16_t*)(p.ws + WS_HIN); const size_t t0 = (size_t)b * SEQ + c * 64;
    float* QS = lds; float* KS = lds + 64 * LP; float* BB = lds + 2 * 64 * LP; float* AA = lds + 3 * 64 * LP; bf16_t* VV = (bf16_t*)(lds + 3 * 64 * LP + 64 * AP); float* SP = KS;
#pragma unroll 4
    for (int i = 0; i < 16; ++i) { const int e = tid + 512 * i, j = e >> 7, d = e & 127;
        const float z = bf2f(hin[(t0 + j) * DINP + C_HF + h * 128 + d]); const float lbv = hg_lb(p, l, h * 128 + d);
        const float sn = 1.f / (1.f + __expf(z)), sg = 1.f - sn; const float f = lbv + (1.f - lbv) * sg;
        BB[j * LP + d] = __logf(f); KS[j * LP + d] = (1.f - lbv) * sn;
        QS[j * LP + d] = siluf(bf2f(hin[(t0 + j) * DINP + C_HQ + h * 128 + d]));
        VV[j * 136 + d] = hin[(t0 + j) * DINP + C_HI + h * 128 + d]; }
    __syncthreads();
    if (tid < 128) { float a = 0.f; for (int j = 0; j < 64; ++j) { a += BB[j * LP + tid]; BB[j * LP + tid] = a; } }
    __syncthreads();
    { float acc[2][4]; scores_hg(QS, KS, BB, acc);
#pragma unroll
      for (int a = 0; a < 2; ++a)
#pragma unroll
          for (int jj = 0; jj < 4; ++jj) { const int i = ti + 32 * a, j = tj + 16 * jj; AA[i * AP + j] = (j <= i) ? acc[a][jj] : 0.f; } }
    __syncthreads();
#pragma unroll 4
    for (int i = 0; i < 16; ++i) { const int e = tid + 512 * i, j = e >> 7, d = e & 127; QS[j * LP + d] *= __expf(BB[j * LP + d]); }
    __syncthreads();
    load_sprev<128>((const bf16_t*)(p.ws + WS_STH) + (size_t)item * 16384, SP);
    __syncthreads();
    f32x4 intra[2][2], inter[2][2]; out_mm<128, true>(AA, VV, QS, SP, intra, inter);
    const int tv = tj; const float* ng = p.in[11] + l * 512 + h * 128; bf16_t* mixed = (bf16_t*)(p.ws + WS_XB);
#pragma unroll
    for (int a = 0; a < 2; ++a) { const int i = ti + 32 * a; f32x4 o[2]; float ss = 0.f;
#pragma unroll
        for (int n = 0; n < 2; ++n) { o[n] = intra[a][n] + inter[a][n]; ss += (o[n][0] * o[n][0] + o[n][1] * o[n][1]) + (o[n][2] * o[n][2] + o[n][3] * o[n][3]); }
        ss = red16(ss); const float r = rsqrtf(ss * (1.f / 128.f) + 1e-6f);
#pragma unroll
        for (int n = 0; n < 2; ++n) { const int v = n * 64 + tv * 4; const u32x2 gw = *(const u32x2*)(hin + (t0 + i) * DINP + C_HG + h * 128 + v); const f32x4 g4 = *(const f32x4*)(ng + v);
            const float r0 = o[n][0] * r * g4[0] * siluf(bflo(gw.x)), r1 = o[n][1] * r * g4[1] * siluf(bfhi(gw.x)), r2 = o[n][2] * r * g4[2] * siluf(bflo(gw.y)), r3 = o[n][3] * r * g4[3] * siluf(bfhi(gw.y));
            u32x2 w; w.x = pk2(r0, r1); w.y = pk2(r2, r3); *(u32x2*)(mixed + (t0 + i) * DM + h * 128 + v) = w; } }
    __syncthreads();
}
__device__ void ret_out_item(const Params& p, int l, int item, float* lds) {
    const int c = item & 255, h = (item >> 8) & 3, b = item >> 10; const int tid = threadIdx.x, ti = tid >> 4, tj = tid & 15;
    const bf16_t* hin = (const bf16_t*)(p.ws + WS_HIN); const size_t t0 = (size_t)b * SEQ + c * 64;
    float* QS = lds; float* KS = lds + 64 * LP; float* AA = lds + 3 * 64 * LP; bf16_t* VV = (bf16_t*)(lds + 3 * 64 * LP + 64 * AP); float* SP = KS; float* TH = lds + 3 * 64 * LP + 64 * AP + 64 * AP;
    fill_theta(TH);
    __syncthreads();
    load_rotary(hin, t0, c * 64, C_RQ + h * 128, 1.0f, QS, TH);
    load_rotary(hin, t0, c * 64, C_RK + h * 128, 0.08838834764831845f, KS, TH);
#pragma unroll 4
    for (int i = 0; i < 16; ++i) { const int e = tid + 512 * i, j = e >> 7, d = e & 127; VV[j * 136 + d] = hin[(t0 + j) * DINP + C_RV + h * 128 + d]; }
    __syncthreads();
    const float lg = ret_lg(h);
    { float acc[2][4]; scores_plain(QS, KS, acc);
#pragma unroll
      for (int a = 0; a < 2; ++a)
#pragma unroll
          for (int jj = 0; jj < 4; ++jj) { const int i = ti + 32 * a, j = tj + 16 * jj; AA[i * AP + j] = (j <= i) ? acc[a][jj] * __expf(lg * (float)(i - j)) : 0.f; } }
    __syncthreads();
    load_sprev<128>((const bf16_t*)(p.ws + WS_STR) + (size_t)item * 16384, SP);
    __syncthreads();
    f32x4 intra[2][2], inter[2][2]; out_mm<128, true>(AA, VV, QS, SP, intra, inter);
    const int tv = tj; bf16_t* mixed = (bf16_t*)(p.ws + WS_XB);
#pragma unroll
    for (int a = 0; a < 2; ++a) { const int i = ti + 32 * a; const float sc = __expf(lg * (float)(i + 1)); f32x4 o[2]; float s = 0.f;
#pragma unroll
        for (int n = 0; n < 2; ++n) { o[n] = intra[a][n] + inter[a][n] * sc; s += (o[n][0] + o[n][1]) + (o[n][2] + o[n][3]); }
        s = red16(s); const float mu = s * (1.f / 128.f); float q = 0.f;
#pragma unroll
        for (int n = 0; n < 2; ++n) { const f32x4 d = o[n] - mu; q += (d[0] * d[0] + d[1] * d[1]) + (d[2] * d[2] + d[3] * d[3]); }
        q = red16(q); const float r = rsqrtf(q * (1.f / 128.f) + 1e-5f);
#pragma unroll
        for (int n = 0; n < 2; ++n) { const int v = n * 64 + tv * 4; const u32x2 gw = *(const u32x2*)(hin + (t0 + i) * DINP + C_RG + h * 128 + v);
            const float r0 = (o[n][0] - mu) * r * siluf(bflo(gw.x)), r1 = (o[n][1] - mu) * r * siluf(bfhi(gw.x)), r2 = (o[n][2] - mu) * r * siluf(bflo(gw.y)), r3 = (o[n][3] - mu) * r * siluf(bfhi(gw.y));
            u32x2 w; w.x = pk2(r0, r1); w.y = pk2(r2, r3); *(u32x2*)(mixed + (t0 + i) * DM + 1536 + h * 128 + v) = w; } }
    __syncthreads();
}
__device__ void ssd_out_item(const Params& p, int l, int item, float* lds) {
    const int c = item & 255, g = (item >> 8) & 1, b = item >> 9; const int tid = threadIdx.x, ti = tid >> 4, tj = tid & 15, tv = tj;
    const bf16_t* hin = (const bf16_t*)(p.ws + WS_HIN); const size_t t0 = (size_t)b * SEQ + c * 64;
    const float* cw = p.in[20] + l * 4096; const float* cbias = p.in[21] + l * 1024;
    float* CM = lds; float* BM = lds + 8448; float* SP = BM; float* G = lds + 17152; float* AH = lds + 21504; float* VV = lds + 25856; float* XS = lds + 30208; float* AUX = lds + 34560;
    if (tid < 256) { const int hh = tid >> 6, j = tid & 63, h = g * 4 + hh; const float dtv = softplusf(bf2f(hin[(t0 + j) * DINP + C_SDT + h]) + p.in[22][l * 8 + h]);
        AUX[hh * 64 + j] = dtv; AUX[512 + hh * 64 + j] = -dtv * __expf(p.in[23][l * 8 + h]); }
#pragma unroll 4
    for (int i = 0; i < 16; ++i) { const int e = tid + 512 * i, j = e >> 7, n = e & 127;
        CM[j * LP + n] = ssd_conv(hin, cw, cbias, b, c * 64 + j, 768 + g * 128 + n); BM[j * LP + n] = ssd_conv(hin, cw, cbias, b, c * 64 + j, 512 + g * 128 + n); }
    __syncthreads();
    if (tid < 256) { const int hh = tid >> 6, j = tid & 63; float a = 0.f; for (int jj = 0; jj <= j; ++jj) a += AUX[512 + hh * 64 + jj]; AUX[256 + hh * 64 + j] = a; }
    { float acc[2][4]; scores_plain(CM, BM, acc);
#pragma unroll
      for (int a = 0; a < 2; ++a)
#pragma unroll
          for (int jj = 0; jj < 4; ++jj) G[(ti + 32 * a) * AP + tj + 16 * jj] = acc[a][jj]; }
    __syncthreads();
    float ss[2] = {0.f, 0.f}; bf16_t* mixed = (bf16_t*)(p.ws + WS_XB);
#pragma unroll 1
    for (int hh = 0; hh < 4; ++hh) {
        const int h = g * 4 + hh; const float* dt = AUX + hh * 64; const float* cb = AUX + 256 + hh * 64;
#pragma unroll 2
        for (int i = 0; i < 8; ++i) { const int e = tid + 512 * i, ii = e >> 6, j = e & 63; AH[ii * AP + j] = (j <= ii) ? G[ii * AP + j] * __expf(cb[ii] - cb[j]) : 0.f; }
#pragma unroll 2
        for (int i = 0; i < 8; ++i) { const int e = tid + 512 * i, j = e >> 6, pc = e & 63; const float xs = ssd_conv(hin, cw, cbias, b, c * 64 + j, h * 64 + pc); XS[j * AP + pc] = xs; VV[j * AP + pc] = xs * dt[j]; }
        load_sprev<64>((const bf16_t*)(p.ws + WS_STS) + (size_t)(((b * 8 + h) << 8) + c) * 8192, SP);
        __syncthreads();
        f32x4 intra[2][1], inter[2][1]; out_mm<64, false>(AH, VV, CM, SP, intra, inter);
        const float dsk = p.in[24][l * 8 + h];
#pragma unroll
        for (int a = 0; a < 2; ++a) { const int i = ti + 32 * a; const f32x4 xs = *(const f32x4*)(XS + i * AP + tv * 4); const u32x2 zw = *(const u32x2*)(hin + (t0 + i) * DINP + C_SZ + h * 64 + tv * 4);
            f32x4 o = intra[a][0] + inter[a][0] * __expf(cb[i]) + xs * dsk;
            o[0] *= siluf(bflo(zw.x)); o[1] *= siluf(bfhi(zw.x)); o[2] *= siluf(bflo(zw.y)); o[3] *= siluf(bfhi(zw.y));
            ss[a] += (o[0] * o[0] + o[1] * o[1]) + (o[2] * o[2] + o[3] * o[3]);
            u32x2 w; w.x = pk2(o[0], o[1]); w.y = pk2(o[2], o[3]); *(u32x2*)(mixed + (t0 + i) * DM + 1024 + g * 256 + hh * 64 + tv * 4) = w; }
        __syncthreads();
    }
    const float* ng = p.in[25] + l * 512 + g * 256;
#pragma unroll
    for (int a = 0; a < 2; ++a) { const int i = ti + 32 * a; const float r = rsqrtf(red16(ss[a]) * (1.f / 256.f) + 1e-6f);
#pragma unroll 1
        for (int hh = 0; hh < 4; ++hh) { const f32x4 g4 = *(const f32x4*)(ng + hh * 64 + tv * 4); u32x2* ptr = (u32x2*)(mixed + (t0 + i) * DM + 1024 + g * 256 + hh * 64 + tv * 4); const u32x2 yw = *ptr;
            const f32x4 o = (f32x4){bflo(yw.x), bfhi(yw.x), bflo(yw.y), bfhi(yw.y)} * r * g4;
            u32x2 w; w.x = pk2(o[0], o[1]); w.y = pk2(o[2], o[3]); *ptr = w; } }
    __syncthreads();
}
__device__ __forceinline__ int t5_bucket(int dist) {
    if (dist < 16) return dist;
    const int lg = 16 + (int)(__log2f((float)dist * 0.0625f) * 2.2857142857142856f);
    return lg < 31 ? lg : 31;
}
__device__ __forceinline__ float dot64_bf(const float (&q)[64], const bf16_t* kp) {
    float s0 = 0.f, s1 = 0.f;
#pragma unroll
    for (int i = 0; i < 8; ++i) { const u32x4 w = *(const u32x4*)(kp + i * 8);
        s0 += (q[8 * i + 0] * bflo(w.x) + q[8 * i + 2] * bflo(w.y)) + (q[8 * i + 4] * bflo(w.z) + q[8 * i + 6] * bflo(w.w));
        s1 += (q[8 * i + 1] * bfhi(w.x) + q[8 * i + 3] * bfhi(w.y)) + (q[8 * i + 5] * bfhi(w.z) + q[8 * i + 7] * bfhi(w.w)); }
    return s0 + s1;
}
__device__ __forceinline__ float dot64_f(const float (&q)[64], const float* kp) {
    float s0 = 0.f, s1 = 0.f;
#pragma unroll
    for (int i = 0; i < 16; ++i) { const f32x4 w = *(const f32x4*)(kp + i * 4); s0 += q[4 * i] * w[0] + q[4 * i + 2] * w[2]; s1 += q[4 * i + 1] * w[1] + q[4 * i + 3] * w[3]; }
    return s0 + s1;
}
__device__ __forceinline__ float softmax_row(float* scr, int ks, int n, float mx_local) {
    const float mx = max16(mx_local); float sum = 0.f;
    for (int idx = ks; idx < n; idx += 16) { const float e = __expf(scr[idx] - mx); scr[idx] = e; sum += e; }
    sum = red16(sum);
    return n > 0 ? 1.f / sum : 0.f;
}
__device__ void nsa_item(const Params& p, int l, int item, float* lds) {
    int b = item >> 8, qt = item & 255; if (b) qt = 255 - qt;
    const int tid = threadIdx.x, wid = tid >> 6, lane = tid & 63, h = lane >> 4, ks = lane & 15;
    float* sc = lds + wid * 4096; float* scr = sc + h * 1024; float* RB = lds + 32768;
    if (tid < 256) RB[tid] = p.in[19][tid];
    __syncthreads();
    const bf16_t* hin = (const bf16_t*)(p.ws + WS_HIN); const float* ng = p.in[18] + l * 512; bf16_t* mixed = (bf16_t*)(p.ws + WS_XB);
    for (int qi = 0; qi < 8; ++qi) {
        const int qpos = qt * 64 + wid * 8 + qi; const size_t tq = (size_t)b * SEQ + qpos; const int cur = qpos >> 6;
        f32x4 o0 = (f32x4){0.f, 0.f, 0.f, 0.f}, o1 = o0;
#pragma unroll 1
        for (int kv = 0; kv < 2; ++kv) {
            const int head = kv * 4 + h;
            float q[64];
            { const bf16_t* qp = hin + tq * DINP + C_NQ + head * 64;
#pragma unroll
              for (int i = 0; i < 8; ++i) { const u32x4 w = *(const u32x4*)(qp + i * 8);
                  q[8 * i + 0] = bflo(w.x) * 0.125f; q[8 * i + 1] = bfhi(w.x) * 0.125f; q[8 * i + 2] = bflo(w.y) * 0.125f; q[8 * i + 3] = bfhi(w.y) * 0.125f;
                  q[8 * i + 4] = bflo(w.z) * 0.125f; q[8 * i + 5] = bfhi(w.z) * 0.125f; q[8 * i + 6] = bflo(w.w) * 0.125f; q[8 * i + 7] = bfhi(w.w) * 0.125f; } }
            const float g0 = sigmf(bf2f(hin[tq * DINP + C_NGATE + head * 3 + 0])), g1 = sigmf(bf2f(hin[tq * DINP + C_NGATE + head * 3 + 1])), g2 = sigmf(bf2f(hin[tq * DINP + C_NGATE + head * 3 + 2]));
            f32x4 o = (f32x4){0.f, 0.f, 0.f, 0.f};
            const int nvis = qpos >= 31 ? ((qpos - 31) >> 4) + 1 : 0;
            const float* kc = (const float*)(p.ws + WS_KCMP) + (size_t)(b * 2 + kv) * 1024 * 64; const float* vc = (const float*)(p.ws + WS_VCMP) + (size_t)(b * 2 + kv) * 1024 * 64;
            float inv;
            { float mx = -INFINITY;
              for (int m = ks; m < nvis; m += 16) { const float s = dot64_f(q, kc + (size_t)m * 64) + RB[t5_bucket(qpos - (16 * m + 31)) * 8 + head]; scr[m] = s; mx = fmaxf(mx, s); }
              inv = softmax_row(scr, ks, nvis, mx); }
            const float inv0 = __shfl(inv, 0), inv1 = __shfl(inv, 16), inv2 = __shfl(inv, 32), inv3 = __shfl(inv, 48);
            __builtin_amdgcn_wave_barrier();
            unsigned long long key[4];
#pragma unroll
            for (int jj = 0; jj < 4; ++jj) { const int j = lane + 64 * jj; unsigned long long kk = 0ull;
                if (j <= cur) { float val;
                    if (j == 0 || j == cur || j == cur - 1) val = 5.0f;
                    else { val = 0.f;
#pragma unroll
                        for (int x = 0; x < 5; ++x) { const int mm = 4 * j - 1 + x;
                            if (mm >= 0 && mm < nvis) { const float pm = (sc[mm] * inv0 + sc[1024 + mm] * inv1) + (sc[2048 + mm] * inv2 + sc[3072 + mm] * inv3); val += (x == 0 || x == 4) ? 0.5f * pm : pm; } } }
                    kk = ((unsigned long long)(__float_as_uint(val) + 1u) << 32) | (unsigned)(255 - j); }
                key[jj] = kk; }
            { f32x4 acc = (f32x4){0.f, 0.f, 0.f, 0.f};
              for (int m = 0; m < nvis; ++m) { const float pm = scr[m]; const f32x4 v = *(const f32x4*)(vc + (size_t)m * 64 + ks * 4); acc += v * pm; }
              o += acc * (inv * g0); }
            int selv = 0, nsel = 0;
            for (int it = 0; it < 16; ++it) {
                unsigned long long best = key[0] > key[1] ? key[0] : key[1]; { const unsigned long long b2 = key[2] > key[3] ? key[2] : key[3]; best = b2 > best ? b2 : best; }
#pragma unroll
                for (int of = 32; of >= 1; of >>= 1) { const unsigned long long other = __shfl_xor(best, of); best = other > best ? other : best; }
                if ((best >> 32) == 0ull) break;
                if (lane == it) selv = 255 - (int)(unsigned)(best & 0xffffffffull);
                ++nsel;
#pragma unroll
                for (int jj = 0; jj < 4; ++jj) if (key[jj] == best) key[jj] = 0ull;
            }
            __builtin_amdgcn_wave_barrier();
            { float mx = -INFINITY;
              for (int si = 0; si < nsel; ++si) { const int jb = __shfl(selv, si);
#pragma unroll
                  for (int r = 0; r < 4; ++r) { const int kl = ks + 16 * r, kp = jb * 64 + kl; float s = -INFINITY;
                      if (kp <= qpos) s = dot64_bf(q, hin + ((size_t)b * SEQ + kp) * DINP + C_NKS + kv * 64) + RB[t5_bucket(qpos - kp) * 8 + head];
                      scr[si * 64 + kl] = s; mx = fmaxf(mx, s); } }
              inv = softmax_row(scr, ks, nsel * 64, mx);
              __builtin_amdgcn_wave_barrier();
              f32x4 acc = (f32x4){0.f, 0.f, 0.f, 0.f};
              for (int si = 0; si < nsel; ++si) { const int jb = __shfl(selv, si); const bf16_t* vp = hin + ((size_t)b * SEQ + jb * 64) * DINP + C_NVS + kv * 64 + ks * 4;
#pragma unroll 4
                  for (int kl = 0; kl < 64; ++kl) { const float pm = scr[si * 64 + kl]; const u32x2 w = *(const u32x2*)(vp + (size_t)kl * DINP);
                      acc += (f32x4){bflo(w.x), bfhi(w.x), bflo(w.y), bfhi(w.y)} * pm; } }
              o += acc * (inv * g1); }
            __builtin_amdgcn_wave_barrier();
            { const int lo = qpos > 511 ? qpos - 511 : 0, cnt = qpos - lo + 1; float mx = -INFINITY;
              for (int idx = ks; idx < cnt; idx += 16) { const int kp = lo + idx; const float s = dot64_bf(q, hin + ((size_t)b * SEQ + kp) * DINP + C_NKW + kv * 64) + RB[t5_bucket(qpos - kp) * 8 + head]; scr[idx] = s; mx = fmaxf(mx, s); }
              inv = softmax_row(scr, ks, cnt, mx);
              __builtin_amdgcn_wave_barrier();
              f32x4 acc = (f32x4){0.f, 0.f, 0.f, 0.f}; const bf16_t* vp = hin + ((size_t)b * SEQ + lo) * DINP + C_NVW + kv * 64 + ks * 4;
#pragma unroll 4
              for (int idx = 0; idx < cnt; ++idx) { const float pm = scr[idx]; const u32x2 w = *(const u32x2*)(vp + (size_t)idx * DINP);
                  acc += (f32x4){bflo(w.x), bfhi(w.x), bflo(w.y), bfhi(w.y)} * pm; }
              o += acc * (inv * g2); }
            __builtin_amdgcn_wave_barrier();
            if (kv == 0) o0 = o; else o1 = o;
        }
        float ss = (o0[0] * o0[0] + o0[1] * o0[1]) + (o0[2] * o0[2] + o0[3] * o0[3]) + (o1[0] * o1[0] + o1[1] * o1[1]) + (o1[2] * o1[2] + o1[3] * o1[3]);
#pragma unroll
        for (int of = 32; of >= 1; of >>= 1) ss += __shfl_xor(ss, of);
        const float r = rsqrtf(ss * (1.f / 512.f) + 1e-6f);
        { const int c0 = h * 64 + ks * 4, c1 = 256 + h * 64 + ks * 4; const f32x4 ga = *(const f32x4*)(ng + c0), gb = *(const f32x4*)(ng + c1);
          const f32x4 a = o0 * r * ga, bb = o1 * r * gb; u32x2 w;
          w.x = pk2(a[0], a[1]); w.y = pk2(a[2], a[3]); *(u32x2*)(mixed + tq * DM + 512 + c0) = w;
          w.x = pk2(bb[0], bb[1]); w.y = pk2(bb[2], bb[3]); *(u32x2*)(mixed + tq * DM + 512 + c1) = w; }
    }
    __syncthreads();
}
template <int PCM> __device__ __forceinline__ void mixer_phase_c(const Params& p, int l, float* lds) {
    for (int it = blockIdx.x; it < 5632; it += gridDim.x) {
        if (it < 512) { if (PCM & 1) nsa_item(p, l, it, lds); }
        else if (it < 2560) { if (PCM & 2) hg_out_item(p, l, it - 512, lds); }
        else if (it < 3584) { if (PCM & 4) ssd_out_item(p, l, it - 2560, lds); }
        else { if (PCM & 8) ret_out_item(p, l, it - 3584, lds); }
    }
}
constexpr int NPHASE = 1 + 12 * NLAYER;
template <int PHM> __global__ void __launch_bounds__(NTHREADS, 2) mega_fwd(Params p) {
    extern __shared__ __attribute__((aligned(16))) unsigned char lds_raw[];
    float* ldsf = (float*)lds_raw; LAS unsigned char* ldsl = (LAS unsigned char*)lds_raw;
    bf16_t* XB = (bf16_t*)(p.ws + WS_XB); bf16_t* HIN = (bf16_t*)(p.ws + WS_HIN);
    for (int ph = p.ph_lo; ph < p.ph_hi; ++ph) {
        if (ph == 0 && (PHM & 1)) { cvt_x(p); cvt_ffn(p, 0, 0, ldsf); cvt_mix(p, 0, ldsf); }
        else {
            const int l = (ph - 1) / 12, s = (ph - 1) % 12;
            if ((s == 0 || s == 9) && (PHM & 2)) {
                pg8::Gemm g{XB, (const bf16_t*)(p.ws + WS_WA), NTOK, 11264, DM}; pg8::StaticOrder S; S.init(NTOK, 11264, (int)gridDim.x, (int)blockIdx.x);
                EpiUp E{HIN}; pg8::gemm_phase<EpiUp, pg8::StaticOrder>(ldsl, g, S, E, nullptr);
            } else if ((s == 1 || s == 10 || s == 7) && (PHM & 4)) {
                const bool mix = (s == 7);
                pg8::Gemm g{mix ? XB : HIN, (const bf16_t*)(p.ws + (mix ? WS_WD : WS_WB)), NTOK, DM, mix ? DM : DFF}; pg8::StaticOrder S; S.init(NTOK, DM, (int)gridDim.x, (int)blockIdx.x);
                EpiRes E{(l == 0 && s == 1) ? p.in[0] : p.out, p.out, ALPHA, mix ? 1.0f : 0.5f}; pg8::gemm_phase<EpiRes, pg8::StaticOrder>(ldsl, g, S, E, nullptr);
            } else if (s == 3 && (PHM & 8)) {
                pg8::Gemm g{XB, (const bf16_t*)(p.ws + WS_WC), NTOK, DINP, DM}; pg8::StaticOrder S; S.init(NTOK, DINP, (int)gridDim.x, (int)blockIdx.x);
                pg8::EpiBf16<0> E{HIN, DINP, nullptr, 0, 0}; pg8::gemm_phase<pg8::EpiBf16<0>, pg8::StaticOrder>(ldsl, g, S, E, nullptr);
            } else if (s == 2 && (PHM & 16)) { ln_rows(p.out, XB, p.in[1] + l * DM, p.in[2] + l * DM); cvt_ffn(p, l, 1, ldsf); }
            else if (s == 8 && (PHM & 16)) { ln_rows(p.out, XB, p.in[6] + l * DM, p.in[7] + l * DM); }
            else if (s == 11 && (PHM & 16)) { ln_rows(p.out, XB, p.in[26] + l * DM, p.in[27] + l * DM); if (l + 1 < NLAYER) { cvt_ffn(p, l + 1, 0, ldsf); cvt_mix(p, l + 1, ldsf); } }
            else if (s == 4 && (PHM & 32)) mixer_phase_a(p, l, ldsf);
            else if (s == 5 && (PHM & 64)) scan_phase(p);
            else if (s == 6 && (PHM & 384)) mixer_phase_c<((PHM & 128) ? 1 : 0) | ((PHM & 256) ? 14 : 0)>(p, l, ldsf);
        }
        if (ph + 1 < p.ph_hi) cg::this_grid().sync();
    }
}

#ifndef MULTI_LAUNCH
#define MULTI_LAUNCH 1
#endif
static int phase_mask(int ph) { if (ph == 0) return 1; const int s = (ph - 1) % 12; return (s == 0 || s == 9) ? 2 : (s == 1 || s == 10 || s == 7) ? 4 : s == 3 ? 8 : (s == 2 || s == 8 || s == 11) ? 16 : s == 4 ? 32 : s == 5 ? 64 : 128; }
template <int M> static bool setup_one(int* per_cu) {
    if (hipFuncSetAttribute((const void*)mega_fwd<M>, hipFuncAttributeMaxDynamicSharedMemorySize, LDS_BYTES) != hipSuccess) return false;
    int pc = 0; if (hipOccupancyMaxActiveBlocksPerMultiprocessor(&pc, (const void*)mega_fwd<M>, NTHREADS, LDS_BYTES) != hipSuccess) pc = 0; *per_cu = pc; return true;
}
extern "C" void kernel_launch(void* const* d_in, const int* in_sizes, int n_in, void* d_out, int out_size, void* d_ws, size_t ws_size, hipStream_t stream) {
    static int grid = 0;
    if (grid == 0) {
        if (n_in != 31 || out_size != NTOK * DM || ws_size < WS_END) { fprintf(stderr, "kernel_launch: unexpected shapes: n_in %d out %d ws %zu (need %zu)\n", n_in, out_size, ws_size, (size_t)WS_END); grid = -1; return; }
        int dev = 0, cus = 0, per_cu = 0; bool ok = true;
        (void)hipGetDevice(&dev); (void)hipDeviceGetAttribute(&cus, hipDeviceAttributeMultiprocessorCount, dev);
#if MULTI_LAUNCH
        ok = setup_one<1>(&per_cu) && setup_one<2>(&per_cu) && setup_one<4>(&per_cu) && setup_one<8>(&per_cu) && setup_one<16>(&per_cu) && setup_one<32>(&per_cu) && setup_one<64>(&per_cu) && setup_one<128>(&per_cu) && setup_one<256>(&per_cu);
#else
        ok = setup_one<511>(&per_cu);
#endif
        (void)hipGetLastError();
        if (!ok) { fprintf(stderr, "kernel_launch: hipFuncSetAttribute failed\n"); grid = -1; return; }
        grid = cus;
        fprintf(stderr, "kernel_launch: grid %d (cus %d, per_cu %d)\n", grid, cus, per_cu);
    }
    if (grid < 0) return;
    Params p{};
    for (int i = 0; i < 31; ++i) p.in[i] = (const float*)d_in[i];
    p.out = (float*)d_out; p.ws = (unsigned char*)d_ws;
#if MULTI_LAUNCH
    for (int ph = 0; ph < NPHASE; ++ph) { p.ph_lo = ph; p.ph_hi = ph + 1;
        switch (phase_mask(ph)) {
            case 1: hipLaunchKernelGGL(mega_fwd<1>, dim3(grid), dim3(NTHREADS), LDS_BYTES, stream, p); break;
            case 2: hipLaunchKernelGGL(mega_fwd<2>, dim3(grid), dim3(NTHREADS), LDS_BYTES, stream, p); break;
            case 4: hipLaunchKernelGGL(mega_fwd<4>, dim3(grid), dim3(NTHREADS), LDS_BYTES, stream, p); break;
            case 8: hipLaunchKernelGGL(mega_fwd<8>, dim3(grid), dim3(NTHREADS), LDS_BYTES, stream, p); break;
            case 16: hipLaunchKernelGGL(mega_fwd<16>, dim3(grid), dim3(NTHREADS), LDS_BYTES, stream, p); break;
            case 32: hipLaunchKernelGGL(mega_fwd<32>, dim3(grid), dim3(NTHREADS), LDS_BYTES, stream, p); break;
            case 64: hipLaunchKernelGGL(mega_fwd<64>, dim3(grid), dim3(NTHREADS), LDS_BYTES, stream, p); break;
            default: hipLaunchKernelGGL(mega_fwd<128>, dim3(grid), dim3(NTHREADS), LDS_BYTES, stream, p); hipLaunchKernelGGL(mega_fwd<256>, dim3(grid), dim3(NTHREADS), LDS_BYTES, stream, p); break;
        }
    }
#else
    p.ph_lo = 0; p.ph_hi = NPHASE;
    void* args[] = {&p};
    hipError_t e = hipLaunchCooperativeKernel((const void*)mega_fwd<511>, dim3(grid), dim3(NTHREADS), args, LDS_BYTES, stream);
    if (e != hipSuccess) fprintf(stderr, "kernel_launch: cooperative launch failed: %s (grid %d)\n", hipGetErrorString(e), grid);
#endif
}
```

```cpp
#include <hip/hip_runtime.h>
#include <hip/hip_cooperative_groups.h>
#include <cstdio>
namespace cg = cooperative_groups;
__device__ __forceinline__ int otid() { int t = (int)threadIdx.x; asm volatile("" : "+v"(t)); return t; }
__device__ __forceinline__ int obid() { int t = (int)blockIdx.x; asm volatile("" : "+s"(t)); return t; }
template <int CTRL> __device__ __forceinline__ float dppf(float v) { return __int_as_float(__builtin_amdgcn_mov_dpp(__float_as_int(v), CTRL, 0xf, 0xf, true)); }
template <int CTRL> __device__ __forceinline__ unsigned dppu(unsigned v) { return (unsigned)__builtin_amdgcn_mov_dpp((int)v, CTRL, 0xf, 0xf, true); }
template <int CTRL> __device__ __forceinline__ unsigned long long dppu64(unsigned long long v) { return ((unsigned long long)dppu<CTRL>((unsigned)(v >> 32)) << 32) | dppu<CTRL>((unsigned)v); }
template <int K> __device__ __forceinline__ int sxi(int v) {
    if constexpr (K < 32) return __builtin_amdgcn_ds_swizzle(v, (K << 10) | 0x1f);
    else return __builtin_amdgcn_ds_bpermute(((otid() & 63) ^ 32) << 2, v);
}
template <int K> __device__ __forceinline__ float sxf(float v) { return __int_as_float(sxi<K>(__float_as_int(v))); }
__device__ __forceinline__ float wave_sum(float v) { v += sxf<1>(v); v += sxf<2>(v); v += sxf<4>(v); v += sxf<8>(v); v += sxf<16>(v); v += sxf<32>(v); return v; }
template <int K> __device__ __forceinline__ unsigned long long sxu64(unsigned long long v) { const unsigned lo = (unsigned)sxi<K>((int)(unsigned)v), hi = (unsigned)sxi<K>((int)(unsigned)(v >> 32)); return ((unsigned long long)hi << 32) | lo; }
__device__ __forceinline__ unsigned long long wave_max_u64(unsigned long long b) { unsigned long long o;
    o = dppu64<0xB1>(b); b = o > b ? o : b; o = dppu64<0x4E>(b); b = o > b ? o : b; o = dppu64<0x141>(b); b = o > b ? o : b; o = dppu64<0x140>(b); b = o > b ? o : b; o = sxu64<16>(b); b = o > b ? o : b; o = sxu64<32>(b); b = o > b ? o : b; return b; }
__device__ __forceinline__ float wave_maxf(float v) { v = fmaxf(v, dppf<0xB1>(v)); v = fmaxf(v, dppf<0x4E>(v)); v = fmaxf(v, dppf<0x141>(v)); v = fmaxf(v, dppf<0x140>(v)); v = fmaxf(v, sxf<16>(v)); v = fmaxf(v, sxf<32>(v)); return v; }
__device__ __forceinline__ void lds_addf(float* p, float v) { __hip_atomic_fetch_add((__attribute__((address_space(3))) float*)p, v, __ATOMIC_RELAXED, __HIP_MEMORY_SCOPE_WORKGROUP); }
__device__ __forceinline__ void lds_or64(unsigned long long* p, unsigned long long v) { __hip_atomic_fetch_or((__attribute__((address_space(3))) unsigned long long*)p, v, __ATOMIC_RELAXED, __HIP_MEMORY_SCOPE_WORKGROUP); }
namespace pg8 {
#define PG8_LAS __attribute__((address_space(3)))
typedef unsigned short bf16_t;
typedef short bf16x8 __attribute__((ext_vector_type(8)));
typedef float f32x4 __attribute__((ext_vector_type(4)));
typedef unsigned u32x4 __attribute__((ext_vector_type(4)));
constexpr int BM = 256, BK = 64, HALF = 128, HTB = HALF * BK * 2  , STAGE_BYTES = 8 * HTB, NXCD = 8, WGM = 8;

__host__ __device__ __forceinline__ int lds_byte(int r, int c) { const int st = (r >> 4) * 2 + (c >> 5), rr = r & 15, cc = c & 31, ob = rr * 64 + cc * 2; return st * 1024 + (ob ^ (((ob >> 9) & 1) << 5)); }
__host__ __device__ __forceinline__ void stage_rc(int b, int& R, int& C) { const int st = b / 1024, sb = b % 1024, swz = sb ^ (((sb >> 9) & 1) << 5); R = (st >> 1) * 16 + swz / 64; C = (st & 1) * 32 + (swz % 64) / 2; }
__host__ __device__ __forceinline__ int perm32(int rho) { const int n = rho >> 4, i = rho & 15; return 8 * (i >> 2) + 4 * n + (i & 3); }

struct Unit { int pm, pn; };
struct Gemm { const bf16_t* A; const bf16_t* Bt; int M, N, K; };

struct StaticOrder {
    int nM, nN, nwg, G, c;
    __host__ __device__ void init(int M, int N, int G_, int c_) { nM = M / BM; nN = N / BM; nwg = nM * nN; G = G_; c = c_; }
    __host__ __device__ bool next(int i, Unit& u) const {
        const long L = (long)i * G + c; if (L >= nwg) return false;
        int wgid = (int)L; { const int q = nwg / NXCD, r = nwg % NXCD, xcd = wgid % NXCD, off = wgid / NXCD; wgid = (xcd < r ? xcd * (q + 1) : r * (q + 1) + (xcd - r) * q) + off; }
        const int nig = WGM * nN, gid = wgid / nig, fm = gid * WGM, gsz = (nM - fm) < WGM ? (nM - fm) : WGM;
        u.pm = fm + ((wgid % nig) % gsz); u.pn = (wgid % nig) / gsz; return true;
    }
    __device__ __forceinline__ void a_ready(const Unit&) const {}
    __device__ __forceinline__ void done(const Unit&) const {}
};
struct CountedOrder : StaticOrder {
    const unsigned* ready; unsigned need; unsigned* tmo;
    __device__ __forceinline__ void a_ready(const Unit& u) const {
        if (threadIdx.x < 64) {
            const unsigned long long t0 = __builtin_amdgcn_s_memrealtime(); unsigned polls = 0;
            while ((unsigned)__builtin_amdgcn_readfirstlane(__hip_atomic_load(ready + 64 * u.pm, __ATOMIC_RELAXED, __HIP_MEMORY_SCOPE_AGENT)) < need) {
                if ((++polls & 255u) == 0u && __builtin_amdgcn_readfirstlane(__hip_atomic_load(tmo, __ATOMIC_RELAXED, __HIP_MEMORY_SCOPE_AGENT)) != 0u) break;
                if (__builtin_amdgcn_s_memrealtime() - t0 > 2000000ull) {
                    if (threadIdx.x == 0) { unsigned expect = 0u; __hip_atomic_compare_exchange_strong(tmo + 1, &expect, 0x600u | (unsigned)(u.pm & 0xff), __ATOMIC_RELAXED, __ATOMIC_RELAXED, __HIP_MEMORY_SCOPE_AGENT); __hip_atomic_store(tmo, 1u, __ATOMIC_RELAXED, __HIP_MEMORY_SCOPE_AGENT); }
                    break; }
                __builtin_amdgcn_s_sleep(2); }
            __builtin_amdgcn_fence(__ATOMIC_ACQUIRE, "agent");
            asm volatile("s_waitcnt vmcnt(0)" ::: "memory");
        }
#if !defined(BROKEN_HOOK_NO_BARRIER)
        asm volatile("" ::: "memory"); __builtin_amdgcn_s_barrier(); asm volatile("" ::: "memory");
#endif
    }
};

__device__ __forceinline__ unsigned cvt_pk_bf16(float lo, float hi) { unsigned r; asm volatile("v_cvt_pk_bf16_f32 %0, %1, %2" : "=v"(r) : "v"(lo), "v"(hi)); return r; }
typedef float f32x2 __attribute__((ext_vector_type(2)));
__device__ __forceinline__ f32x2 gelu_pk(f32x2 v) {
    const f32x2 av = __builtin_elementwise_abs(v), d = av * 0.2316418882f + 1.0f;
    f32x2 t; t.x = __builtin_amdgcn_rcpf(d.x); t.y = __builtin_amdgcn_rcpf(d.y);
    f32x2 q = t * 0.5307027145f + (-0.7265760135f); q = q * t + 0.7107068705f; q = q * t + (-0.142248368f); q = q * t + 0.127414796f; q = q * t;
    const f32x2 s = (v * v) * (-0.72134752044f);
    f32x2 e; e.x = __builtin_amdgcn_exp2f(s.x); e.y = __builtin_amdgcn_exp2f(s.y);
    const f32x2 m = v * (q * e), r = v - m;
    f32x2 o; o.x = v.x < 0.f ? m.x : r.x; o.y = v.y < 0.f ? m.y : r.y; return o;
}

struct EpiF32 {
    static constexpr bool PERM = false, AFTER_DRAIN = false;
    float* C; int ldc; const float* bias;
    __device__ __forceinline__ void operator()(const f32x4 (&acc)[2][2][4][2], const Unit& u, int wr, int wc, int fr, int fq) const {
        const int row0 = u.pm * BM + wr * 64 + fr, col0 = u.pn * BM + wc * 32 + 4 * fq;
        f32x4 bv[2][2];
#pragma unroll
        for (int bj = 0; bj < 2; ++bj)
#pragma unroll
            for (int n = 0; n < 2; ++n) bv[bj][n] = bias ? *(const f32x4*)(bias + col0 + bj * HALF + n * 16) : (f32x4){0.f, 0.f, 0.f, 0.f};
#pragma unroll
        for (int ai = 0; ai < 2; ++ai)
#pragma unroll
            for (int m = 0; m < 4; ++m) { float* rowp = C + (size_t)(row0 + ai * HALF + m * 16) * ldc + col0;
#pragma unroll
                for (int bj = 0; bj < 2; ++bj)
#pragma unroll
                    for (int n = 0; n < 2; ++n) *(f32x4*)(rowp + bj * HALF + n * 16) = acc[ai][bj][m][n] + bv[bj][n]; }
    }
};
template <int ACT  > struct EpiBf16 {
    static constexpr bool PERM = true, AFTER_DRAIN = false;
    bf16_t* O; int ldc; const float* bias; int split_cols; size_t split_stride;
    __device__ __forceinline__ void operator()(const f32x4 (&acc)[2][2][4][2], const Unit& u, int wr, int wc, int fr, int fq) const {
        const int row0 = u.pm * BM + wr * 64 + fr; int colt = u.pn * BM; bf16_t* base = O;
        if (split_cols) { const int t = colt / split_cols; base += (size_t)t * split_stride; colt -= t * split_cols; }
        const int col0 = colt + wc * 32 + 8 * fq, bcol0 = u.pn * BM + wc * 32 + 8 * fq;
        f32x4 bv[2][2];
#pragma unroll
        for (int bj = 0; bj < 2; ++bj)
#pragma unroll
            for (int n = 0; n < 2; ++n) bv[bj][n] = bias ? *(const f32x4*)(bias + bcol0 + bj * HALF + 4 * n) : (f32x4){0.f, 0.f, 0.f, 0.f};
#pragma unroll
        for (int ai = 0; ai < 2; ++ai)
#pragma unroll
            for (int m = 0; m < 4; ++m) { bf16_t* rowp = base + (size_t)(row0 + ai * HALF + m * 16) * ldc + col0;
#pragma unroll
                for (int bj = 0; bj < 2; ++bj) { f32x4 v0 = acc[ai][bj][m][0] + bv[bj][0], v1 = acc[ai][bj][m][1] + bv[bj][1];
                    if (ACT == 1) { f32x2 a = gelu_pk((f32x2){v0[0], v0[1]}), b = gelu_pk((f32x2){v0[2], v0[3]}), c = gelu_pk((f32x2){v1[0], v1[1]}), d = gelu_pk((f32x2){v1[2], v1[3]});
                        v0 = (f32x4){a.x, a.y, b.x, b.y}; v1 = (f32x4){c.x, c.y, d.x, d.y}; }
                    if (ACT == 2) {
#pragma unroll
                        for (int j = 0; j < 4; ++j) { v0[j] = 0.5f * v0[j] * (1.0f + erff(v0[j] * 0.70710678f)); v1[j] = 0.5f * v1[j] * (1.0f + erff(v1[j] * 0.70710678f)); } }
                    u32x4 w; w.x = cvt_pk_bf16(v0[0], v0[1]); w.y = cvt_pk_bf16(v0[2], v0[3]); w.z = cvt_pk_bf16(v1[0], v1[1]); w.w = cvt_pk_bf16(v1[2], v1[3]);
                    *(u32x4*)(rowp + bj * HALF) = w; } }
    }
};
template <class Epi, class Sched, bool STAMP = false>
__device__ __forceinline__ void gemm_phase(PG8_LAS unsigned char* lds, const Gemm g, const Sched& S, const Epi& E, unsigned long long* stamps) {
    const int tid = otid(), wid = __builtin_amdgcn_readfirstlane(tid >> 6), lane = tid & 63, wr = wid >> 2, wc = wid & 3, fr = lane & 15, fq = lane >> 4;
    const int K = g.K, nt = K / BK;
    int ts_lo = 0, ts_hi = 0, nts = 0; const unsigned long long rt_entry = STAMP ? (unsigned long long)wall_clock64() : 0ull;
#define PG8_STAMP() do { if (STAMP && wid == 0 && nts < 64) { const unsigned long long _c = (unsigned long long)clock64(); \
        ts_lo = (lane == nts) ? (int)(unsigned)_c : ts_lo; ts_hi = (lane == nts) ? (int)(unsigned)(_c >> 32) : ts_hi; ++nts; } } while (0)
    PG8_STAMP();
    unsigned voffA[2], voffB[2];
#pragma unroll
    for (int i = 0; i < 2; ++i) { int R, C; stage_rc(tid * 16 + i * 8192, R, C); const int Rb = Epi::PERM ? ((R & ~31) + perm32(R & 31)) : R;
        voffA[i] = (unsigned)(R * K + C) * 2u; voffB[i] = (unsigned)(Rb * K + C) * 2u; }
    const size_t kstep = (size_t)(BK * 2);
    const size_t hstep = (size_t)HALF * K * 2;
    const size_t tstep = 2 * hstep;
    const unsigned ldsw = (unsigned)wid * 1024u;
    const int aoff = lds_byte(wr * 64 + fr, fq * 8), boff = lds_byte(wc * 32 + fr, fq * 8);
#define PG8_SA(b, h) (((b) * 2 + (h)) * HTB)
#define PG8_SB(b, h) ((4 + (b) * 2 + (h)) * HTB)
#define PG8_STAGE(bufoff, gbase, voff) do { _Pragma("unroll") for (int _i = 0; _i < 2; ++_i) \
        __builtin_amdgcn_global_load_lds((const unsigned*)((const char*)(gbase) + (voff)[_i]), (PG8_LAS unsigned*)(lds + (bufoff) + ldsw + _i * 8192), 16, 0, 0); } while (0)
#define PG8_LDA(dst, b, h) do { _Pragma("unroll") for (int m = 0; m < 4; ++m) _Pragma("unroll") for (int k = 0; k < 2; ++k) dst[m][k] = *(const PG8_LAS bf16x8*)(lds + PG8_SA(b, h) + aoff + m * 2048 + k * 1024); } while (0)
#define PG8_LDB(dst, b, h) do { _Pragma("unroll") for (int n = 0; n < 2; ++n) _Pragma("unroll") for (int k = 0; k < 2; ++k) dst[n][k] = *(const PG8_LAS bf16x8*)(lds + PG8_SB(b, h) + boff + n * 2048 + k * 1024); } while (0)
#define PG8_MMA(ai, bj, At, Bt) do { __builtin_amdgcn_s_setprio(1); _Pragma("unroll") for (int m = 0; m < 4; ++m) _Pragma("unroll") for (int n = 0; n < 2; ++n) _Pragma("unroll") for (int k = 0; k < 2; ++k) \
        acc[ai][bj][m][n] = __builtin_amdgcn_mfma_f32_16x16x32_bf16(Bt[n][k], At[m][k], acc[ai][bj][m][n], 0, 0, 0); __builtin_amdgcn_s_setprio(0); } while (0)
#define PG8_WAIT_V(n) asm volatile("s_waitcnt vmcnt(" #n ")" ::: "memory")
#define PG8_WAIT_L(n) asm volatile("s_waitcnt lgkmcnt(" #n ")" ::: "memory")
#define PG8_BAR __builtin_amdgcn_s_barrier()
#define PG8_SCHED __builtin_amdgcn_sched_barrier(0)
    Unit cur, nxt; int ui = 0;
    if (!S.next(0, cur)) return;
    f32x4 acc[2][2][4][2];
#pragma unroll
    for (int a = 0; a < 2; ++a)
#pragma unroll
        for (int b = 0; b < 2; ++b)
#pragma unroll
            for (int m = 0; m < 4; ++m)
#pragma unroll
                for (int n = 0; n < 2; ++n) acc[a][b][m][n] = (f32x4){0.f, 0.f, 0.f, 0.f};
    bf16x8 At[4][2], B0[2][2], B1[2][2];
    const char* cA = (const char*)g.A + (size_t)cur.pm * tstep; const char* cB = (const char*)g.Bt + (size_t)cur.pn * tstep;
    S.a_ready(cur);
    PG8_STAGE(PG8_SB(0, 0), cB, voffB); PG8_STAGE(PG8_SA(0, 0), cA, voffA); PG8_STAGE(PG8_SB(0, 1), cB + hstep, voffB); PG8_STAGE(PG8_SA(0, 1), cA + hstep, voffA);
    if (wr == 1) PG8_BAR;
    PG8_WAIT_V(4); PG8_BAR;
    PG8_STAGE(PG8_SB(1, 0), cB + kstep, voffB); PG8_STAGE(PG8_SA(1, 0), cA + kstep, voffA); PG8_STAGE(PG8_SB(1, 1), cB + hstep + kstep, voffB);
    PG8_WAIT_V(6); PG8_BAR;
    PG8_STAMP();
    for (;;) {
        const bool has_next = S.next(ui + 1, nxt);
        const char* nA = has_next ? (const char*)g.A + (size_t)nxt.pm * tstep : cA; const char* nB = has_next ? (const char*)g.Bt + (size_t)nxt.pn * tstep : cB;
        for (int t = 0; t < nt; t += 2) {
            const bool last = (t == nt - 2);
            const char* a1 = cA + (size_t)(t + 1) * kstep;
            const char* a2 = last ? nA : cA + (size_t)(t + 2) * kstep; const char* b2 = last ? nB : cB + (size_t)(t + 2) * kstep;
            const char* a3 = a2 + kstep; const char* b3 = b2 + kstep;
            if (last && has_next) S.a_ready(nxt);
            PG8_LDB(B0, 0, 0); PG8_SCHED; PG8_LDA(At, 0, 0); PG8_STAGE(PG8_SA(1, 1), a1 + hstep, voffA);
            PG8_WAIT_L(8); PG8_BAR; PG8_WAIT_L(0); PG8_MMA(0, 0, At, B0); PG8_BAR; PG8_SCHED;
            PG8_LDB(B1, 0, 1); PG8_STAGE(PG8_SB(0, 0), b2, voffB);
            PG8_BAR; PG8_WAIT_L(0); PG8_MMA(0, 1, At, B1); PG8_BAR;
            PG8_LDA(At, 0, 1); PG8_STAGE(PG8_SA(0, 0), a2, voffA);
            PG8_BAR; PG8_WAIT_L(0); PG8_MMA(1, 0, At, B0); PG8_BAR; PG8_SCHED;
            PG8_STAGE(PG8_SB(0, 1), b2 + hstep, voffB);
            PG8_WAIT_V(6); PG8_BAR; PG8_MMA(1, 1, At, B1); PG8_BAR;
            PG8_LDB(B0, 1, 0); PG8_SCHED; PG8_LDA(At, 1, 0); PG8_STAGE(PG8_SA(0, 1), a2 + hstep, voffA);
            PG8_WAIT_L(8); PG8_BAR; PG8_WAIT_L(0); PG8_MMA(0, 0, At, B0); PG8_BAR; PG8_SCHED;
            PG8_LDB(B1, 1, 1); PG8_STAGE(PG8_SB(1, 0), b3, voffB);
            PG8_BAR; PG8_WAIT_L(0); PG8_MMA(0, 1, At, B1); PG8_BAR;
            PG8_LDA(At, 1, 1); PG8_STAGE(PG8_SA(1, 0), a3, voffA);
            PG8_BAR; PG8_WAIT_L(0); PG8_MMA(1, 0, At, B0); PG8_BAR; PG8_SCHED;
            PG8_STAGE(PG8_SB(1, 1), b3 + hstep, voffB);
            PG8_WAIT_V(6); PG8_BAR; PG8_MMA(1, 1, At, B1); PG8_BAR;
        }
        PG8_STAMP();
        if constexpr (!Epi::AFTER_DRAIN) { E(acc, cur, wr, wc, fr, fq); S.done(cur); }
        PG8_STAMP();
        if (!has_next) break;
#pragma unroll
        for (int a = 0; a < 2; ++a)
#pragma unroll
            for (int b = 0; b < 2; ++b)
#pragma unroll
                for (int m = 0; m < 4; ++m)
#pragma unroll
                    for (int n = 0; n < 2; ++n) acc[a][b][m][n] = (f32x4){0.f, 0.f, 0.f, 0.f};
        cur = nxt; cA = nA; cB = nB; ++ui;
    }
    PG8_WAIT_V(0);
    if (wr == 0) PG8_BAR;
    PG8_BAR;
    if constexpr (Epi::AFTER_DRAIN) { E.fused(acc, cur, wr, wc, fr, fq, lds, wid, lane); S.done(cur); }
    PG8_STAMP();
    if (STAMP && wid == 0) { stamps[lane] = lane < nts ? (((unsigned long long)(unsigned)ts_hi << 32) | (unsigned)ts_lo) : 0ull;
        if (lane == 62) stamps[62] = rt_entry; if (lane == 63) stamps[63] = (unsigned long long)wall_clock64(); }
#undef PG8_STAMP
#undef PG8_SA
#undef PG8_SB
#undef PG8_STAGE
#undef PG8_LDA
#undef PG8_LDB
#undef PG8_MMA
#undef PG8_WAIT_V
#undef PG8_WAIT_L
#undef PG8_BAR
#undef PG8_SCHED
}
}
typedef unsigned short bf16_t;
typedef float f32x4 __attribute__((ext_vector_type(4)));
typedef unsigned u32x4 __attribute__((ext_vector_type(4)));
typedef unsigned u32x2 __attribute__((ext_vector_type(2)));
typedef short bf16x8 __attribute__((ext_vector_type(8)));
#define MFMA16(a, b, c) __builtin_amdgcn_mfma_f32_16x16x32_bf16((a), (b), (c), 0, 0, 0)
#define LAS __attribute__((address_space(3)))

constexpr int SEQ = 16384, NBATCH = 2, NTOK = 32768, DM = 2048, DFF = 5632, DIN = 6944, DINP = 7168, NLAYER = 2;
constexpr int C_HQ = 0, C_HF = 512, C_HI = 1024, C_HG = 1536, C_NQ = 2048, C_NKC = 2560, C_NVC = 2688, C_NKS = 2816, C_NVS = 2944,
              C_NKW = 3072, C_NVW = 3200, C_NGATE = 3328, C_SZ = 3352, C_SXBC = 3864, C_SDT = 4888, C_RQ = 4896, C_RK = 5408, C_RV = 5920, C_RG = 6432;
constexpr float ALPHA = 1.41421356237f;
constexpr int LDS_BYTES = 147456;
constexpr int NTHREADS = 512;

constexpr size_t WS_WA = 0;
constexpr size_t WS_WB = WS_WA + (size_t)11264 * 2048 * 2;
constexpr size_t WS_WC = WS_WB + (size_t)2048 * 5632 * 2;
constexpr size_t WS_WD = WS_WC + (size_t)7168 * 2048 * 2;
constexpr size_t WS_XB = WS_WD + (size_t)2048 * 2048 * 2;
constexpr size_t WS_HIN = WS_XB + (size_t)NTOK * 2048 * 2;
constexpr size_t WS_STH = WS_HIN + (size_t)NTOK * DINP * 2;
constexpr size_t WS_STS = WS_STH + (size_t)2048 * 16384 * 2;
constexpr size_t WS_STR = WS_STS + (size_t)4096 * 8192 * 2;
constexpr size_t WS_DECH = WS_STR + (size_t)2048 * 16384 * 2;
constexpr size_t WS_DECS = WS_DECH + (size_t)2048 * 128 * 4;
constexpr size_t WS_KCMP = WS_DECS + (size_t)4096 * 4;
constexpr size_t WS_VCMP = WS_KCMP + (size_t)4 * 1024 * 64 * 4;
constexpr size_t WS_VST = WS_VCMP + (size_t)4 * 1024 * 64 * 4;
constexpr size_t WS_VWT = WS_VST + (size_t)4 * 256 * 4096 * 2;
constexpr size_t WS_KCB = WS_VWT + (size_t)4 * 256 * 4096 * 2;
constexpr size_t WS_VCT = WS_KCB + (size_t)4 * 1024 * 64 * 2;
constexpr size_t WS_XBC = WS_VCT + (size_t)4 * 16 * 4096 * 2;
constexpr size_t WS_KNORM = WS_XBC + (size_t)NTOK * 1024 * 2;
constexpr size_t WS_BAR = WS_KNORM + (size_t)4 * 256 * 4;
constexpr size_t WS_W1T = WS_BAR + 256;
constexpr size_t WS_END = WS_W1T + (size_t)4 * 256 * 2048 * 2;

struct Params {
    const float* in[31];
    float* out;
    unsigned char* ws;
    int ph_lo, ph_hi;
};

__shared__ unsigned long long g_ptab[40];
__device__ __forceinline__ unsigned long long ptab_get(int k) { const unsigned long long v = *(volatile LAS unsigned long long*)((LAS unsigned long long*)g_ptab + k);
    unsigned lo = __builtin_amdgcn_readfirstlane((unsigned)v), hi = __builtin_amdgcn_readfirstlane((unsigned)(v >> 32)); asm volatile("" : "+s"(lo), "+s"(hi)); return ((unsigned long long)hi << 32) | lo; }
#define GAS __attribute__((address_space(1)))
__device__ __forceinline__ const float* pin(int k) { return (const float*)(GAS const float*)ptab_get(k); }
__device__ __forceinline__ float* pout() { return (float*)(GAS float*)ptab_get(31); }
__device__ __forceinline__ unsigned char* pws() { return (unsigned char*)(GAS unsigned char*)ptab_get(32); }
__device__ __forceinline__ float bf2f(bf16_t v) { return __uint_as_float(((unsigned)v) << 16); }
__device__ __forceinline__ float bflo(unsigned w) { return __uint_as_float(w << 16); }
__device__ __forceinline__ float bfhi(unsigned w) { return __uint_as_float(w & 0xffff0000u); }
__device__ __forceinline__ unsigned pk2(float lo, float hi) { return pg8::cvt_pk_bf16(lo, hi); }
__device__ __forceinline__ void ld8(const bf16_t* p, float (&x)[8]) { const u32x4 w = *(const u32x4*)p; x[0] = bflo(w.x); x[1] = bfhi(w.x); x[2] = bflo(w.y); x[3] = bfhi(w.y); x[4] = bflo(w.z); x[5] = bfhi(w.z); x[6] = bflo(w.w); x[7] = bfhi(w.w); }
__device__ __forceinline__ void st8(float* p, const float (&x)[8]) { *(f32x4*)p = (f32x4){x[0], x[1], x[2], x[3]}; *(f32x4*)(p + 4) = (f32x4){x[4], x[5], x[6], x[7]}; }
__device__ __forceinline__ void ldf8(const float* p, float (&x)[8]) { const f32x4 a = *(const f32x4*)p, b = *(const f32x4*)(p + 4); x[0] = a[0]; x[1] = a[1]; x[2] = a[2]; x[3] = a[3]; x[4] = b[0]; x[5] = b[1]; x[6] = b[2]; x[7] = b[3]; }
__device__ __forceinline__ float siluf(float x) { return x * __builtin_amdgcn_rcpf(1.f + __expf(-x)); }
__device__ __forceinline__ float sigmf(float x) { return __builtin_amdgcn_rcpf(1.f + __expf(-x)); }
__device__ __forceinline__ float softplusf(float x) { const float e = __expf(-fabsf(x)); const float l1 = e < 0.01f ? e * (1.f - e * (0.5f - e * (1.f / 3.f))) : __logf(1.f + e); return fmaxf(x, 0.f) + l1; }

__device__ __forceinline__ void cvt_tile(const float* s0, const float* s1, bf16_t* dstp, int K, int N, int mode, int tile, float* tl) {
    const int nkb = K >> 6; const int rb = tile / nkb, kb = tile - rb * nkb;
    const int r0 = rb * 128; const float* src = s0; int col0 = r0;
    if (mode == 1) { const int pn = r0 >> 8, bj = (r0 >> 7) & 1; src = bj ? s1 : s0; col0 = pn * 128; }
    const int tid = otid();
    { const int n = tid & 127, k0 = tid >> 7; const bool ok = (col0 + n) < N; const float* sp = src + (size_t)(kb * 64 + k0) * N + col0 + n;
#pragma unroll
      for (int i = 0; i < 16; ++i) tl[(k0 + 4 * i) * 129 + n] = ok ? sp[(size_t)(4 * i) * N] : 0.f; }
    __syncthreads();
    { const int k8 = (tid & 7) * 8;
#pragma unroll
      for (int i = 0; i < 2; ++i) { const int n = (tid >> 3) + 64 * i; const float* c = tl + k8 * 129 + n;
          u32x4 w; w.x = pk2(c[0], c[129]); w.y = pk2(c[2 * 129], c[3 * 129]); w.z = pk2(c[4 * 129], c[5 * 129]); w.w = pk2(c[6 * 129], c[7 * 129]);
          *(u32x4*)(dstp + (size_t)(r0 + n) * K + kb * 64 + k8) = w; } }
    __syncthreads();
}
__device__ void cvt_ffn(const Params& p, int l, int which  , float* tl) {
    const float* w1 = pin(which ? 28 : 3) + (size_t)l * DM * DFF; const float* w3 = pin(which ? 29 : 4) + (size_t)l * DM * DFF; const float* w2 = pin(which ? 30 : 5) + (size_t)l * DFF * DM;
    constexpr int n0 = (11264 / 128) * (DM / 64), n1 = (DM / 128) * (DFF / 64);
    for (int g = obid(); g < n0 + n1; g += gridDim.x) { const bool f = g < n0;
        cvt_tile(f ? w1 : w2, w3, (bf16_t*)(pws() + (f ? WS_WA : WS_WB)), f ? DM : DFF, f ? DFF : DM, f ? 1 : 0, f ? g : g - n0, tl); }
}
__device__ void cvt_mix(const Params& p, int l, float* tl) {
    constexpr int n0 = (DINP / 128) * (DM / 64), n1 = (DM / 128) * (DM / 64);
    for (int g = obid(); g < n0 + n1; g += gridDim.x) { const bool f = g < n0;
        cvt_tile(f ? pin(8) + (size_t)l * DM * DIN : pin(9) + (size_t)l * DM * DM, nullptr, (bf16_t*)(pws() + (f ? WS_WC : WS_WD)), DM, f ? DIN : DM, 0, f ? g : g - n0, tl); }
}
__device__ void cvt_w1t(const Params& p, float* tl) {
    for (int g = obid(); g < 256; g += gridDim.x) { const int job = g >> 6, l = job >> 1, which = job & 1;
        cvt_tile(pin(which ? 16 : 13) + (size_t)l * 2048 * 256, nullptr, (bf16_t*)(pws() + WS_W1T) + (size_t)job * 256 * 2048, 2048, 256, 0, g & 63, tl); }
}
__device__ void cvt_x(const Params& p) {
    const f32x4* x = (const f32x4*)pin(0); u32x2* xb = (u32x2*)(pws() + WS_XB);
    for (size_t i = (size_t)obid() * NTHREADS + otid(); i < (size_t)NTOK * DM / 4; i += (size_t)gridDim.x * NTHREADS) {
        const f32x4 v = x[i]; u32x2 w; w.x = pk2(v[0], v[1]); w.y = pk2(v[2], v[3]); xb[i] = w; }
}

struct EpiUp {
    static constexpr bool PERM = true, AFTER_DRAIN = false;
    bf16_t* H;
    __device__ __forceinline__ void operator()(const pg8::f32x4 (&acc)[2][2][4][2], const pg8::Unit& u, int wr, int wc, int fr, int fq) const {
        const int row0 = u.pm * 256 + wr * 64 + fr, col0 = u.pn * 128 + wc * 32 + 8 * fq;
#pragma unroll
        for (int ai = 0; ai < 2; ++ai)
#pragma unroll
            for (int m = 0; m < 4; ++m) { bf16_t* rowp = H + (size_t)(row0 + ai * 128 + m * 16) * DFF + col0;
                const pg8::f32x4 a0 = acc[ai][0][m][0], a1 = acc[ai][0][m][1], b0 = acc[ai][1][m][0], b1 = acc[ai][1][m][1];
                float v0[4], v1[4];
#pragma unroll
                for (int j = 0; j < 4; ++j) { v0[j] = siluf(a0[j]) * b0[j]; v1[j] = siluf(a1[j]) * b1[j]; }
                pg8::u32x4 w; w.x = pk2(v0[0], v0[1]); w.y = pk2(v0[2], v0[3]); w.z = pk2(v1[0], v1[1]); w.w = pk2(v1[2], v1[3]);
                *(pg8::u32x4*)rowp = w; }
    }
};
struct EpiRes {
    static constexpr bool PERM = false, AFTER_DRAIN = false;
    const float* res32; const bf16_t* res16; float* out; float alpha, scale;
    __device__ __forceinline__ void operator()(const pg8::f32x4 (&acc)[2][2][4][2], const pg8::Unit& u, int wr, int wc, int fr, int fq) const {
        const int row0 = u.pm * 256 + wr * 64 + fr, col0 = u.pn * 256 + wc * 32 + 4 * fq;
#pragma unroll
        for (int ai = 0; ai < 2; ++ai)
#pragma unroll
            for (int m = 0; m < 4; ++m) { const size_t off = (size_t)(row0 + ai * 128 + m * 16) * DM + col0;
#pragma unroll
                for (int bj = 0; bj < 2; ++bj)
#pragma unroll
                    for (int n = 0; n < 2; ++n) { pg8::f32x4 r;
                        if (res32) r = *(const pg8::f32x4*)(res32 + off + bj * 128 + n * 16);
                        else { const u32x2 w = *(const u32x2*)(res16 + off + bj * 128 + n * 16); r = (pg8::f32x4){bflo(w.x), bfhi(w.x), bflo(w.y), bfhi(w.y)}; }
                        *(pg8::f32x4*)(out + off + bj * 128 + n * 16) = r * alpha + acc[ai][bj][m][n] * scale; } }
    }
};

__device__ void ln_rows(float* X, bf16_t* xb, const float* g, const float* b, bool write_f32) {
    const int wid = otid() >> 6, lane = otid() & 63;
    for (int row = obid() * 8 + wid; row < NTOK; row += gridDim.x * 8) {
        float* xr = X + (size_t)row * DM; f32x4 v[8]; float s = 0.f;
#pragma unroll
        for (int i = 0; i < 8; ++i) { v[i] = *(const f32x4*)(xr + i * 256 + lane * 4); s += (v[i][0] + v[i][1]) + (v[i][2] + v[i][3]); }
        s = wave_sum(s);
        const float mean = s * (1.f / DM); float q = 0.f;
#pragma unroll
        for (int i = 0; i < 8; ++i) { const f32x4 d = v[i] - mean; q += (d[0] * d[0] + d[1] * d[1]) + (d[2] * d[2] + d[3] * d[3]); }
        q = wave_sum(q);
        const float rstd = rsqrtf(q * (1.f / DM) + 1e-5f);
#pragma unroll
        for (int i = 0; i < 8; ++i) { const int c = i * 256 + lane * 4; const f32x4 gg = *(const f32x4*)(g + c), bb = *(const f32x4*)(b + c);
            const f32x4 o = (v[i] - mean) * rstd * gg + bb; if (write_f32) *(f32x4*)(xr + c) = o;
            u32x2 w; w.x = pk2(o[0], o[1]); w.y = pk2(o[2], o[3]); *(u32x2*)(xb + (size_t)row * DM + c) = w; }
    }
}
#ifndef AREP
#define AREP 0
#endif
#ifndef CREP
#define CREP 0
#endif
constexpr int LP = 132;
__device__ __forceinline__ float hg_lb(const float* lg, int l, int idx) {
    if (l == 0) return 0.f; const float a0 = lg[idx], a1 = lg[512 + idx]; return 1.f / (1.f + __expf(a0 - a1));
}
__device__ __forceinline__ void hg_lb8(const float* lg, int l, int idx, float (&lb)[8]) {
    if (l == 0) {
#pragma unroll
        for (int k = 0; k < 8; ++k) lb[k] = 0.f;
    } else { float a0[8], a1[8]; ldf8(lg + idx, a0); ldf8(lg + 512 + idx, a1);
#pragma unroll
        for (int k = 0; k < 8; ++k) lb[k] = __builtin_amdgcn_rcpf(1.f + __expf(a0[k] - a1[k])); }
}
template <int DV> __device__ __forceinline__ void state_mm(const float* KD, const float* VV, bf16_t* dst) {
    const int tid = otid(), td = tid >> 4, tv = tid & 15;
    constexpr int NV = DV / 64;
    f32x4 acc[4][NV];
#pragma unroll
    for (int a = 0; a < 4; ++a)
#pragma unroll
        for (int n = 0; n < NV; ++n) acc[a][n] = (f32x4){0.f, 0.f, 0.f, 0.f};
    for (int j = 0; j < 64; ++j) {
        f32x4 v[NV];
#pragma unroll
        for (int n = 0; n < NV; ++n) v[n] = *(const f32x4*)(VV + j * LP + n * 64 + tv * 4);
#pragma unroll
        for (int a = 0; a < 4; ++a) { const float kd = KD[j * LP + td + 32 * a];
#pragma unroll
            for (int n = 0; n < NV; ++n) acc[a][n] += v[n] * kd; }
    }
#pragma unroll
    for (int a = 0; a < 4; ++a)
#pragma unroll
        for (int n = 0; n < NV; ++n) { u32x2 w; w.x = pk2(acc[a][n][0], acc[a][n][1]); w.y = pk2(acc[a][n][2], acc[a][n][3]);
            *(u32x2*)(dst + (size_t)(td + 32 * a) * DV + n * 64 + tv * 4) = w; }
}
__device__ __forceinline__ float ssd_act(const bf16_t* xbc, int b, int s, int ch) { return bf2f(xbc[((size_t)b * SEQ + s) * 1024 + ch]); }
__device__ void conv_prepass(const Params& p, int l) {
    const int tid = otid(), cg8 = (tid & 127) * 8, slot = tid >> 7;
    const bf16_t* hin = (const bf16_t*)(pws() + WS_HIN); bf16_t* xbc = (bf16_t*)(pws() + WS_XBC); const float* cw = pin(20) + l * 4096; const float* cb = pin(21) + l * 1024;
    float w[4][8], bias[8];
#pragma unroll
    for (int c = 0; c < 8; ++c) { bias[c] = cb[cg8 + c];
#pragma unroll
        for (int t = 0; t < 4; ++t) w[t][c] = cw[t * 1024 + cg8 + c]; }
    for (int tok = obid() * 4 + slot; tok < NTOK; tok += gridDim.x * 4) {
        const int s = tok & (SEQ - 1); float acc[8];
#pragma unroll
        for (int c = 0; c < 8; ++c) acc[c] = bias[c];
#pragma unroll
        for (int t = 0; t < 4; ++t) { if (s - 3 + t >= 0) { const u32x4 x = *(const u32x4*)(hin + (size_t)(tok - 3 + t) * DINP + C_SXBC + cg8);
            acc[0] += w[t][0] * bflo(x.x); acc[1] += w[t][1] * bfhi(x.x); acc[2] += w[t][2] * bflo(x.y); acc[3] += w[t][3] * bfhi(x.y);
            acc[4] += w[t][4] * bflo(x.z); acc[5] += w[t][5] * bfhi(x.z); acc[6] += w[t][6] * bflo(x.w); acc[7] += w[t][7] * bfhi(x.w); } }
        u32x4 o; o.x = pk2(siluf(acc[0]), siluf(acc[1])); o.y = pk2(siluf(acc[2]), siluf(acc[3])); o.z = pk2(siluf(acc[4]), siluf(acc[5])); o.w = pk2(siluf(acc[6]), siluf(acc[7]));
        *(u32x4*)(xbc + (size_t)tok * 1024 + cg8) = o;
    }
}
__device__ __forceinline__ void load_rotary(const bf16_t* hin, size_t t0, int pos0, int col0, float scale, float* dst, const float* theta) {
    const int tid = otid();
#pragma unroll
    for (int i = 0; i < 2; ++i) { const int e = tid + 512 * i; const int j = e >> 4, p0 = (e & 15) * 4;
        float x[8], y[8]; ld8(hin + (t0 + j) * DINP + col0 + 2 * p0, x);
#pragma unroll
        for (int k = 0; k < 4; ++k) { const float ang = (float)(pos0 + j) * theta[p0 + k];
            const float n = rintf(ang * 0.15915494309189535f); float r = fmaf(-n, 6.28125f, ang); r = fmaf(-n, 1.9353071795864769e-3f, r);
            const float sn = __sinf(r), cs = __cosf(r);
            y[2 * k] = (x[2 * k] * cs - x[2 * k + 1] * sn) * scale; y[2 * k + 1] = (x[2 * k] * sn + x[2 * k + 1] * cs) * scale; }
        st8(dst + j * LP + 2 * p0, y); }
}
__device__ __forceinline__ void fill_theta(float* theta) { if (otid() < 64) theta[otid()] = exp2f(-(float)otid() * (13.287712379549449f / 63.0f)); }

__device__ void hg_state_item(const Params& p, int l, int item, float* lds) {
    const int c = item & 255, h = (item >> 8) & 3, b = item >> 10; const int tid = otid();
    const bf16_t* hin = (const bf16_t*)(pws() + WS_HIN); const size_t t0 = (size_t)b * SEQ + c * 64;
    float* KD = lds; float* VV = lds + 64 * LP; float* BB = lds + 2 * 64 * LP; const float* lbl = pin(10);
#pragma unroll
    for (int i = 0; i < 2; ++i) { const int e = tid + 512 * i, j = e >> 4, d0 = (e & 15) * 8;
        float z[8], v[8], lb[8], bb[8], kk[8]; ld8(hin + (t0 + j) * DINP + C_HF + h * 128 + d0, z); ld8(hin + (t0 + j) * DINP + C_HI + h * 128 + d0, v); hg_lb8(lbl, l, h * 128 + d0, lb);
#pragma unroll
        for (int k = 0; k < 8; ++k) { const float sn = __builtin_amdgcn_rcpf(1.f + __expf(z[k])), sg = 1.f - sn; bb[k] = __logf(lb[k] + (1.f - lb[k]) * sg); kk[k] = (1.f - lb[k]) * sn; }
        st8(BB + j * LP + d0, bb); st8(KD + j * LP + d0, kk); st8(VV + j * LP + d0, v); }
    __syncthreads();
    if (tid < 128) { float a = 0.f; for (int j = 0; j < 64; ++j) { a += BB[j * LP + tid]; BB[j * LP + tid] = a; } }
    __syncthreads();
#pragma unroll
    for (int i = 0; i < 2; ++i) { const int e = tid + 512 * i, j = e >> 4, d0 = (e & 15) * 8; float kk[8], bj[8], bl[8]; ldf8(KD + j * LP + d0, kk); ldf8(BB + j * LP + d0, bj); ldf8(BB + 63 * LP + d0, bl);
#pragma unroll
        for (int k = 0; k < 8; ++k) kk[k] *= __expf(bl[k] - bj[k]);
        st8(KD + j * LP + d0, kk); }
    if (tid < 128) ((float*)(pws() + WS_DECH))[(size_t)item * 128 + tid] = __expf(BB[63 * LP + tid]);
    __syncthreads();
    state_mm<128>(KD, VV, (bf16_t*)(pws() + WS_STH) + (size_t)item * 16384);
    __syncthreads();
}
__device__ void ssd_state_item(const Params& p, int l, int item, float* lds) {
    const int c = item & 255, h = (item >> 8) & 7, b = item >> 11, g = h >> 2; const int tid = otid();
    const bf16_t* hin = (const bf16_t*)(pws() + WS_HIN); const size_t t0 = (size_t)b * SEQ + c * 64;
    const bf16_t* xbc = (const bf16_t*)(pws() + WS_XBC);
    float* KD = lds; float* VV = lds + 64 * LP; float* AUX = lds + 2 * 64 * LP;
    if (tid < 64) { const float dtv = softplusf(bf2f(hin[(t0 + tid) * DINP + C_SDT + h]) + pin(22)[l * 8 + h]);
        AUX[tid] = dtv; AUX[64 + tid] = -dtv * __expf(pin(23)[l * 8 + h]); }
    __syncthreads();
    if (tid < 64) { float a = 0.f; for (int j = 0; j <= tid; ++j) a += AUX[64 + j]; AUX[128 + tid] = a; }
    __syncthreads();
    const float cl = AUX[128 + 63];
#pragma unroll
    for (int i = 0; i < 2; ++i) { const int e = tid + 512 * i, j = e >> 4, n0 = (e & 15) * 8; float x[8]; ld8(xbc + ((size_t)b * SEQ + c * 64 + j) * 1024 + 512 + g * 128 + n0, x); const float f = __expf(cl - AUX[128 + j]);
#pragma unroll
        for (int k = 0; k < 8; ++k) x[k] *= f;
        st8(KD + j * LP + n0, x); }
    { const int j = tid >> 3, pc0 = (tid & 7) * 8; float x[8]; ld8(xbc + ((size_t)b * SEQ + c * 64 + j) * 1024 + h * 64 + pc0, x); const float f = AUX[j];
#pragma unroll
      for (int k = 0; k < 8; ++k) x[k] *= f;
      st8(VV + j * LP + pc0, x); }
    if (tid == 0) ((float*)(pws() + WS_DECS))[item] = __expf(cl);
    __syncthreads();
    state_mm<64>(KD, VV, (bf16_t*)(pws() + WS_STS) + (size_t)item * 8192);
    __syncthreads();
}
__device__ __forceinline__ float ret_lg(int h) { return __logf(1.f - exp2f(-5.f - (float)h)); }
__device__ void ret_state_item(const Params& p, int l, int item, float* lds) {
    const int c = item & 255, h = (item >> 8) & 3, b = item >> 10; const int tid = otid();
    const bf16_t* hin = (const bf16_t*)(pws() + WS_HIN); const size_t t0 = (size_t)b * SEQ + c * 64;
    float* KD = lds; float* VV = lds + 64 * LP; float* TH = lds + 2 * 64 * LP;
    fill_theta(TH);
    __syncthreads();
    load_rotary(hin, t0, c * 64, C_RK + h * 128, 0.08838834764831845f, KD, TH);
#pragma unroll
    for (int i = 0; i < 2; ++i) { const int e = tid + 512 * i, j = e >> 4, d0 = (e & 15) * 8; float v[8]; ld8(hin + (t0 + j) * DINP + C_RV + h * 128 + d0, v); st8(VV + j * LP + d0, v); }
    __syncthreads();
    const float lg = ret_lg(h);
#pragma unroll 4
    for (int i = 0; i < 16; ++i) { const int e = tid + 512 * i, j = e >> 7, d = e & 127; KD[j * LP + d] *= __expf(lg * (float)(63 - j)); }
    __syncthreads();
    state_mm<128>(KD, VV, (bf16_t*)(pws() + WS_STR) + (size_t)item * 16384);
    __syncthreads();
}
__device__ void cmp_item(const Params& p, int l, int item, float* lds) {
    const int mb = item & 63, kv = (item >> 6) & 1, b = (item >> 7) & 1, which = item >> 8; const int tid = otid();
    const bf16_t* hin = (const bf16_t*)(pws() + WS_HIN);
    const float* pe = pin(which ? 15 : 12) + l * 2048; const float* w2 = pin(which ? 17 : 14) + l * 256 * 64;
    float* dst = (float*)(pws() + (which ? WS_VCMP : WS_KCMP)) + (size_t)(b * 2 + kv) * 1024 * 64;
    const int colx = (which ? C_NVC : C_NKC) + kv * 64;
    bf16_t* AF = (bf16_t*)lds; float* HID = lds + 16448;
    const bf16_t* w1t = (const bf16_t*)(pws() + WS_W1T) + (size_t)((l * 2 + which) * 256) * 2048;
    const int tok0 = mb * 256;
#pragma unroll 2
    for (int i = 0; i < 8; ++i) { const int e = tid + 512 * i, r = e >> 8, rem = e & 255, pos = rem >> 3, d8 = (rem & 7) * 8; const int s = tok0 + 16 * r + pos;
        float x[8], pe8[8]; ldf8(pe + pos * 64 + d8, pe8);
        if (s < SEQ) ld8(hin + ((size_t)b * SEQ + s) * DINP + colx + d8, x); else {
#pragma unroll
            for (int k = 0; k < 8; ++k) x[k] = 0.f; }
        u32x4 w; w.x = pk2(x[0] + pe8[0], x[1] + pe8[1]); w.y = pk2(x[2] + pe8[2], x[3] + pe8[3]); w.z = pk2(x[4] + pe8[4], x[5] + pe8[5]); w.w = pk2(x[6] + pe8[6], x[7] + pe8[7]);
        *(u32x4*)(AF + r * 2056 + pos * 64 + d8) = w; }
    __syncthreads();
    { const int wid = tid >> 6, lane = tid & 63, fr = lane & 15, fq = lane >> 4;
      f32x4 acc0 = (f32x4){0.f, 0.f, 0.f, 0.f}, acc1 = acc0;
      const bf16_t* bp0 = w1t + (size_t)((2 * wid) * 16 + fr) * 2048 + fq * 8; const bf16_t* bp1 = bp0 + 16 * 2048; const bf16_t* ap = AF + fr * 2056 + fq * 8;
#pragma unroll 8
      for (int ks = 0; ks < 64; ++ks) { const bf16x8 av = *(const bf16x8*)(ap + ks * 32), b0 = *(const bf16x8*)(bp0 + ks * 32), b1 = *(const bf16x8*)(bp1 + ks * 32);
          acc0 = MFMA16(av, b0, acc0); acc1 = MFMA16(av, b1, acc1); }
#pragma unroll
      for (int j = 0; j < 4; ++j) { HID[(fq * 4 + j) * 256 + (2 * wid) * 16 + fr] = siluf(acc0[j]); HID[(fq * 4 + j) * 256 + (2 * wid + 1) * 16 + fr] = siluf(acc1[j]); } }
    __syncthreads();
    { const int e = tid & 63, r0 = tid >> 6; float o0 = 0.f, o1 = 0.f;
      for (int nn = 0; nn < 256; ++nn) { const float w = w2[nn * 64 + e]; o0 += HID[r0 * 256 + nn] * w; o1 += HID[(r0 + 8) * 256 + nn] * w; }
      const int m0 = mb * 16 + r0; if (m0 < 1023) dst[(size_t)m0 * 64 + e] = o0; if (m0 + 8 < 1023) dst[(size_t)(m0 + 8) * 64 + e] = o1;
      const float z0 = m0 < 1023 ? o0 : 0.f, z1 = m0 + 8 < 1023 ? o1 : 0.f; const int m1 = m0 + 8;
      if (which == 0) { bf16_t* kb = (bf16_t*)(pws() + WS_KCB) + (size_t)(b * 2 + kv) * 1024 * 64; kb[(size_t)m0 * 64 + e] = (bf16_t)(pk2(z0, 0.f) & 0xffffu); kb[(size_t)m1 * 64 + e] = (bf16_t)(pk2(z1, 0.f) & 0xffffu); }
      else { bf16_t* vt = (bf16_t*)(pws() + WS_VCT) + (size_t)(b * 2 + kv) * 16 * 4096; vt[(size_t)(m0 >> 6) * 4096 + e * 64 + (m0 & 63)] = (bf16_t)(pk2(z0, 0.f) & 0xffffu); vt[(size_t)(m1 >> 6) * 4096 + e * 64 + (m1 & 63)] = (bf16_t)(pk2(z1, 0.f) & 0xffffu); } }
    __syncthreads();
}
__device__ void vtr_item(const Params& p, int item, float* lds) {
    const int blk = item & 255, kv = (item >> 8) & 1, b = (item >> 9) & 1, which = item >> 10; const int tid = otid();
    const bf16_t* hin = (const bf16_t*)(pws() + WS_HIN); bf16_t* T = (bf16_t*)lds;
    { const int key = tid >> 3, d8 = (tid & 7) * 8; const u32x4 w = *(const u32x4*)(hin + ((size_t)b * SEQ + blk * 64 + key) * DINP + (which ? C_NVW : C_NVS) + kv * 64 + d8);
      T[(d8 + 0) * 72 + key] = (bf16_t)(w.x & 0xffffu); T[(d8 + 1) * 72 + key] = (bf16_t)(w.x >> 16); T[(d8 + 2) * 72 + key] = (bf16_t)(w.y & 0xffffu); T[(d8 + 3) * 72 + key] = (bf16_t)(w.y >> 16);
      T[(d8 + 4) * 72 + key] = (bf16_t)(w.z & 0xffffu); T[(d8 + 5) * 72 + key] = (bf16_t)(w.z >> 16); T[(d8 + 6) * 72 + key] = (bf16_t)(w.w & 0xffffu); T[(d8 + 7) * 72 + key] = (bf16_t)(w.w >> 16); }
    if (which == 0) {
        const int key = tid >> 3, d8 = (tid & 7) * 8; const u32x4 w = *(const u32x4*)(hin + ((size_t)b * SEQ + blk * 64 + key) * DINP + C_NKS + kv * 64 + d8);
        float a = (bflo(w.x) * bflo(w.x) + bfhi(w.x) * bfhi(w.x)) + (bflo(w.y) * bflo(w.y) + bfhi(w.y) * bfhi(w.y)) + (bflo(w.z) * bflo(w.z) + bfhi(w.z) * bfhi(w.z)) + (bflo(w.w) * bflo(w.w) + bfhi(w.w) * bfhi(w.w));
        a += dppf<0xB1>(a); a += dppf<0x4E>(a); a += dppf<0x141>(a);
        a = wave_maxf(a);
        if ((tid & 63) == 0) lds[4096 + (tid >> 6)] = a;
    }
    __syncthreads();
    if (which == 0 && tid == 0) { float m = 0.f; for (int w8 = 0; w8 < 8; ++w8) m = fmaxf(m, lds[4096 + w8]); ((float*)(pws() + WS_KNORM))[(b * 2 + kv) * 256 + blk] = sqrtf(m); }
    { const int dv = tid >> 3, k8 = (tid & 7) * 8; bf16_t* dst = (bf16_t*)(pws() + (which ? WS_VWT : WS_VST)) + ((size_t)((b * 2 + kv) * 256 + blk)) * 4096;
      *(u32x4*)(dst + dv * 64 + k8) = *(const u32x4*)(T + dv * 72 + k8); }
    __syncthreads();
}
__device__ void mixer_phase_pre(const Params& p, int l, float* lds) {
    for (int it = obid(); it < 512 + 2048; it += gridDim.x) { if (it < 512) cmp_item(p, l, it, lds); else vtr_item(p, it - 512, lds); }
    conv_prepass(p, l);
}
__device__ void mixer_phase_a(const Params& p, int l, float* lds) {
    for (int it = obid() + 512; it < 8704; it += gridDim.x) {
        if (it < 512) { for (int r = 0; r < 1 + (AREP & 1); ++r) cmp_item(p, l, it, lds); }
        else if (it < 2560) { for (int r = 0; r < 1 + ((AREP >> 1) & 1); ++r) hg_state_item(p, l, it - 512, lds); }
        else if (it < 6656) { for (int r = 0; r < 1 + ((AREP >> 2) & 1); ++r) ssd_state_item(p, l, it - 2560, lds); }
        else { for (int r = 0; r < 1 + ((AREP >> 3) & 1); ++r) ret_state_item(p, l, it - 6656, lds); }
    }
}
__device__ void scan_phase(const Params& p) {
    for (int wt = obid() + (int)gridDim.x * (otid() >> 6); wt < 1536; wt += (int)gridDim.x * 8) {
        const int task = wt * 64 + (otid() & 63);
        const int br = task >> 15, r = task & 32767;
        bf16_t* base; size_t cstride; const float* decp = nullptr; int dstride = 0; float dconst = 0.f;
        if (br == 0) { const int bh = r >> 12, e4 = r & 4095; base = (bf16_t*)(pws() + WS_STH) + (size_t)bh * 256 * 16384 + e4 * 4; cstride = 16384;
            decp = (const float*)(pws() + WS_DECH) + (size_t)bh * 256 * 128 + ((e4 * 4) >> 7); dstride = 128; }
        else if (br == 1) { const int bh = r >> 11, e4 = r & 2047; base = (bf16_t*)(pws() + WS_STS) + (size_t)bh * 256 * 8192 + e4 * 4; cstride = 8192;
            decp = (const float*)(pws() + WS_DECS) + (size_t)bh * 256; dstride = 1; }
        else { const int bh = r >> 12, e4 = r & 4095; base = (bf16_t*)(pws() + WS_STR) + (size_t)bh * 256 * 16384 + e4 * 4; cstride = 16384; dconst = __expf(64.f * ret_lg(bh & 3)); }
        float s0 = 0.f, s1 = 0.f, s2 = 0.f, s3 = 0.f;
#pragma unroll 8
        for (int c = 0; c < 256; ++c) {
            u32x2* ptr = (u32x2*)(base + (size_t)c * cstride); const u32x2 w = *ptr; const float dec = decp ? decp[(size_t)c * dstride] : dconst;
            u32x2 o; o.x = pk2(s0, s1); o.y = pk2(s2, s3); *ptr = o;
            s0 = dec * s0 + bflo(w.x); s1 = dec * s1 + bfhi(w.x); s2 = dec * s2 + bflo(w.y); s3 = dec * s3 + bfhi(w.y);
        }
    }
}
constexpr int AP = 68;
__device__ __forceinline__ void scores_plain(const float* QS, const float* KS, float (&acc)[2][4]) {
    const int tid = otid(), ti = tid >> 4, tj = tid & 15;
#pragma unroll
    for (int a = 0; a < 2; ++a)
#pragma unroll
        for (int jj = 0; jj < 4; ++jj) acc[a][jj] = 0.f;
    for (int d = 0; d < 128; d += 4) {
        f32x4 q[2], k[4];
#pragma unroll
        for (int a = 0; a < 2; ++a) q[a] = *(const f32x4*)(QS + (ti + 32 * a) * LP + d);
#pragma unroll
        for (int jj = 0; jj < 4; ++jj) k[jj] = *(const f32x4*)(KS + (tj + 16 * jj) * LP + d);
#pragma unroll
        for (int a = 0; a < 2; ++a)
#pragma unroll
            for (int jj = 0; jj < 4; ++jj) { if (a == 0 && jj >= 2) continue;
                acc[a][jj] += (q[a][0] * k[jj][0] + q[a][1] * k[jj][1]) + (q[a][2] * k[jj][2] + q[a][3] * k[jj][3]); }
    }
}
__device__ __forceinline__ void scores_hg(const float* QS, const float* KS, const float* BB, float (&acc)[2][4]) {
    const int tid = otid(), ti = tid >> 4, tj = tid & 15;
#pragma unroll
    for (int a = 0; a < 2; ++a)
#pragma unroll
        for (int jj = 0; jj < 4; ++jj) acc[a][jj] = 0.f;
    for (int d = 0; d < 128; d += 4) {
        f32x4 q[2], bi[2], k[4], bj[4];
#pragma unroll
        for (int a = 0; a < 2; ++a) { q[a] = *(const f32x4*)(QS + (ti + 32 * a) * LP + d); bi[a] = *(const f32x4*)(BB + (ti + 32 * a) * LP + d); }
#pragma unroll
        for (int jj = 0; jj < 4; ++jj) { k[jj] = *(const f32x4*)(KS + (tj + 16 * jj) * LP + d); bj[jj] = *(const f32x4*)(BB + (tj + 16 * jj) * LP + d); }
#pragma unroll
        for (int a = 0; a < 2; ++a)
#pragma unroll
            for (int jj = 0; jj < 4; ++jj) { if (a == 0 && jj >= 2) continue;
#pragma unroll
                for (int x = 0; x < 4; ++x) acc[a][jj] += q[a][x] * k[jj][x] * __expf(fminf(bi[a][x] - bj[jj][x], 0.f)); }
    }
}
template <int DV> __device__ __forceinline__ void load_sprev(const bf16_t* src, float* SP) {
    const int tid = otid();
    for (int e = tid; e < 128 * DV / 4; e += 512) { const int d = e / (DV / 4), v4 = e % (DV / 4); const u32x2 w = *(const u32x2*)(src + (size_t)d * DV + v4 * 4);
        *(f32x4*)(SP + d * (DV + 4) + v4 * 4) = (f32x4){bflo(w.x), bfhi(w.x), bflo(w.y), bfhi(w.y)}; }
}
template <int DV, bool VBF> __device__ __forceinline__ void out_mm(const float* AA, const void* VVp, const float* QS, const float* SP, f32x4 (&intra)[2][DV / 64], f32x4 (&inter)[2][DV / 64]) {
    const int tid = otid(), ti = tid >> 4, tv = tid & 15; constexpr int NV = DV / 64;
#pragma unroll
    for (int a = 0; a < 2; ++a)
#pragma unroll
        for (int n = 0; n < NV; ++n) { intra[a][n] = (f32x4){0.f, 0.f, 0.f, 0.f}; inter[a][n] = (f32x4){0.f, 0.f, 0.f, 0.f}; }
    for (int j = 0; j < 64; j += 4) {
        f32x4 a4[2];
#pragma unroll
        for (int a = 0; a < 2; ++a) a4[a] = *(const f32x4*)(AA + (ti + 32 * a) * AP + j);
#pragma unroll
        for (int x = 0; x < 4; ++x)
#pragma unroll
            for (int n = 0; n < NV; ++n) { f32x4 v;
                if (VBF) { const u32x2 w = *(const u32x2*)((const bf16_t*)VVp + (j + x) * 136 + n * 64 + tv * 4); v = (f32x4){bflo(w.x), bfhi(w.x), bflo(w.y), bfhi(w.y)}; }
                else v = *(const f32x4*)((const float*)VVp + (j + x) * AP + n * 64 + tv * 4);
#pragma unroll
                for (int a = 0; a < 2; ++a) intra[a][n] += v * a4[a][x]; }
    }
    for (int d = 0; d < 128; d += 4) {
        f32x4 q4[2];
#pragma unroll
        for (int a = 0; a < 2; ++a) q4[a] = *(const f32x4*)(QS + (ti + 32 * a) * LP + d);
#pragma unroll
        for (int x = 0; x < 4; ++x)
#pragma unroll
            for (int n = 0; n < NV; ++n) { const f32x4 s = *(const f32x4*)(SP + (d + x) * (DV + 4) + n * 64 + tv * 4);
#pragma unroll
                for (int a = 0; a < 2; ++a) inter[a][n] += s * q4[a][x]; }
    }
}
__device__ __forceinline__ float red16(float v) { v += dppf<0xB1>(v); v += dppf<0x4E>(v); v += dppf<0x141>(v); v += dppf<0x140>(v); return v; }
__device__ __forceinline__ float max16(float v) { v = fmaxf(v, dppf<0xB1>(v)); v = fmaxf(v, dppf<0x4E>(v)); v = fmaxf(v, dppf<0x141>(v)); v = fmaxf(v, dppf<0x140>(v)); return v; }

__device__ void hg_out_item(const Params& p, int l, int item, float* lds) {
    const int c = item & 255, h = (item >> 8) & 3, b = item >> 10; const int tid = otid(), ti = tid >> 4, tj = tid & 15;
    const bf16_t* hin = (const bf16_t*)(pws() + WS_HIN); const size_t t0 = (size_t)b * SEQ + c * 64;
    float* QS = lds; float* KS = lds + 64 * LP; float* BB = lds + 2 * 64 * LP; float* AA = lds + 3 * 64 * LP; bf16_t* VV = (bf16_t*)(lds + 3 * 64 * LP + 64 * AP); float* SP = KS; const float* lbl = pin(10);
#pragma unroll
    for (int i = 0; i < 2; ++i) { const int e = tid + 512 * i, j = e >> 4, d0 = (e & 15) * 8;
        float z[8], q[8], lb[8], bb[8], kk[8]; ld8(hin + (t0 + j) * DINP + C_HF + h * 128 + d0, z); ld8(hin + (t0 + j) * DINP + C_HQ + h * 128 + d0, q); hg_lb8(lbl, l, h * 128 + d0, lb);
#pragma unroll
        for (int k = 0; k < 8; ++k) { const float sn = __builtin_amdgcn_rcpf(1.f + __expf(z[k])), sg = 1.f - sn; bb[k] = __logf(lb[k] + (1.f - lb[k]) * sg); kk[k] = (1.f - lb[k]) * sn; q[k] = siluf(q[k]); }
        st8(BB + j * LP + d0, bb); st8(KS + j * LP + d0, kk); st8(QS + j * LP + d0, q);
        *(u32x4*)(VV + j * 136 + d0) = *(const u32x4*)(hin + (t0 + j) * DINP + C_HI + h * 128 + d0); }
    __syncthreads();
    if (tid < 128) { float a = 0.f; for (int j = 0; j < 64; ++j) { a += BB[j * LP + tid]; BB[j * LP + tid] = a; } }
    __syncthreads();
    { float acc[2][4]; scores_hg(QS, KS, BB, acc);
#pragma unroll
      for (int a = 0; a < 2; ++a)
#pragma unroll
          for (int jj = 0; jj < 4; ++jj) { const int i = ti + 32 * a, j = tj + 16 * jj; AA[i * AP + j] = (j <= i) ? acc[a][jj] : 0.f; } }
    __syncthreads();
#pragma unroll 4
    for (int i = 0; i < 16; ++i) { const int e = tid + 512 * i, j = e >> 7, d = e & 127; QS[j * LP + d] *= __expf(BB[j * LP + d]); }
    __syncthreads();
    load_sprev<128>((const bf16_t*)(pws() + WS_STH) + (size_t)item * 16384, SP);
    __syncthreads();
    f32x4 intra[2][2], inter[2][2]; out_mm<128, true>(AA, VV, QS, SP, intra, inter);
    const int tv = tj; const float* ng = pin(11) + l * 512 + h * 128; bf16_t* mixed = (bf16_t*)(pws() + WS_XB);
#pragma unroll
    for (int a = 0; a < 2; ++a) { const int i = ti + 32 * a; f32x4 o[2]; float ss = 0.f;
#pragma unroll
        for (int n = 0; n < 2; ++n) { o[n] = intra[a][n] + inter[a][n]; ss += (o[n][0] * o[n][0] + o[n][1] * o[n][1]) + (o[n][2] * o[n][2] + o[n][3] * o[n][3]); }
        ss = red16(ss); const float r = rsqrtf(ss * (1.f / 128.f) + 1e-6f);
#pragma unroll
        for (int n = 0; n < 2; ++n) { const int v = n * 64 + tv * 4; const u32x2 gw = *(const u32x2*)(hin + (t0 + i) * DINP + C_HG + h * 128 + v); const f32x4 g4 = *(const f32x4*)(ng + v);
            const float r0 = o[n][0] * r * g4[0] * siluf(bflo(gw.x)), r1 = o[n][1] * r * g4[1] * siluf(bfhi(gw.x)), r2 = o[n][2] * r * g4[2] * siluf(bflo(gw.y)), r3 = o[n][3] * r * g4[3] * siluf(bfhi(gw.y));
            u32x2 w; w.x = pk2(r0, r1); w.y = pk2(r2, r3); *(u32x2*)(mixed + (t0 + i) * DM + h * 128 + v) = w; } }
    __syncthreads();
}
__device__ void ret_out_item(const Params& p, int l, int item, float* lds) {
    const int c = item & 255, h = (item >> 8) & 3, b = item >> 10; const int tid = otid(), ti = tid >> 4, tj = tid & 15;
    const bf16_t* hin = (const bf16_t*)(pws() + WS_HIN); const size_t t0 = (size_t)b * SEQ + c * 64;
    float* QS = lds; float* KS = lds + 64 * LP; float* AA = lds + 3 * 64 * LP; bf16_t* VV = (bf16_t*)(lds + 3 * 64 * LP + 64 * AP); float* SP = KS; float* TH = lds + 3 * 64 * LP + 64 * AP + 64 * AP;
    fill_theta(TH);
    __syncthreads();
    load_rotary(hin, t0, c * 64, C_RQ + h * 128, 1.0f, QS, TH);
    load_rotary(hin, t0, c * 64, C_RK + h * 128, 0.08838834764831845f, KS, TH);
#pragma unroll
    for (int i = 0; i < 2; ++i) { const int e = tid + 512 * i, j = e >> 4, d0 = (e & 15) * 8; *(u32x4*)(VV + j * 136 + d0) = *(const u32x4*)(hin + (t0 + j) * DINP + C_RV + h * 128 + d0); }
    __syncthreads();
    const float lg = ret_lg(h);
    { float acc[2][4]; scores_plain(QS, KS, acc);
#pragma unroll
      for (int a = 0; a < 2; ++a)
#pragma unroll
          for (int jj = 0; jj < 4; ++jj) { const int i = ti + 32 * a, j = tj + 16 * jj; AA[i * AP + j] = (j <= i) ? acc[a][jj] * __expf(lg * (float)(i - j)) : 0.f; } }
    __syncthreads();
    load_sprev<128>((const bf16_t*)(pws() + WS_STR) + (size_t)item * 16384, SP);
    __syncthreads();
    f32x4 intra[2][2], inter[2][2]; out_mm<128, true>(AA, VV, QS, SP, intra, inter);
    const int tv = tj; bf16_t* mixed = (bf16_t*)(pws() + WS_XB);
#pragma unroll
    for (int a = 0; a < 2; ++a) { const int i = ti + 32 * a; const float sc = __expf(lg * (float)(i + 1)); f32x4 o[2]; float s = 0.f;
#pragma unroll
        for (int n = 0; n < 2; ++n) { o[n] = intra[a][n] + inter[a][n] * sc; s += (o[n][0] + o[n][1]) + (o[n][2] + o[n][3]); }
        s = red16(s); const float mu = s * (1.f / 128.f); float q = 0.f;
#pragma unroll
        for (int n = 0; n < 2; ++n) { const f32x4 d = o[n] - mu; q += (d[0] * d[0] + d[1] * d[1]) + (d[2] * d[2] + d[3] * d[3]); }
        q = red16(q); const float r = rsqrtf(q * (1.f / 128.f) + 1e-5f);
#pragma unroll
        for (int n = 0; n < 2; ++n) { const int v = n * 64 + tv * 4; const u32x2 gw = *(const u32x2*)(hin + (t0 + i) * DINP + C_RG + h * 128 + v);
            const float r0 = (o[n][0] - mu) * r * siluf(bflo(gw.x)), r1 = (o[n][1] - mu) * r * siluf(bfhi(gw.x)), r2 = (o[n][2] - mu) * r * siluf(bflo(gw.y)), r3 = (o[n][3] - mu) * r * siluf(bfhi(gw.y));
            u32x2 w; w.x = pk2(r0, r1); w.y = pk2(r2, r3); *(u32x2*)(mixed + (t0 + i) * DM + 1536 + h * 128 + v) = w; } }
    __syncthreads();
}
__device__ void ssd_out_item(const Params& p, int l, int item, float* lds) {
    const int c = item & 255, g = (item >> 8) & 1, b = item >> 9; const int tid = otid(), ti = tid >> 4, tj = tid & 15, tv = tj;
    const bf16_t* hin = (const bf16_t*)(pws() + WS_HIN); const size_t t0 = (size_t)b * SEQ + c * 64;
    const bf16_t* xbc = (const bf16_t*)(pws() + WS_XBC);
    float* CM = lds; float* BM = lds + 8448; float* SP = BM; float* G = lds + 17152; float* AH = lds + 21504; float* VV = lds + 25856; float* XS = lds + 30208; float* AUX = lds + 34560;
    if (tid < 256) { const int hh = tid >> 6, j = tid & 63, h = g * 4 + hh; const float dtv = softplusf(bf2f(hin[(t0 + j) * DINP + C_SDT + h]) + pin(22)[l * 8 + h]);
        AUX[hh * 64 + j] = dtv; AUX[512 + hh * 64 + j] = -dtv * __expf(pin(23)[l * 8 + h]); }
#pragma unroll
    for (int i = 0; i < 2; ++i) { const int e = tid + 512 * i, j = e >> 4, n0 = (e & 15) * 8; float x[8];
        ld8(xbc + ((size_t)b * SEQ + c * 64 + j) * 1024 + 768 + g * 128 + n0, x); st8(CM + j * LP + n0, x);
        ld8(xbc + ((size_t)b * SEQ + c * 64 + j) * 1024 + 512 + g * 128 + n0, x); st8(BM + j * LP + n0, x); }
    __syncthreads();
    if (tid < 256) { const int hh = tid >> 6, j = tid & 63; float a = 0.f; for (int jj = 0; jj <= j; ++jj) a += AUX[512 + hh * 64 + jj]; AUX[256 + hh * 64 + j] = a; }
    { float acc[2][4]; scores_plain(CM, BM, acc);
#pragma unroll
      for (int a = 0; a < 2; ++a)
#pragma unroll
          for (int jj = 0; jj < 4; ++jj) G[(ti + 32 * a) * AP + tj + 16 * jj] = acc[a][jj]; }
    __syncthreads();
    float ss[2] = {0.f, 0.f}; bf16_t* mixed = (bf16_t*)(pws() + WS_XB);
#pragma unroll 1
    for (int hh = 0; hh < 4; ++hh) {
        const int h = g * 4 + hh; const float* dt = AUX + hh * 64; const float* cb = AUX + 256 + hh * 64;
#pragma unroll 2
        for (int i = 0; i < 8; ++i) { const int e = tid + 512 * i, ii = e >> 6, j = e & 63; AH[ii * AP + j] = (j <= ii) ? G[ii * AP + j] * __expf(cb[ii] - cb[j]) : 0.f; }
        { const int j = tid >> 3, pc0 = (tid & 7) * 8; float x[8]; ld8(xbc + ((size_t)b * SEQ + c * 64 + j) * 1024 + h * 64 + pc0, x); st8(XS + j * AP + pc0, x); const float f = dt[j];
#pragma unroll
          for (int k = 0; k < 8; ++k) x[k] *= f;
          st8(VV + j * AP + pc0, x); }
        load_sprev<64>((const bf16_t*)(pws() + WS_STS) + (size_t)(((b * 8 + h) << 8) + c) * 8192, SP);
        __syncthreads();
        f32x4 intra[2][1], inter[2][1]; out_mm<64, false>(AH, VV, CM, SP, intra, inter);
        const float dsk = pin(24)[l * 8 + h];
#pragma unroll
        for (int a = 0; a < 2; ++a) { const int i = ti + 32 * a; const f32x4 xs = *(const f32x4*)(XS + i * AP + tv * 4); const u32x2 zw = *(const u32x2*)(hin + (t0 + i) * DINP + C_SZ + h * 64 + tv * 4);
            f32x4 o = intra[a][0] + inter[a][0] * __expf(cb[i]) + xs * dsk;
            o[0] *= siluf(bflo(zw.x)); o[1] *= siluf(bfhi(zw.x)); o[2] *= siluf(bflo(zw.y)); o[3] *= siluf(bfhi(zw.y));
            ss[a] += (o[0] * o[0] + o[1] * o[1]) + (o[2] * o[2] + o[3] * o[3]);
            u32x2 w; w.x = pk2(o[0], o[1]); w.y = pk2(o[2], o[3]); *(u32x2*)(mixed + (t0 + i) * DM + 1024 + g * 256 + hh * 64 + tv * 4) = w; }
        __syncthreads();
    }
    const float* ng = pin(25) + l * 512 + g * 256;
#pragma unroll
    for (int a = 0; a < 2; ++a) { const int i = ti + 32 * a; const float r = rsqrtf(red16(ss[a]) * (1.f / 256.f) + 1e-6f);
#pragma unroll 1
        for (int hh = 0; hh < 4; ++hh) { const f32x4 g4 = *(const f32x4*)(ng + hh * 64 + tv * 4); u32x2* ptr = (u32x2*)(mixed + (t0 + i) * DM + 1024 + g * 256 + hh * 64 + tv * 4); const u32x2 yw = *ptr;
            const f32x4 o = (f32x4){bflo(yw.x), bfhi(yw.x), bflo(yw.y), bfhi(yw.y)} * r * g4;
            u32x2 w; w.x = pk2(o[0], o[1]); w.y = pk2(o[2], o[3]); *ptr = w; } }
    __syncthreads();
}
#ifndef WREP
#define WREP 1
#endif
#ifndef TREP
#define TREP 1
#endif
#ifndef SREP
#define SREP 1
#endif
__device__ __forceinline__ int t5_bucket(int dist) {
    if (dist < 16) return dist;
    const int lg = 16 + (int)(__log2f((float)dist * 0.0625f) * 2.2857142857142856f);
    return lg < 31 ? lg : 31;
}
__device__ __forceinline__ float dot64_bf(const float (&q)[64], const bf16_t* kp) {
    float s0 = 0.f, s1 = 0.f;
#pragma unroll
    for (int i = 0; i < 8; ++i) { const u32x4 w = *(const u32x4*)(kp + i * 8);
        s0 += (q[8 * i + 0] * bflo(w.x) + q[8 * i + 2] * bflo(w.y)) + (q[8 * i + 4] * bflo(w.z) + q[8 * i + 6] * bflo(w.w));
        s1 += (q[8 * i + 1] * bfhi(w.x) + q[8 * i + 3] * bfhi(w.y)) + (q[8 * i + 5] * bfhi(w.z) + q[8 * i + 7] * bfhi(w.w)); }
    return s0 + s1;
}
__device__ __forceinline__ float dot64_f(const float (&q)[64], const float* kp) {
    float s0 = 0.f, s1 = 0.f;
#pragma unroll
    for (int i = 0; i < 16; ++i) { const f32x4 w = *(const f32x4*)(kp + i * 4); s0 += q[4 * i] * w[0] + q[4 * i + 2] * w[2]; s1 += q[4 * i + 1] * w[1] + q[4 * i + 3] * w[3]; }
    return s0 + s1;
}
__device__ __forceinline__ float softmax_row(float* scr, int ks, int n, float mx_local) {
    const float mx = max16(mx_local); float sum = 0.f;
    for (int idx = ks; idx < n; idx += 16) { const float e = __expf(scr[idx] - mx); scr[idx] = e; sum += e; }
    sum = red16(sum);
    return n > 0 ? 1.f / sum : 0.f;
}
constexpr float NEG_BIG = -1.0e30f;
__device__ __forceinline__ bf16_t f2bf(float x) { return (bf16_t)(pk2(x, 0.f) & 0xffffu); }
__device__ __forceinline__ void ld_k(const bf16_t* kbase, int kpitch, int fr, int fq, bf16x8 (&kb)[4][2]) {
#pragma unroll
    for (int nt = 0; nt < 4; ++nt)
#pragma unroll
        for (int ks = 0; ks < 2; ++ks) kb[nt][ks] = *(const bf16x8*)(kbase + (nt * 16 + fr) * kpitch + ks * 32 + fq * 8);
}
__device__ __forceinline__ void ld_v(const bf16_t* vt, int fr, int fq, bf16x8 (&vb)[4][2]) {
#pragma unroll
    for (int nt = 0; nt < 4; ++nt)
#pragma unroll
        for (int ks = 0; ks < 2; ++ks) vb[nt][ks] = *(const bf16x8*)(vt + (nt * 16 + fr) * 64 + ks * 32 + fq * 8);
}
__device__ __forceinline__ void mma_qk(const bf16x8 (&qa)[2][2], const bf16x8 (&kb)[4][2], f32x4 (&s)[2][4]) {
#pragma unroll
    for (int mt = 0; mt < 2; ++mt)
#pragma unroll
        for (int nt = 0; nt < 4; ++nt) { f32x4 c = (f32x4){0.f, 0.f, 0.f, 0.f};
#pragma unroll
            for (int ks = 0; ks < 2; ++ks) c = MFMA16(qa[mt][ks], kb[nt][ks], c);
            s[mt][nt] = c; }
}
__device__ __forceinline__ void mma_pv(const bf16_t* Pl, const bf16x8 (&vb)[4][2], int fr, int fq, f32x4 (&o)[2][4]) {
    bf16x8 pa[2][2];
#pragma unroll
    for (int mt = 0; mt < 2; ++mt)
#pragma unroll
        for (int ks = 0; ks < 2; ++ks) pa[mt][ks] = *(const bf16x8*)(Pl + (mt * 16 + fr) * 72 + ks * 32 + fq * 8);
#pragma unroll
    for (int nt = 0; nt < 4; ++nt)
#pragma unroll
        for (int ks = 0; ks < 2; ++ks)
#pragma unroll
            for (int mt = 0; mt < 2; ++mt) o[mt][nt] = MFMA16(pa[mt][ks], vb[nt][ks], o[mt][nt]);
}
__device__ void nsa_unit(const Params& p, int l, int item, float* ldsf) {
    int b = item >> 8, qt = (item & 7) * 32 + ((item & 255) >> 3); if (b) qt = 255 - qt;
    const int tid = otid(), wid = tid >> 6, lane = tid & 63, fr = lane & 15, fq = lane >> 4;
    unsigned char* wb = (unsigned char*)ldsf + wid * 16384;
    bf16_t* Pl = (bf16_t*)wb; float* IMP = (float*)(wb + 4608); float* OSEL = IMP; float* PS = (float*)(wb + 12928); int* SEL = (int*)(wb + 15104); int* NSEL = (int*)(wb + 15616);
    float* RB = ldsf + 32768; float* LSUM = ldsf + 33024; float* BND = ldsf + 33280; unsigned long long* QM = (unsigned long long*)(ldsf + 33536); const unsigned char* BK = (const unsigned char*)(ldsf + 34048);
    if (tid < 256) RB[tid] = pin(19)[tid];
    { unsigned char* BKw = (unsigned char*)(ldsf + 34048);
#pragma unroll
      for (int k = 0; k < 4; ++k) BKw[tid * 4 + k] = (unsigned char)t5_bucket(tid * 4 + k); }
    __syncthreads();
    const bf16_t* hin = (const bf16_t*)(pws() + WS_HIN); bf16_t* mixed = (bf16_t*)(pws() + WS_XB);
    const int q0 = qt * 64 + wid * 8; const int tb = b * SEQ;
    float ss[2] = {0.f, 0.f};
#pragma unroll 1
    for (int kv = 0; kv < 2; ++kv) {
        if (tid < 256) QM[tid] = (unsigned long long)(unsigned)(tid >> 20);
        bf16x8 qa[2][2];
#pragma unroll
        for (int mt = 0; mt < 2; ++mt)
#pragma unroll
            for (int ks = 0; ks < 2; ++ks) qa[mt][ks] = *(const bf16x8*)(hin + (tb + q0 + mt * 4 + (fr >> 2)) * DINP + C_NQ + (kv * 4 + (fr & 3)) * 64 + ks * 32 + fq * 8);
        f32x4 ofin[2][4];
        {
            f32x4 (&o)[2][4] = ofin; float m[2][4], ls[2][4];
#pragma unroll
            for (int mt = 0; mt < 2; ++mt) {
#pragma unroll
                for (int nt = 0; nt < 4; ++nt) o[mt][nt] = (f32x4){0.f, 0.f, 0.f, 0.f};
#pragma unroll
                for (int j = 0; j < 4; ++j) { m[mt][j] = NEG_BIG; ls[mt][j] = 0.f; } }
            bf16x8 kb[4][2]; ld_k(hin + (tb + (qt >= 8 ? qt - 8 : 0) * 64) * DINP + C_NKW + kv * 64, DINP, fr, fq, kb);
#pragma unroll 1
            for (int kt = (qt >= 8 ? qt - 8 : 0); kt <= qt; ++kt) {
                bf16x8 vb[4][2]; ld_v((const bf16_t*)(pws() + WS_VWT) + ((size_t)((b * 2 + kv) * 256 + kt)) * 4096, fr, fq, vb);
                f32x4 s[2][4]; mma_qk(qa, kb, s);
#pragma unroll
                for (int mt = 0; mt < 2; ++mt) {
                    const int qpos = q0 + mt * 4 + fq; bool ok[4]; float tmax[4] = {NEG_BIG, NEG_BIG, NEG_BIG, NEG_BIG};
#pragma unroll
                    for (int nt = 0; nt < 4; ++nt) { const int dist = qpos - (kt * 64 + nt * 16 + fr); ok[nt] = dist >= 0 && dist < 512;
                        const f32x4 bias = *(const f32x4*)(RB + (int)BK[dist < 0 ? 0 : (dist > 2047 ? 2047 : dist)] * 8 + kv * 4);
#pragma unroll
                        for (int j = 0; j < 4; ++j) { const float v = ok[nt] ? s[mt][nt][j] * 0.125f + bias[j] : NEG_BIG; s[mt][nt][j] = v; tmax[j] = fmaxf(tmax[j], v); } }
#pragma unroll
                    for (int j = 0; j < 4; ++j) { const float mn = fmaxf(m[mt][j], max16(tmax[j])); const float alpha = __expf(m[mt][j] - mn); m[mt][j] = mn; float rs = 0.f;
#pragma unroll
                        for (int nt = 0; nt < 4; ++nt) { const float pe = ok[nt] ? __expf(s[mt][nt][j] - mn) : 0.f; rs += pe; Pl[(mt * 16 + fq * 4 + j) * 72 + nt * 16 + fr] = f2bf(pe); o[mt][nt][j] *= alpha; }
                        ls[mt][j] = ls[mt][j] * alpha + red16(rs); }
                }
                __builtin_amdgcn_wave_barrier();
                if (kt < qt) ld_k(hin + (tb + (kt + 1) * 64) * DINP + C_NKW + kv * 64, DINP, fr, fq, kb);
                mma_pv(Pl, vb, fr, fq, o);
                __builtin_amdgcn_wave_barrier();
            }
#pragma unroll
            for (int mt = 0; mt < 2; ++mt)
#pragma unroll
                for (int j = 0; j < 4; ++j) { const float g2 = sigmf(bf2f(hin[(tb + q0 + mt * 4 + fq) * DINP + C_NGATE + (kv * 4 + j) * 3 + 2])); const float sc = ls[mt][j] > 0.f ? g2 / ls[mt][j] : 0.f;
#pragma unroll
                    for (int nt = 0; nt < 4; ++nt) ofin[mt][nt][j] *= sc; }
        }
        {
            const int nct = (4 * qt + 3 + 63) >> 6;
            const bf16_t* kc = (const bf16_t*)(pws() + WS_KCB) + (size_t)(b * 2 + kv) * 1024 * 64; const bf16_t* vct = (const bf16_t*)(pws() + WS_VCT) + (size_t)(b * 2 + kv) * 16 * 4096;
            float m[2][4], ls[2][4];
#pragma unroll
            for (int mt = 0; mt < 2; ++mt)
#pragma unroll
                for (int j = 0; j < 4; ++j) { m[mt][j] = NEG_BIG; ls[mt][j] = 0.f; }
            for (int e = lane; e < 8 * 260; e += 64) IMP[e] = 0.f;
            bf16x8 kb[4][2]; ld_k(kc, 64, fr, fq, kb);
#pragma unroll 1
            for (int ct = 0; ct < nct; ++ct) {
                f32x4 s[2][4]; mma_qk(qa, kb, s);
                ld_k(kc + (size_t)(ct + 1 < nct ? ct + 1 : 0) * 64 * 64, 64, fr, fq, kb);
#pragma unroll
                for (int mt = 0; mt < 2; ++mt) {
                    const int qpos = q0 + mt * 4 + fq; bool ok[4]; float tmax[4] = {NEG_BIG, NEG_BIG, NEG_BIG, NEG_BIG};
#pragma unroll
                    for (int nt = 0; nt < 4; ++nt) { const int dist = qpos - (16 * (ct * 64 + nt * 16 + fr) + 31); ok[nt] = dist >= 0;
                        const f32x4 bias = *(const f32x4*)(RB + (int)BK[dist < 0 ? 0 : (dist > 2047 ? 2047 : dist)] * 8 + kv * 4);
#pragma unroll
                        for (int j = 0; j < 4; ++j) { const float v = ok[nt] ? s[mt][nt][j] * 0.125f + bias[j] : NEG_BIG; s[mt][nt][j] = v; tmax[j] = fmaxf(tmax[j], v); } }
#pragma unroll
                    for (int j = 0; j < 4; ++j) { const float mn = fmaxf(m[mt][j], max16(tmax[j])); const float alpha = __expf(m[mt][j] - mn); m[mt][j] = mn; float rs = 0.f;
#pragma unroll
                        for (int nt = 0; nt < 4; ++nt) rs += ok[nt] ? __expf(s[mt][nt][j] - mn) : 0.f;
                        ls[mt][j] = ls[mt][j] * alpha + red16(rs); }
                }
            }
            float inv[2][4];
#pragma unroll
            for (int mt = 0; mt < 2; ++mt)
#pragma unroll
                for (int j = 0; j < 4; ++j) inv[mt][j] = ls[mt][j] > 0.f ? 1.f / ls[mt][j] : 0.f;
            float g0[2][4];
#pragma unroll
            for (int mt = 0; mt < 2; ++mt)
#pragma unroll
                for (int j = 0; j < 4; ++j) g0[mt][j] = sigmf(bf2f(hin[(tb + q0 + mt * 4 + fq) * DINP + C_NGATE + (kv * 4 + j) * 3 + 0]));
            __builtin_amdgcn_wave_barrier();
#pragma unroll 1
            for (int ct = 0; ct < nct; ++ct) {
                bf16x8 vb[4][2]; ld_v(vct + (size_t)ct * 4096, fr, fq, vb);
                f32x4 s[2][4]; mma_qk(qa, kb, s);
#pragma unroll
                for (int mt = 0; mt < 2; ++mt) {
                    const int qpos = q0 + mt * 4 + fq;
#pragma unroll
                    for (int nt = 0; nt < 4; ++nt) { const int dist = qpos - (16 * (ct * 64 + nt * 16 + fr) + 31); const bool ok = dist >= 0;
                        const f32x4 bias = *(const f32x4*)(RB + (int)BK[dist < 0 ? 0 : (dist > 2047 ? 2047 : dist)] * 8 + kv * 4); float psum = 0.f;
#pragma unroll
                        for (int j = 0; j < 4; ++j) { const float pe = ok ? __expf(s[mt][nt][j] * 0.125f + bias[j] - m[mt][j]) * inv[mt][j] : 0.f; psum += pe; Pl[(mt * 16 + fq * 4 + j) * 72 + nt * 16 + fr] = f2bf(pe * g0[mt][j]); }
                        PS[(mt * 4 + fq) * 68 + nt * 16 + fr] = psum; }
                }
                __builtin_amdgcn_wave_barrier();
                { const int qi = lane >> 3, l8 = lane & 7; const float* pr = PS + qi * 68; float* ir = IMP + qi * 260 + ct * 16;
#pragma unroll
                  for (int x = 0; x < 2; ++x) { const int jb = l8 + 8 * x; const f32x4 v = *(const f32x4*)(pr + 4 * jb); float a = (v[0] + v[1]) + (v[2] + 0.5f * v[3]); if (jb > 0) a += 0.5f * pr[4 * jb - 1]; ir[jb] += a; }
                  if (l8 == 0) ir[16] += 0.5f * pr[63]; }
                if (ct + 1 < nct) ld_k(kc + (size_t)(ct + 1) * 64 * 64, 64, fr, fq, kb);
                mma_pv(Pl, vb, fr, fq, ofin);
                __builtin_amdgcn_wave_barrier();
            }
        }
        __syncthreads();
        float* QN = PS;
        {
            if (lane < 32) { const bf16_t* qp = hin + (tb + q0 + (lane >> 2)) * DINP + C_NQ + (kv * 4 + (lane & 3)) * 64; float a = 0.f;
#pragma unroll
                for (int i = 0; i < 8; ++i) { const u32x4 w = *(const u32x4*)(qp + i * 8);
                    a += (bflo(w.x) * bflo(w.x) + bfhi(w.x) * bfhi(w.x)) + (bflo(w.y) * bflo(w.y) + bfhi(w.y) * bfhi(w.y)) + (bflo(w.z) * bflo(w.z) + bfhi(w.z) * bfhi(w.z)) + (bflo(w.w) * bflo(w.w) + bfhi(w.w) * bfhi(w.w)); }
                QN[lane] = sqrtf(a); }
            if (lane < 4) { float bm = 0.f; for (int bk = 0; bk < 32; ++bk) bm = fmaxf(bm, fabsf(RB[bk * 8 + kv * 4 + lane])); QN[32 + lane] = bm; }
        }
        __builtin_amdgcn_wave_barrier();
        const float* KN = (const float*)(pws() + WS_KNORM) + (b * 2 + kv) * 256;
#pragma unroll 1
        for (int qi = 0; qi < 8; ++qi) {
            const int qpos = q0 + qi, cur = qpos >> 6; unsigned long long key[4];
#pragma unroll
            for (int jj = 0; jj < 4; ++jj) { const int j = lane + 64 * jj; unsigned long long kk = 0ull;
                if (j <= cur) { const float val = (j == 0 || j == cur || j == cur - 1) ? 5.0f : IMP[qi * 260 + j]; kk = ((unsigned long long)(__float_as_uint(val) + 1u) << 32) | (unsigned)(255 - j); }
                key[jj] = kk; }
            float knmax = 0.f;
            for (int it = 0; it < 16; ++it) {
                unsigned long long best = key[0] > key[1] ? key[0] : key[1]; { const unsigned long long b2 = key[2] > key[3] ? key[2] : key[3]; best = b2 > best ? b2 : best; }
                best = wave_max_u64(best);
                if ((best >> 32) == 0ull) break;
                const int jsel = 255 - (int)(unsigned)(best & 0xffffffffull);
                if (lane == it) { lds_or64(QM + jsel, 1ull << (wid * 8 + qi)); knmax = KN[jsel]; }
#pragma unroll
                for (int jj = 0; jj < 4; ++jj) if (key[jj] == best) key[jj] = 0ull;
            }
            const float bq = wave_maxf(knmax);
            if (lane < 4) BND[(wid * 8 + qi) * 4 + lane] = QN[qi * 4 + lane] * bq * (0.125f * 1.002f) + QN[32 + lane] + 1e-3f;
        }
        __builtin_amdgcn_wave_barrier();
        for (int e = lane; e < 2048; e += 64) OSEL[e] = 0.f;
        if (lane < 32) LSUM[wid * 32 + lane] = 0.f;
        __syncthreads();
#pragma unroll 1
        for (int j = wid; j <= qt; j += 8) {
            unsigned long long mask; { const unsigned long long mv = QM[j]; mask = ((unsigned long long)(unsigned)__builtin_amdgcn_readfirstlane((unsigned)(mv >> 32)) << 32) | (unsigned long long)(unsigned)__builtin_amdgcn_readfirstlane((unsigned)mv); }
            if (mask == 0ull) continue;
            bf16x8 kb[4][2], vb[4][2]; ld_k(hin + (tb + j * 64) * DINP + C_NKS + kv * 64, DINP, fr, fq, kb); ld_v((const bf16_t*)(pws() + WS_VST) + ((size_t)((b * 2 + kv) * 256 + j)) * 4096, fr, fq, vb);
            const bool far = (qt * 64 - (j * 64 + 63)) >= 1536;
#pragma unroll 1
            while (mask != 0ull) {
                int q4[4];
#pragma unroll
                for (int g = 0; g < 4; ++g) { if (mask != 0ull) { q4[g] = __builtin_ctzll(mask); mask &= mask - 1ull; } else q4[g] = -1; }
                const int ga = fr >> 2; const int myq = ga == 0 ? q4[0] : ga == 1 ? q4[1] : ga == 2 ? q4[2] : q4[3];
                const int rq = fq == 0 ? q4[0] : fq == 1 ? q4[1] : fq == 2 ? q4[2] : q4[3];
                bf16x8 qs[2];
#pragma unroll
                for (int ks = 0; ks < 2; ++ks) { qs[ks] = (bf16x8){0, 0, 0, 0, 0, 0, 0, 0}; if (myq >= 0) qs[ks] = *(const bf16x8*)(hin + (tb + qt * 64 + myq) * DINP + C_NQ + (kv * 4 + (fr & 3)) * 64 + ks * 32 + fq * 8); }
                f32x4 s[4];
#pragma unroll
                for (int nt = 0; nt < 4; ++nt) { f32x4 c = (f32x4){0.f, 0.f, 0.f, 0.f};
#pragma unroll
                    for (int ks = 0; ks < 2; ++ks) c = MFMA16(qs[ks], kb[nt][ks], c);
                    s[nt] = c; }
                const f32x4 bnd = *(const f32x4*)(BND + (rq >= 0 ? rq : 0) * 4); const int qpos = qt * 64 + rq; float rs[4] = {0.f, 0.f, 0.f, 0.f};
#pragma unroll
                for (int nt = 0; nt < 4; ++nt) { const int dist = qpos - (j * 64 + nt * 16 + fr); const bool ok = rq >= 0 && dist >= 0;
                    const f32x4 bias = *(const f32x4*)(RB + (far ? 31 : (int)BK[dist < 0 ? 0 : (dist > 2047 ? 2047 : dist)]) * 8 + kv * 4);
#pragma unroll
                    for (int jj = 0; jj < 4; ++jj) { const float pe = ok ? __expf(s[nt][jj] * 0.125f + bias[jj] - bnd[jj]) : 0.f; rs[jj] += pe; Pl[(fq * 4 + jj) * 72 + nt * 16 + fr] = f2bf(pe); } }
#pragma unroll
                for (int jj = 0; jj < 4; ++jj) { const float r = red16(rs[jj]); if (fr == 0 && rq >= 0) lds_addf(LSUM + rq * 4 + jj, r); }
                __builtin_amdgcn_wave_barrier();
                bf16x8 pa[2];
#pragma unroll
                for (int ks = 0; ks < 2; ++ks) pa[ks] = *(const bf16x8*)(Pl + fr * 72 + ks * 32 + fq * 8);
                { float* ob = ldsf + ((rq >= 0 ? rq : 0) >> 3) * 4096 + 1152 + ((rq >= 0 ? rq : 0) & 7) * 256;
#pragma unroll
                    for (int nt = 0; nt < 4; ++nt) { f32x4 c = (f32x4){0.f, 0.f, 0.f, 0.f};
#pragma unroll
                        for (int ks = 0; ks < 2; ++ks) c = MFMA16(pa[ks], vb[nt][ks], c);
                        if (rq >= 0) {
#pragma unroll
                            for (int jj = 0; jj < 4; ++jj) lds_addf(ob + jj * 64 + nt * 16 + fr, c[jj]); } } }
                __builtin_amdgcn_wave_barrier();
            }
        }
        __syncthreads();
#pragma unroll
        for (int mt = 0; mt < 2; ++mt) { const int trow = (tb + q0 + mt * 4 + fq) * DM + 512 + kv * 256;
#pragma unroll
            for (int j = 0; j < 4; ++j) { const float g1 = sigmf(bf2f(hin[(tb + q0 + mt * 4 + fq) * DINP + C_NGATE + (kv * 4 + j) * 3 + 1])); const float lsum = LSUM[(wid * 8 + mt * 4 + fq) * 4 + j]; const float scl = lsum > 0.f ? g1 / lsum : 0.f;
#pragma unroll
                for (int nt = 0; nt < 4; ++nt) { const float v = ofin[mt][nt][j] + OSEL[((mt * 4 + fq) * 4 + j) * 64 + nt * 16 + fr] * scl; ss[mt] += v * v; mixed[trow + j * 64 + nt * 16 + fr] = f2bf(v); } } }
        __syncthreads();
    }
    const float* ng = pin(18) + l * 512;
#pragma unroll
    for (int mt = 0; mt < 2; ++mt) { const float r = rsqrtf(red16(ss[mt]) * (1.f / 512.f) + 1e-6f); const int trow = (tb + q0 + mt * 4 + fq) * DM + 512;
#pragma unroll 4
        for (int c = 0; c < 32; ++c) { const int col = c * 16 + fr; mixed[trow + col] = f2bf(bf2f(mixed[trow + col]) * r * ng[col]); } }
    __syncthreads();
}
#ifndef NSA_REP
#define NSA_REP 1
#endif
template <int PCM> __device__ __forceinline__ void mixer_phase_c(const Params& p, int l, float* lds) {
    for (int it = obid(); it < 5632; it += gridDim.x) {
        if (it < 512) { if (PCM & 1) { for (int rep = 0; rep < NSA_REP; ++rep) nsa_unit(p, l, it, lds); } }
        else if (it < 2560) { if (PCM & 2) { for (int r = 0; r < 1 + (CREP & 1); ++r) hg_out_item(p, l, it - 512, lds); } }
        else if (it < 3584) { if (PCM & 4) { for (int r = 0; r < 1 + ((CREP >> 1) & 1); ++r) ssd_out_item(p, l, it - 2560, lds); } }
        else { if (PCM & 8) { for (int r = 0; r < 1 + ((CREP >> 2) & 1); ++r) ret_out_item(p, l, it - 3584, lds); } }
    }
}
#ifndef REPEAT_MASK
#define REPEAT_MASK 0
#endif
constexpr int NPHASE = 1 + 13 * NLAYER;
__device__ __forceinline__ void grid_bar(unsigned* ctr, unsigned target) {
    asm volatile("s_waitcnt vmcnt(0) lgkmcnt(0)" ::: "memory");
    __syncthreads();
    if (threadIdx.x == 0) {
        __builtin_amdgcn_fence(__ATOMIC_RELEASE, "agent");
        asm volatile("s_waitcnt vmcnt(0)" ::: "memory");
        __hip_atomic_fetch_add(ctr, 1u, __ATOMIC_RELAXED, __HIP_MEMORY_SCOPE_AGENT);
        unsigned spins = 0;
        while (__hip_atomic_load(ctr, __ATOMIC_RELAXED, __HIP_MEMORY_SCOPE_AGENT) < target) { __builtin_amdgcn_s_sleep(2); if (++spins > (1u << 22)) break; }
        __builtin_amdgcn_fence(__ATOMIC_ACQUIRE, "agent");
        asm volatile("s_waitcnt vmcnt(0)" ::: "memory");
    }
    __syncthreads();
}
template <int PHM> __global__ void __launch_bounds__(NTHREADS, 2) mega_fwd(Params p) {
    extern __shared__ __attribute__((aligned(16))) unsigned char lds_raw[];
    if (threadIdx.x == 0) {
#pragma unroll
        for (int k = 0; k < 31; ++k) g_ptab[k] = (unsigned long long)p.in[k];
        g_ptab[31] = (unsigned long long)p.out; g_ptab[32] = (unsigned long long)p.ws; }
    __syncthreads();
    float* ldsf = (float*)lds_raw; LAS unsigned char* ldsl = (LAS unsigned char*)lds_raw;
        unsigned nbar = 0;
    for (int ph = p.ph_lo; ph < p.ph_hi; ++ph) {
        if (ph == 0 && (PHM & 1)) { cvt_x(p); cvt_ffn(p, 0, 0, ldsf); cvt_mix(p, 0, ldsf); cvt_w1t(p, ldsf); }
        else {
            bf16_t* XB = (bf16_t*)(pws() + WS_XB); bf16_t* HIN = (bf16_t*)(pws() + WS_HIN);
            const int l = (ph - 1) / 13, s = (ph - 1) % 13;
            for (int rep = 0; rep < (((REPEAT_MASK >> s) & 1) ? 2 : 1); ++rep) {
            if ((s == 0 || s == 10) && (PHM & 2)) {
                pg8::Gemm g{XB, (const bf16_t*)(pws() + WS_WA), NTOK, 11264, DM}; pg8::StaticOrder S; S.init(NTOK, 11264, (int)gridDim.x, (int)obid());
                EpiUp E{HIN}; pg8::gemm_phase<EpiUp, pg8::StaticOrder>(ldsl, g, S, E, nullptr);
            } else if ((s == 1 || s == 11 || s == 8) && (PHM & 4)) {
                const bool mix = (s == 8);
                pg8::Gemm g{mix ? XB : HIN, (const bf16_t*)(pws() + (mix ? WS_WD : WS_WB)), NTOK, DM, mix ? DM : DFF}; pg8::StaticOrder S; S.init(NTOK, DM, (int)gridDim.x, (int)obid());
                EpiRes E{(l == 0 && s == 1) ? pin(0) : (mix ? (const float*)pout() : nullptr), XB, pout(), ALPHA, mix ? 1.0f : 0.5f}; pg8::gemm_phase<EpiRes, pg8::StaticOrder>(ldsl, g, S, E, nullptr);
            } else if (s == 3 && (PHM & 8)) {
                pg8::Gemm g{XB, (const bf16_t*)(pws() + WS_WC), NTOK, DINP, DM}; pg8::StaticOrder S; S.init(NTOK, DINP, (int)gridDim.x, (int)obid());
                pg8::EpiBf16<0> E{HIN, DINP, nullptr, 0, 0}; pg8::gemm_phase<pg8::EpiBf16<0>, pg8::StaticOrder>(ldsl, g, S, E, nullptr);
            } else if (s == 2 && (PHM & 16)) { ln_rows(pout(), XB, pin(1) + l * DM, pin(2) + l * DM, true); cvt_ffn(p, l, 1, ldsf); }
            else if (s == 9 && (PHM & 16)) { ln_rows(pout(), XB, pin(6) + l * DM, pin(7) + l * DM, false); }
            else if (s == 12 && (PHM & 16)) { ln_rows(pout(), XB, pin(26) + l * DM, pin(27) + l * DM, l + 1 == NLAYER); if (l + 1 < NLAYER) { cvt_ffn(p, l + 1, 0, ldsf); cvt_mix(p, l + 1, ldsf); } }
            else if (s == 4 && (PHM & 32)) mixer_phase_pre(p, l, ldsf);
            else if (s == 5 && (PHM & 32)) mixer_phase_a(p, l, ldsf);
            else if (s == 6 && (PHM & 64)) scan_phase(p);
            else if (s == 7 && (PHM & 384)) mixer_phase_c<((PHM & 128) ? 1 : 0) | ((PHM & 256) ? 14 : 0)>(p, l, ldsf);
            }
        }
        if (ph + 1 < p.ph_hi) { if (ph == p.ph_lo) cg::this_grid().sync(); else grid_bar((unsigned*)(pws() + WS_BAR), (++nbar) * gridDim.x); }
    }
}

#ifndef HOST_REPEAT
#define HOST_REPEAT 0
#endif
#ifndef MULTI_LAUNCH
#define MULTI_LAUNCH 0
#endif
static int phase_mask(int ph) { if (ph == 0) return 1; const int s = (ph - 1) % 13; return (s == 0 || s == 10) ? 2 : (s == 1 || s == 11 || s == 8) ? 4 : s == 3 ? 8 : (s == 2 || s == 9 || s == 12) ? 16 : (s == 4 || s == 5) ? 32 : s == 6 ? 64 : 128; }
template <int M> static bool setup_one(int* per_cu) {
    if (hipFuncSetAttribute((const void*)mega_fwd<M>, hipFuncAttributeMaxDynamicSharedMemorySize, LDS_BYTES) != hipSuccess) return false;
    int pc = 0; if (hipOccupancyMaxActiveBlocksPerMultiprocessor(&pc, (const void*)mega_fwd<M>, NTHREADS, LDS_BYTES) != hipSuccess) pc = 0; *per_cu = pc; return true;
}
extern "C" void kernel_launch(void* const* d_in, const int* in_sizes, int n_in, void* d_out, int out_size, void* d_ws, size_t ws_size, hipStream_t stream) {
    static int grid = 0;
    if (grid == 0) {
        if (n_in != 31 || out_size != NTOK * DM || ws_size < WS_END) { fprintf(stderr, "kernel_launch: unexpected shapes: n_in %d out %d ws %zu (need %zu)\n", n_in, out_size, ws_size, (size_t)WS_END); grid = -1; return; }
        int dev = 0, cus = 0, per_cu = 0; bool ok = true;
        (void)hipGetDevice(&dev); (void)hipDeviceGetAttribute(&cus, hipDeviceAttributeMultiprocessorCount, dev);
#if MULTI_LAUNCH
        ok = setup_one<1>(&per_cu) && setup_one<2>(&per_cu) && setup_one<4>(&per_cu) && setup_one<8>(&per_cu) && setup_one<16>(&per_cu) && setup_one<32>(&per_cu) && setup_one<64>(&per_cu) && setup_one<128>(&per_cu) && setup_one<256>(&per_cu);
#else
        ok = setup_one<511>(&per_cu);
#endif
        (void)hipGetLastError();
        if (!ok) { fprintf(stderr, "kernel_launch: hipFuncSetAttribute failed\n"); grid = -1; return; }
        grid = cus;
        fprintf(stderr, "kernel_launch: grid %d (cus %d, per_cu %d)\n", grid, cus, per_cu);
    }
    if (grid < 0) return;
    Params p{};
    for (int i = 0; i < 31; ++i) p.in[i] = (const float*)d_in[i];
    p.out = (float*)d_out; p.ws = (unsigned char*)d_ws;
#if MULTI_LAUNCH
    for (int ph = 0; ph < NPHASE; ++ph) { p.ph_lo = ph; p.ph_hi = ph + 1;
      for (int hrep = 0; hrep < ((ph > 0 && ((HOST_REPEAT >> ((ph - 1) % 13)) & 1)) ? 2 : 1); ++hrep)
        switch (phase_mask(ph)) {
            case 1: hipLaunchKernelGGL(mega_fwd<1>, dim3(grid), dim3(NTHREADS), LDS_BYTES, stream, p); break;
            case 2: hipLaunchKernelGGL(mega_fwd<2>, dim3(grid), dim3(NTHREADS), LDS_BYTES, stream, p); break;
            case 4: hipLaunchKernelGGL(mega_fwd<4>, dim3(grid), dim3(NTHREADS), LDS_BYTES, stream, p); break;
            case 8: hipLaunchKernelGGL(mega_fwd<8>, dim3(grid), dim3(NTHREADS), LDS_BYTES, stream, p); break;
            case 16: hipLaunchKernelGGL(mega_fwd<16>, dim3(grid), dim3(NTHREADS), LDS_BYTES, stream, p); break;
            case 32: hipLaunchKernelGGL(mega_fwd<32>, dim3(grid), dim3(NTHREADS), LDS_BYTES, stream, p); break;
            case 64: hipLaunchKernelGGL(mega_fwd<64>, dim3(grid), dim3(NTHREADS), LDS_BYTES, stream, p); break;
            default: hipLaunchKernelGGL(mega_fwd<128>, dim3(grid), dim3(NTHREADS), LDS_BYTES, stream, p); hipLaunchKernelGGL(mega_fwd<256>, dim3(grid), dim3(NTHREADS), LDS_BYTES, stream, p); break;
        }
    }
#else
    p.ph_lo = 0; p.ph_hi = NPHASE;
    (void)hipMemsetAsync((unsigned char*)d_ws + WS_BAR, 0, 256, stream);
    void* args[] = {&p};
    hipError_t e = hipLaunchCooperativeKernel((const void*)mega_fwd<511>, dim3(grid), dim3(NTHREADS), args, LDS_BYTES, stream);
    if (e != hipSuccess) fprintf(stderr, "kernel_launch: cooperative launch failed: %s (grid %d)\n", hipGetErrorString(e), grid);
#endif
}
```

```cpp
#include <hip/hip_runtime.h>
#include <hip/hip_cooperative_groups.h>
#include <cstdio>
namespace cg = cooperative_groups;
__device__ __forceinline__ int otid() { int t = (int)threadIdx.x; asm volatile("" : "+v"(t)); return t; }
__device__ __forceinline__ int obid() { int t = (int)blockIdx.x; asm volatile("" : "+s"(t)); return t; }
template <int CTRL> __device__ __forceinline__ float dppf(float v) { return __int_as_float(__builtin_amdgcn_mov_dpp(__float_as_int(v), CTRL, 0xf, 0xf, true)); }
template <int CTRL> __device__ __forceinline__ unsigned dppu(unsigned v) { return (unsigned)__builtin_amdgcn_mov_dpp((int)v, CTRL, 0xf, 0xf, true); }
template <int CTRL> __device__ __forceinline__ unsigned long long dppu64(unsigned long long v) { return ((unsigned long long)dppu<CTRL>((unsigned)(v >> 32)) << 32) | dppu<CTRL>((unsigned)v); }
template <int K> __device__ __forceinline__ int sxi(int v) {
    if constexpr (K < 32) return __builtin_amdgcn_ds_swizzle(v, (K << 10) | 0x1f);
    else return __builtin_amdgcn_ds_bpermute(((otid() & 63) ^ 32) << 2, v);
}
template <int K> __device__ __forceinline__ float sxf(float v) { return __int_as_float(sxi<K>(__float_as_int(v))); }
__device__ __forceinline__ float wave_sum(float v) { v += sxf<1>(v); v += sxf<2>(v); v += sxf<4>(v); v += sxf<8>(v); v += sxf<16>(v); v += sxf<32>(v); return v; }
template <int K> __device__ __forceinline__ unsigned long long sxu64(unsigned long long v) { const unsigned lo = (unsigned)sxi<K>((int)(unsigned)v), hi = (unsigned)sxi<K>((int)(unsigned)(v >> 32)); return ((unsigned long long)hi << 32) | lo; }
__device__ __forceinline__ unsigned long long wave_max_u64(unsigned long long b) { unsigned long long o;
    o = dppu64<0xB1>(b); b = o > b ? o : b; o = dppu64<0x4E>(b); b = o > b ? o : b; o = dppu64<0x141>(b); b = o > b ? o : b; o = dppu64<0x140>(b); b = o > b ? o : b; o = sxu64<16>(b); b = o > b ? o : b; o = sxu64<32>(b); b = o > b ? o : b; return b; }
__device__ __forceinline__ float wave_maxf(float v) { v = fmaxf(v, dppf<0xB1>(v)); v = fmaxf(v, dppf<0x4E>(v)); v = fmaxf(v, dppf<0x141>(v)); v = fmaxf(v, dppf<0x140>(v)); v = fmaxf(v, sxf<16>(v)); v = fmaxf(v, sxf<32>(v)); return v; }
__device__ __forceinline__ void lds_addf(float* p, float v) { __hip_atomic_fetch_add((__attribute__((address_space(3))) float*)p, v, __ATOMIC_RELAXED, __HIP_MEMORY_SCOPE_WORKGROUP); }
__device__ __forceinline__ void lds_or64(unsigned long long* p, unsigned long long v) { __hip_atomic_fetch_or((__attribute__((address_space(3))) unsigned long long*)p, v, __ATOMIC_RELAXED, __HIP_MEMORY_SCOPE_WORKGROUP); }
namespace pg8 {
#define PG8_LAS __attribute__((address_space(3)))
typedef unsigned short bf16_t;
typedef short bf16x8 __attribute__((ext_vector_type(8)));
typedef float f32x4 __attribute__((ext_vector_type(4)));
typedef unsigned u32x4 __attribute__((ext_vector_type(4)));
constexpr int BM = 256, BK = 64, HALF = 128, HTB = HALF * BK * 2  , STAGE_BYTES = 8 * HTB, NXCD = 8, WGM = 8;

__host__ __device__ __forceinline__ int lds_byte(int r, int c) { const int st = (r >> 4) * 2 + (c >> 5), rr = r & 15, cc = c & 31, ob = rr * 64 + cc * 2; return st * 1024 + (ob ^ (((ob >> 9) & 1) << 5)); }
__host__ __device__ __forceinline__ void stage_rc(int b, int& R, int& C) { const int st = b / 1024, sb = b % 1024, swz = sb ^ (((sb >> 9) & 1) << 5); R = (st >> 1) * 16 + swz / 64; C = (st & 1) * 32 + (swz % 64) / 2; }
__host__ __device__ __forceinline__ int perm32(int rho) { const int n = rho >> 4, i = rho & 15; return 8 * (i >> 2) + 4 * n + (i & 3); }

struct Unit { int pm, pn; };
struct Gemm { const bf16_t* A; const bf16_t* Bt; int M, N, K; };

struct StaticOrder {
    int nM, nN, nwg, G, c;
    __host__ __device__ void init(int M, int N, int G_, int c_) { nM = M / BM; nN = N / BM; nwg = nM * nN; G = G_; c = c_; }
    __host__ __device__ bool next(int i, Unit& u) const {
        const long L = (long)i * G + c; if (L >= nwg) return false;
        int wgid = (int)L; { const int q = nwg / NXCD, r = nwg % NXCD, xcd = wgid % NXCD, off = wgid / NXCD; wgid = (xcd < r ? xcd * (q + 1) : r * (q + 1) + (xcd - r) * q) + off; }
        const int nig = WGM * nN, gid = wgid / nig, fm = gid * WGM, gsz = (nM - fm) < WGM ? (nM - fm) : WGM;
        u.pm = fm + ((wgid % nig) % gsz); u.pn = (wgid % nig) / gsz; return true;
    }
    __device__ __forceinline__ void a_ready(const Unit&) const {}
    __device__ __forceinline__ void done(const Unit&) const {}
};
struct CountedOrder : StaticOrder {
    const unsigned* ready; unsigned need; unsigned* tmo;
    __device__ __forceinline__ void a_ready(const Unit& u) const {
        if (threadIdx.x < 64) {
            const unsigned long long t0 = __builtin_amdgcn_s_memrealtime(); unsigned polls = 0;
            while ((unsigned)__builtin_amdgcn_readfirstlane(__hip_atomic_load(ready + 64 * u.pm, __ATOMIC_RELAXED, __HIP_MEMORY_SCOPE_AGENT)) < need) {
                if ((++polls & 255u) == 0u && __builtin_amdgcn_readfirstlane(__hip_atomic_load(tmo, __ATOMIC_RELAXED, __HIP_MEMORY_SCOPE_AGENT)) != 0u) break;
                if (__builtin_amdgcn_s_memrealtime() - t0 > 2000000ull) {
                    if (threadIdx.x == 0) { unsigned expect = 0u; __hip_atomic_compare_exchange_strong(tmo + 1, &expect, 0x600u | (unsigned)(u.pm & 0xff), __ATOMIC_RELAXED, __ATOMIC_RELAXED, __HIP_MEMORY_SCOPE_AGENT); __hip_atomic_store(tmo, 1u, __ATOMIC_RELAXED, __HIP_MEMORY_SCOPE_AGENT); }
                    break; }
                __builtin_amdgcn_s_sleep(2); }
            __builtin_amdgcn_fence(__ATOMIC_ACQUIRE, "agent");
            asm volatile("s_waitcnt vmcnt(0)" ::: "memory");
        }
#if !defined(BROKEN_HOOK_NO_BARRIER)
        asm volatile("" ::: "memory"); __builtin_amdgcn_s_barrier(); asm volatile("" ::: "memory");
#endif
    }
};

__device__ __forceinline__ unsigned cvt_pk_bf16(float lo, float hi) { unsigned r; asm volatile("v_cvt_pk_bf16_f32 %0, %1, %2" : "=v"(r) : "v"(lo), "v"(hi)); return r; }
typedef float f32x2 __attribute__((ext_vector_type(2)));
__device__ __forceinline__ f32x2 gelu_pk(f32x2 v) {
    const f32x2 av = __builtin_elementwise_abs(v), d = av * 0.2316418882f + 1.0f;
    f32x2 t; t.x = __builtin_amdgcn_rcpf(d.x); t.y = __builtin_amdgcn_rcpf(d.y);
    f32x2 q = t * 0.5307027145f + (-0.7265760135f); q = q * t + 0.7107068705f; q = q * t + (-0.142248368f); q = q * t + 0.127414796f; q = q * t;
    const f32x2 s = (v * v) * (-0.72134752044f);
    f32x2 e; e.x = __builtin_amdgcn_exp2f(s.x); e.y = __builtin_amdgcn_exp2f(s.y);
    const f32x2 m = v * (q * e), r = v - m;
    f32x2 o; o.x = v.x < 0.f ? m.x : r.x; o.y = v.y < 0.f ? m.y : r.y; return o;
}

struct EpiF32 {
    static constexpr bool PERM = false, AFTER_DRAIN = false;
    float* C; int ldc; const float* bias;
    __device__ __forceinline__ void operator()(const f32x4 (&acc)[2][2][4][2], const Unit& u, int wr, int wc, int fr, int fq) const {
        const int row0 = u.pm * BM + wr * 64 + fr, col0 = u.pn * BM + wc * 32 + 4 * fq;
        f32x4 bv[2][2];
#pragma unroll
        for (int bj = 0; bj < 2; ++bj)
#pragma unroll
            for (int n = 0; n < 2; ++n) bv[bj][n] = bias ? *(const f32x4*)(bias + col0 + bj * HALF + n * 16) : (f32x4){0.f, 0.f, 0.f, 0.f};
#pragma unroll
        for (int ai = 0; ai < 2; ++ai)
#pragma unroll
            for (int m = 0; m < 4; ++m) { float* rowp = C + (size_t)(row0 + ai * HALF + m * 16) * ldc + col0;
#pragma unroll
                for (int bj = 0; bj < 2; ++bj)
#pragma unroll
                    for (int n = 0; n < 2; ++n) *(f32x4*)(rowp + bj * HALF + n * 16) = acc[ai][bj][m][n] + bv[bj][n]; }
    }
};
template <int ACT  > struct EpiBf16 {
    static constexpr bool PERM = true, AFTER_DRAIN = false;
    bf16_t* O; int ldc; const float* bias; int split_cols; size_t split_stride;
    __device__ __forceinline__ void operator()(const f32x4 (&acc)[2][2][4][2], const Unit& u, int wr, int wc, int fr, int fq) const {
        const int row0 = u.pm * BM + wr * 64 + fr; int colt = u.pn * BM; bf16_t* base = O;
        if (split_cols) { const int t = colt / split_cols; base += (size_t)t * split_stride; colt -= t * split_cols; }
        const int col0 = colt + wc * 32 + 8 * fq, bcol0 = u.pn * BM + wc * 32 + 8 * fq;
        f32x4 bv[2][2];
#pragma unroll
        for (int bj = 0; bj < 2; ++bj)
#pragma unroll
            for (int n = 0; n < 2; ++n) bv[bj][n] = bias ? *(const f32x4*)(bias + bcol0 + bj * HALF + 4 * n) : (f32x4){0.f, 0.f, 0.f, 0.f};
#pragma unroll
        for (int ai = 0; ai < 2; ++ai)
#pragma unroll
            for (int m = 0; m < 4; ++m) { bf16_t* rowp = base + (size_t)(row0 + ai * HALF + m * 16) * ldc + col0;
#pragma unroll
                for (int bj = 0; bj < 2; ++bj) { f32x4 v0 = acc[ai][bj][m][0] + bv[bj][0], v1 = acc[ai][bj][m][1] + bv[bj][1];
                    if (ACT == 1) { f32x2 a = gelu_pk((f32x2){v0[0], v0[1]}), b = gelu_pk((f32x2){v0[2], v0[3]}), c = gelu_pk((f32x2){v1[0], v1[1]}), d = gelu_pk((f32x2){v1[2], v1[3]});
                        v0 = (f32x4){a.x, a.y, b.x, b.y}; v1 = (f32x4){c.x, c.y, d.x, d.y}; }
                    if (ACT == 2) {
#pragma unroll
                        for (int j = 0; j < 4; ++j) { v0[j] = 0.5f * v0[j] * (1.0f + erff(v0[j] * 0.70710678f)); v1[j] = 0.5f * v1[j] * (1.0f + erff(v1[j] * 0.70710678f)); } }
                    u32x4 w; w.x = cvt_pk_bf16(v0[0], v0[1]); w.y = cvt_pk_bf16(v0[2], v0[3]); w.z = cvt_pk_bf16(v1[0], v1[1]); w.w = cvt_pk_bf16(v1[2], v1[3]);
                    *(u32x4*)(rowp + bj * HALF) = w; } }
    }
};
template <class Epi, class Sched, bool STAMP = false>
__device__ __forceinline__ void gemm_phase(PG8_LAS unsigned char* lds, const Gemm g, const Sched& S, const Epi& E, unsigned long long* stamps) {
    const int tid = otid(), wid = __builtin_amdgcn_readfirstlane(tid >> 6), lane = tid & 63, wr = wid >> 2, wc = wid & 3, fr = lane & 15, fq = lane >> 4;
    const int K = g.K, nt = K / BK;
    int ts_lo = 0, ts_hi = 0, nts = 0; const unsigned long long rt_entry = STAMP ? (unsigned long long)wall_clock64() : 0ull;
#define PG8_STAMP() do { if (STAMP && wid == 0 && nts < 64) { const unsigned long long _c = (unsigned long long)clock64(); \
        ts_lo = (lane == nts) ? (int)(unsigned)_c : ts_lo; ts_hi = (lane == nts) ? (int)(unsigned)(_c >> 32) : ts_hi; ++nts; } } while (0)
    PG8_STAMP();
    unsigned voffA[2], voffB[2];
#pragma unroll
    for (int i = 0; i < 2; ++i) { int R, C; stage_rc(tid * 16 + i * 8192, R, C); const int Rb = Epi::PERM ? ((R & ~31) + perm32(R & 31)) : R;
        voffA[i] = (unsigned)(R * K + C) * 2u; voffB[i] = (unsigned)(Rb * K + C) * 2u; }
    const size_t kstep = (size_t)(BK * 2);
    const size_t hstep = (size_t)HALF * K * 2;
    const size_t tstep = 2 * hstep;
    const unsigned ldsw = (unsigned)wid * 1024u;
    const int aoff = lds_byte(wr * 64 + fr, fq * 8), boff = lds_byte(wc * 32 + fr, fq * 8);
#define PG8_SA(b, h) (((b) * 2 + (h)) * HTB)
#define PG8_SB(b, h) ((4 + (b) * 2 + (h)) * HTB)
#define PG8_STAGE(bufoff, gbase, voff) do { _Pragma("unroll") for (int _i = 0; _i < 2; ++_i) \
        __builtin_amdgcn_global_load_lds((const unsigned*)((const char*)(gbase) + (voff)[_i]), (PG8_LAS unsigned*)(lds + (bufoff) + ldsw + _i * 8192), 16, 0, 0); } while (0)
#define PG8_LDA(dst, b, h) do { _Pragma("unroll") for (int m = 0; m < 4; ++m) _Pragma("unroll") for (int k = 0; k < 2; ++k) dst[m][k] = *(const PG8_LAS bf16x8*)(lds + PG8_SA(b, h) + aoff + m * 2048 + k * 1024); } while (0)
#define PG8_LDB(dst, b, h) do { _Pragma("unroll") for (int n = 0; n < 2; ++n) _Pragma("unroll") for (int k = 0; k < 2; ++k) dst[n][k] = *(const PG8_LAS bf16x8*)(lds + PG8_SB(b, h) + boff + n * 2048 + k * 1024); } while (0)
#define PG8_MMA(ai, bj, At, Bt) do { __builtin_amdgcn_s_setprio(1); _Pragma("unroll") for (int m = 0; m < 4; ++m) _Pragma("unroll") for (int n = 0; n < 2; ++n) _Pragma("unroll") for (int k = 0; k < 2; ++k) \
        acc[ai][bj][m][n] = __builtin_amdgcn_mfma_f32_16x16x32_bf16(Bt[n][k], At[m][k], acc[ai][bj][m][n], 0, 0, 0); __builtin_amdgcn_s_setprio(0); } while (0)
#define PG8_WAIT_V(n) asm volatile("s_waitcnt vmcnt(" #n ")" ::: "memory")
#define PG8_WAIT_L(n) asm volatile("s_waitcnt lgkmcnt(" #n ")" ::: "memory")
#define PG8_BAR __builtin_amdgcn_s_barrier()
#define PG8_SCHED __builtin_amdgcn_sched_barrier(0)
    Unit cur, nxt; int ui = 0;
    if (!S.next(0, cur)) return;
    f32x4 acc[2][2][4][2];
#pragma unroll
    for (int a = 0; a < 2; ++a)
#pragma unroll
        for (int b = 0; b < 2; ++b)
#pragma unroll
            for (int m = 0; m < 4; ++m)
#pragma unroll
                for (int n = 0; n < 2; ++n) acc[a][b][m][n] = (f32x4){0.f, 0.f, 0.f, 0.f};
    bf16x8 At[4][2], B0[2][2], B1[2][2];
    const char* cA = (const char*)g.A + (size_t)cur.pm * tstep; const char* cB = (const char*)g.Bt + (size_t)cur.pn * tstep;
    S.a_ready(cur);
    PG8_STAGE(PG8_SB(0, 0), cB, voffB); PG8_STAGE(PG8_SA(0, 0), cA, voffA); PG8_STAGE(PG8_SB(0, 1), cB + hstep, voffB); PG8_STAGE(PG8_SA(0, 1), cA + hstep, voffA);
    if (wr == 1) PG8_BAR;
    PG8_WAIT_V(4); PG8_BAR;
    PG8_STAGE(PG8_SB(1, 0), cB + kstep, voffB); PG8_STAGE(PG8_SA(1, 0), cA + kstep, voffA); PG8_STAGE(PG8_SB(1, 1), cB + hstep + kstep, voffB);
    PG8_WAIT_V(6); PG8_BAR;
    PG8_STAMP();
    for (;;) {
        const bool has_next = S.next(ui + 1, nxt);
        const char* nA = has_next ? (const char*)g.A + (size_t)nxt.pm * tstep : cA; const char* nB = has_next ? (const char*)g.Bt + (size_t)nxt.pn * tstep : cB;
        for (int t = 0; t < nt; t += 2) {
            const bool last = (t == nt - 2);
            const char* a1 = cA + (size_t)(t + 1) * kstep;
            const char* a2 = last ? nA : cA + (size_t)(t + 2) * kstep; const char* b2 = last ? nB : cB + (size_t)(t + 2) * kstep;
            const char* a3 = a2 + kstep; const char* b3 = b2 + kstep;
            if (last && has_next) S.a_ready(nxt);
            PG8_LDB(B0, 0, 0); PG8_SCHED; PG8_LDA(At, 0, 0); PG8_STAGE(PG8_SA(1, 1), a1 + hstep, voffA);
            PG8_WAIT_L(8); PG8_BAR; PG8_WAIT_L(0); PG8_MMA(0, 0, At, B0); PG8_BAR; PG8_SCHED;
            PG8_LDB(B1, 0, 1); PG8_STAGE(PG8_SB(0, 0), b2, voffB);
            PG8_BAR; PG8_WAIT_L(0); PG8_MMA(0, 1, At, B1); PG8_BAR;
            PG8_LDA(At, 0, 1); PG8_STAGE(PG8_SA(0, 0), a2, voffA);
            PG8_BAR; PG8_WAIT_L(0); PG8_MMA(1, 0, At, B0); PG8_BAR; PG8_SCHED;
            PG8_STAGE(PG8_SB(0, 1), b2 + hstep, voffB);
            PG8_WAIT_V(6); PG8_BAR; PG8_MMA(1, 1, At, B1); PG8_BAR;
            PG8_LDB(B0, 1, 0); PG8_SCHED; PG8_LDA(At, 1, 0); PG8_STAGE(PG8_SA(0, 1), a2 + hstep, voffA);
            PG8_WAIT_L(8); PG8_BAR; PG8_WAIT_L(0); PG8_MMA(0, 0, At, B0); PG8_BAR; PG8_SCHED;
            PG8_LDB(B1, 1, 1); PG8_STAGE(PG8_SB(1, 0), b3, voffB);
            PG8_BAR; PG8_WAIT_L(0); PG8_MMA(0, 1, At, B1); PG8_BAR;
            PG8_LDA(At, 1, 1); PG8_STAGE(PG8_SA(1, 0), a3, voffA);
            PG8_BAR; PG8_WAIT_L(0); PG8_MMA(1, 0, At, B0); PG8_BAR; PG8_SCHED;
            PG8_STAGE(PG8_SB(1, 1), b3 + hstep, voffB);
            PG8_WAIT_V(6); PG8_BAR; PG8_MMA(1, 1, At, B1); PG8_BAR;
        }
        PG8_STAMP();
        if constexpr (!Epi::AFTER_DRAIN) { E(acc, cur, wr, wc, fr, fq); S.done(cur); }
        PG8_STAMP();
        if (!has_next) break;
#pragma unroll
        for (int a = 0; a < 2; ++a)
#pragma unroll
            for (int b = 0; b < 2; ++b)
#pragma unroll
                for (int m = 0; m < 4; ++m)
#pragma unroll
                    for (int n = 0; n < 2; ++n) acc[a][b][m][n] = (f32x4){0.f, 0.f, 0.f, 0.f};
        cur = nxt; cA = nA; cB = nB; ++ui;
    }
    PG8_WAIT_V(0);
    if (wr == 0) PG8_BAR;
    PG8_BAR;
    if constexpr (Epi::AFTER_DRAIN) { E.fused(acc, cur, wr, wc, fr, fq, lds, wid, lane); S.done(cur); }
    PG8_STAMP();
    if (STAMP && wid == 0) { stamps[lane] = lane < nts ? (((unsigned long long)(unsigned)ts_hi << 32) | (unsigned)ts_lo) : 0ull;
        if (lane == 62) stamps[62] = rt_entry; if (lane == 63) stamps[63] = (unsigned long long)wall_clock64(); }
#undef PG8_STAMP
#undef PG8_SA
#undef PG8_SB
#undef PG8_STAGE
#undef PG8_LDA
#undef PG8_LDB
#undef PG8_MMA
#undef PG8_WAIT_V
#undef PG8_WAIT_L
#undef PG8_BAR
#undef PG8_SCHED
}
}
typedef unsigned short bf16_t;
typedef float f32x4 __attribute__((ext_vector_type(4)));
typedef unsigned u32x4 __attribute__((ext_vector_type(4)));
typedef unsigned u32x2 __attribute__((ext_vector_type(2)));
typedef short bf16x8 __attribute__((ext_vector_type(8)));
#define MFMA16(a, b, c) __builtin_amdgcn_mfma_f32_16x16x32_bf16((a), (b), (c), 0, 0, 0)
#define LAS __attribute__((address_space(3)))

constexpr int SEQ = 16384, NBATCH = 2, NTOK = 32768, DM = 2048, DFF = 5632, DIN = 6944, DINP = 7168, NLAYER = 2;
constexpr int C_HQ = 0, C_HF = 512, C_HI = 1024, C_HG = 1536, C_NQ = 2048, C_NKC = 2560, C_NVC = 2688, C_NKS = 2816, C_NVS = 2944,
              C_NKW = 3072, C_NVW = 3200, C_NGATE = 3328, C_SZ = 3352, C_SXBC = 3864, C_SDT = 4888, C_RQ = 4896, C_RK = 5408, C_RV = 5920, C_RG = 6432;
constexpr float ALPHA = 1.41421356237f;
constexpr int LDS_BYTES = 147456;
constexpr int NTHREADS = 512;

constexpr size_t WS_WA = 0;
constexpr size_t WS_WB = WS_WA + (size_t)11264 * 2048 * 2;
constexpr size_t WS_WC = WS_WB + (size_t)2048 * 5632 * 2;
constexpr size_t WS_WD = WS_WC + (size_t)7168 * 2048 * 2;
constexpr size_t WS_XB = WS_WD + (size_t)2048 * 2048 * 2;
constexpr size_t WS_HIN = WS_XB + (size_t)NTOK * 2048 * 2;
constexpr size_t WS_STH = WS_HIN + (size_t)NTOK * DINP * 2;
constexpr size_t WS_STS = WS_STH + (size_t)2048 * 16384 * 2;
constexpr size_t WS_STR = WS_STS + (size_t)4096 * 8192 * 2;
constexpr size_t WS_DECH = WS_STR + (size_t)2048 * 16384 * 2;
constexpr size_t WS_DECS = WS_DECH + (size_t)2048 * 128 * 4;
constexpr size_t WS_KCMP = WS_DECS + (size_t)4096 * 4;
constexpr size_t WS_VCMP = WS_KCMP + (size_t)4 * 1024 * 64 * 4;
constexpr size_t WS_VST = WS_VCMP + (size_t)4 * 1024 * 64 * 4;
constexpr size_t WS_VWT = WS_VST + (size_t)4 * 256 * 4096 * 2;
constexpr size_t WS_KCB = WS_VWT + (size_t)4 * 256 * 4096 * 2;
constexpr size_t WS_VCT = WS_KCB + (size_t)4 * 1024 * 64 * 2;
constexpr size_t WS_XBC = WS_VCT + (size_t)4 * 16 * 4096 * 2;
constexpr size_t WS_KNORM = WS_XBC + (size_t)NTOK * 1024 * 2;
constexpr size_t WS_BAR = WS_KNORM + (size_t)4 * 256 * 4;
constexpr size_t WS_W1T = WS_BAR + 256;
constexpr size_t WS_END = WS_W1T + (size_t)4 * 256 * 2048 * 2;

struct Params {
    const float* in[31];
    float* out;
    unsigned char* ws;
    int ph_lo, ph_hi;
};

__shared__ unsigned long long g_ptab[40];
__device__ __forceinline__ unsigned long long ptab_get(int k) { const unsigned long long v = *(volatile LAS unsigned long long*)((LAS unsigned long long*)g_ptab + k);
    unsigned lo = __builtin_amdgcn_readfirstlane((unsigned)v), hi = __builtin_amdgcn_readfirstlane((unsigned)(v >> 32)); asm volatile("" : "+s"(lo), "+s"(hi)); return ((unsigned long long)hi << 32) | lo; }
#define GAS __attribute__((address_space(1)))
__device__ __forceinline__ const float* pin(int k) { return (const float*)(GAS const float*)ptab_get(k); }
__device__ __forceinline__ float* pout() { return (float*)(GAS float*)ptab_get(31); }
__device__ __forceinline__ unsigned char* pws() { return (unsigned char*)(GAS unsigned char*)ptab_get(32); }
__device__ __forceinline__ float bf2f(bf16_t v) { return __uint_as_float(((unsigned)v) << 16); }
__device__ __forceinline__ float bflo(unsigned w) { return __uint_as_float(w << 16); }
__device__ __forceinline__ float bfhi(unsigned w) { return __uint_as_float(w & 0xffff0000u); }
__device__ __forceinline__ unsigned pk2(float lo, float hi) { return pg8::cvt_pk_bf16(lo, hi); }
__device__ __forceinline__ void ld8(const bf16_t* p, float (&x)[8]) { const u32x4 w = *(const u32x4*)p; x[0] = bflo(w.x); x[1] = bfhi(w.x); x[2] = bflo(w.y); x[3] = bfhi(w.y); x[4] = bflo(w.z); x[5] = bfhi(w.z); x[6] = bflo(w.w); x[7] = bfhi(w.w); }
__device__ __forceinline__ void st8(float* p, const float (&x)[8]) { *(f32x4*)p = (f32x4){x[0], x[1], x[2], x[3]}; *(f32x4*)(p + 4) = (f32x4){x[4], x[5], x[6], x[7]}; }
__device__ __forceinline__ void ldf8(const float* p, float (&x)[8]) { const f32x4 a = *(const f32x4*)p, b = *(const f32x4*)(p + 4); x[0] = a[0]; x[1] = a[1]; x[2] = a[2]; x[3] = a[3]; x[4] = b[0]; x[5] = b[1]; x[6] = b[2]; x[7] = b[3]; }
__device__ __forceinline__ float siluf(float x) { return x * __builtin_amdgcn_rcpf(1.f + __expf(-x)); }
__device__ __forceinline__ float sigmf(float x) { return __builtin_amdgcn_rcpf(1.f + __expf(-x)); }
__device__ __forceinline__ float softplusf(float x) { const float e = __expf(-fabsf(x)); const float l1 = e < 0.01f ? e * (1.f - e * (0.5f - e * (1.f / 3.f))) : __logf(1.f + e); return fmaxf(x, 0.f) + l1; }

__device__ __forceinline__ void cvt_tile(const float* s0, const float* s1, bf16_t* dstp, int K, int N, int mode, int tile, float* tl) {
    const int nkb = K >> 6; const int rb = tile / nkb, kb = tile - rb * nkb;
    const int r0 = rb * 128; const float* src = s0; int col0 = r0;
    if (mode == 1) { const int pn = r0 >> 8, bj = (r0 >> 7) & 1; src = bj ? s1 : s0; col0 = pn * 128; }
    const int tid = otid();
    { const int n = tid & 127, k0 = tid >> 7; const bool ok = (col0 + n) < N; const float* sp = src + (size_t)(kb * 64 + k0) * N + col0 + n;
#pragma unroll
      for (int i = 0; i < 16; ++i) tl[(k0 + 4 * i) * 129 + n] = ok ? sp[(size_t)(4 * i) * N] : 0.f; }
    __syncthreads();
    { const int k8 = (tid & 7) * 8;
#pragma unroll
      for (int i = 0; i < 2; ++i) { const int n = (tid >> 3) + 64 * i; const float* c = tl + k8 * 129 + n;
          u32x4 w; w.x = pk2(c[0], c[129]); w.y = pk2(c[2 * 129], c[3 * 129]); w.z = pk2(c[4 * 129], c[5 * 129]); w.w = pk2(c[6 * 129], c[7 * 129]);
          *(u32x4*)(dstp + (size_t)(r0 + n) * K + kb * 64 + k8) = w; } }
    __syncthreads();
}
__device__ void cvt_ffn(const Params& p, int l, int which  , float* tl) {
    const float* w1 = pin(which ? 28 : 3) + (size_t)l * DM * DFF; const float* w3 = pin(which ? 29 : 4) + (size_t)l * DM * DFF; const float* w2 = pin(which ? 30 : 5) + (size_t)l * DFF * DM;
    constexpr int n0 = (11264 / 128) * (DM / 64), n1 = (DM / 128) * (DFF / 64);
    for (int g = obid(); g < n0 + n1; g += gridDim.x) { const bool f = g < n0;
        cvt_tile(f ? w1 : w2, w3, (bf16_t*)(pws() + (f ? WS_WA : WS_WB)), f ? DM : DFF, f ? DFF : DM, f ? 1 : 0, f ? g : g - n0, tl); }
}
__device__ void cvt_mix(const Params& p, int l, float* tl) {
    constexpr int n0 = (DINP / 128) * (DM / 64), n1 = (DM / 128) * (DM / 64);
    for (int g = obid(); g < n0 + n1; g += gridDim.x) { const bool f = g < n0;
        cvt_tile(f ? pin(8) + (size_t)l * DM * DIN : pin(9) + (size_t)l * DM * DM, nullptr, (bf16_t*)(pws() + (f ? WS_WC : WS_WD)), DM, f ? DIN : DM, 0, f ? g : g - n0, tl); }
}
__device__ void cvt_w1t(const Params& p, float* tl) {
    for (int g = obid(); g < 256; g += gridDim.x) { const int job = g >> 6, l = job >> 1, which = job & 1;
        cvt_tile(pin(which ? 16 : 13) + (size_t)l * 2048 * 256, nullptr, (bf16_t*)(pws() + WS_W1T) + (size_t)job * 256 * 2048, 2048, 256, 0, g & 63, tl); }
}
__device__ void cvt_x(const Params& p) {
    const f32x4* x = (const f32x4*)pin(0); u32x2* xb = (u32x2*)(pws() + WS_XB);
    for (size_t i = (size_t)obid() * NTHREADS + otid(); i < (size_t)NTOK * DM / 4; i += (size_t)gridDim.x * NTHREADS) {
        const f32x4 v = x[i]; u32x2 w; w.x = pk2(v[0], v[1]); w.y = pk2(v[2], v[3]); xb[i] = w; }
}

struct EpiUp {
    static constexpr bool PERM = true, AFTER_DRAIN = false;
    bf16_t* H;
    __device__ __forceinline__ void operator()(const pg8::f32x4 (&acc)[2][2][4][2], const pg8::Unit& u, int wr, int wc, int fr, int fq) const {
        const int row0 = u.pm * 256 + wr * 64 + fr, col0 = u.pn * 128 + wc * 32 + 8 * fq;
#pragma unroll
        for (int ai = 0; ai < 2; ++ai)
#pragma unroll
            for (int m = 0; m < 4; ++m) { bf16_t* rowp = H + (size_t)(row0 + ai * 128 + m * 16) * DFF + col0;
                const pg8::f32x4 a0 = acc[ai][0][m][0], a1 = acc[ai][0][m][1], b0 = acc[ai][1][m][0], b1 = acc[ai][1][m][1];
                float v0[4], v1[4];
#pragma unroll
                for (int j = 0; j < 4; ++j) { v0[j] = siluf(a0[j]) * b0[j]; v1[j] = siluf(a1[j]) * b1[j]; }
                pg8::u32x4 w; w.x = pk2(v0[0], v0[1]); w.y = pk2(v0[2], v0[3]); w.z = pk2(v1[0], v1[1]); w.w = pk2(v1[2], v1[3]);
                *(pg8::u32x4*)rowp = w; }
    }
};
struct EpiRes {
    static constexpr bool PERM = false, AFTER_DRAIN = false;
    const float* res32; const bf16_t* res16; float* out; float alpha, scale;
    __device__ __forceinline__ void operator()(const pg8::f32x4 (&acc)[2][2][4][2], const pg8::Unit& u, int wr, int wc, int fr, int fq) const {
        const int row0 = u.pm * 256 + wr * 64 + fr, col0 = u.pn * 256 + wc * 32 + 4 * fq;
#pragma unroll
        for (int ai = 0; ai < 2; ++ai)
#pragma unroll
            for (int m = 0; m < 4; ++m) { const size_t off = (size_t)(row0 + ai * 128 + m * 16) * DM + col0;
#pragma unroll
                for (int bj = 0; bj < 2; ++bj)
#pragma unroll
                    for (int n = 0; n < 2; ++n) { pg8::f32x4 r;
                        if (res32) r = *(const pg8::f32x4*)(res32 + off + bj * 128 + n * 16);
                        else { const u32x2 w = *(const u32x2*)(res16 + off + bj * 128 + n * 16); r = (pg8::f32x4){bflo(w.x), bfhi(w.x), bflo(w.y), bfhi(w.y)}; }
                        *(pg8::f32x4*)(out + off + bj * 128 + n * 16) = r * alpha + acc[ai][bj][m][n] * scale; } }
    }
};

__device__ void ln_rows(float* X, bf16_t* xb, const float* g, const float* b, bool write_f32) {
    const int wid = otid() >> 6, lane = otid() & 63;
    for (int row = obid() * 8 + wid; row < NTOK; row += gridDim.x * 8) {
        float* xr = X + (size_t)row * DM; f32x4 v[8]; float s = 0.f;
#pragma unroll
        for (int i = 0; i < 8; ++i) { v[i] = *(const f32x4*)(xr + i * 256 + lane * 4); s += (v[i][0] + v[i][1]) + (v[i][2] + v[i][3]); }
        s = wave_sum(s);
        const float mean = s * (1.f / DM); float q = 0.f;
#pragma unroll
        for (int i = 0; i < 8; ++i) { const f32x4 d = v[i] - mean; q += (d[0] * d[0] + d[1] * d[1]) + (d[2] * d[2] + d[3] * d[3]); }
        q = wave_sum(q);
        const float rstd = rsqrtf(q * (1.f / DM) + 1e-5f);
#pragma unroll
        for (int i = 0; i < 8; ++i) { const int c = i * 256 + lane * 4; const f32x4 gg = *(const f32x4*)(g + c), bb = *(const f32x4*)(b + c);
            const f32x4 o = (v[i] - mean) * rstd * gg + bb; if (write_f32) *(f32x4*)(xr + c) = o;
            u32x2 w; w.x = pk2(o[0], o[1]); w.y = pk2(o[2], o[3]); *(u32x2*)(xb + (size_t)row * DM + c) = w; }
    }
}
#ifndef AREP
#define AREP 0
#endif
#ifndef CREP
#define CREP 0
#endif
constexpr int LP = 132;
__device__ __forceinline__ float hg_lb(const float* lg, int l, int idx) {
    if (l == 0) return 0.f; const float a0 = lg[idx], a1 = lg[512 + idx]; return 1.f / (1.f + __expf(a0 - a1));
}
__device__ __forceinline__ void hg_lb8(const float* lg, int l, int idx, float (&lb)[8]) {
    if (l == 0) {
#pragma unroll
        for (int k = 0; k < 8; ++k) lb[k] = 0.f;
    } else { float a0[8], a1[8]; ldf8(lg + idx, a0); ldf8(lg + 512 + idx, a1);
#pragma unroll
        for (int k = 0; k < 8; ++k) lb[k] = __builtin_amdgcn_rcpf(1.f + __expf(a0[k] - a1[k])); }
}
template <int DV> __device__ __forceinline__ void state_mm(const float* KD, const float* VV, bf16_t* dst) {
    const int tid = otid(), td = tid >> 4, tv = tid & 15;
    constexpr int NV = DV / 64;
    f32x4 acc[4][NV];
#pragma unroll
    for (int a = 0; a < 4; ++a)
#pragma unroll
        for (int n = 0; n < NV; ++n) acc[a][n] = (f32x4){0.f, 0.f, 0.f, 0.f};
    for (int j = 0; j < 64; ++j) {
        f32x4 v[NV];
#pragma unroll
        for (int n = 0; n < NV; ++n) v[n] = *(const f32x4*)(VV + j * LP + n * 64 + tv * 4);
#pragma unroll
        for (int a = 0; a < 4; ++a) { const float kd = KD[j * LP + td + 32 * a];
#pragma unroll
            for (int n = 0; n < NV; ++n) acc[a][n] += v[n] * kd; }
    }
#pragma unroll
    for (int a = 0; a < 4; ++a)
#pragma unroll
        for (int n = 0; n < NV; ++n) { u32x2 w; w.x = pk2(acc[a][n][0], acc[a][n][1]); w.y = pk2(acc[a][n][2], acc[a][n][3]);
            *(u32x2*)(dst + (size_t)(td + 32 * a) * DV + n * 64 + tv * 4) = w; }
}
__device__ __forceinline__ float ssd_act(const bf16_t* xbc, int b, int s, int ch) { return bf2f(xbc[((size_t)b * SEQ + s) * 1024 + ch]); }
__device__ void conv_prepass(const Params& p, int l) {
    const int tid = otid(), cg8 = (tid & 127) * 8, slot = tid >> 7;
    const bf16_t* hin = (const bf16_t*)(pws() + WS_HIN); bf16_t* xbc = (bf16_t*)(pws() + WS_XBC); const float* cw = pin(20) + l * 4096; const float* cb = pin(21) + l * 1024;
    float w[4][8], bias[8];
#pragma unroll
    for (int c = 0; c < 8; ++c) { bias[c] = cb[cg8 + c];
#pragma unroll
        for (int t = 0; t < 4; ++t) w[t][c] = cw[t * 1024 + cg8 + c]; }
    for (int tok = obid() * 4 + slot; tok < NTOK; tok += gridDim.x * 4) {
        const int s = tok & (SEQ - 1); float acc[8];
#pragma unroll
        for (int c = 0; c < 8; ++c) acc[c] = bias[c];
#pragma unroll
        for (int t = 0; t < 4; ++t) { if (s - 3 + t >= 0) { const u32x4 x = *(const u32x4*)(hin + (size_t)(tok - 3 + t) * DINP + C_SXBC + cg8);
            acc[0] += w[t][0] * bflo(x.x); acc[1] += w[t][1] * bfhi(x.x); acc[2] += w[t][2] * bflo(x.y); acc[3] += w[t][3] * bfhi(x.y);
            acc[4] += w[t][4] * bflo(x.z); acc[5] += w[t][5] * bfhi(x.z); acc[6] += w[t][6] * bflo(x.w); acc[7] += w[t][7] * bfhi(x.w); } }
        u32x4 o; o.x = pk2(siluf(acc[0]), siluf(acc[1])); o.y = pk2(siluf(acc[2]), siluf(acc[3])); o.z = pk2(siluf(acc[4]), siluf(acc[5])); o.w = pk2(siluf(acc[6]), siluf(acc[7]));
        *(u32x4*)(xbc + (size_t)tok * 1024 + cg8) = o;
    }
}
__device__ __forceinline__ void load_rotary(const bf16_t* hin, size_t t0, int pos0, int col0, float scale, float* dst, const float* theta) {
    const int tid = otid();
#pragma unroll
    for (int i = 0; i < 2; ++i) { const int e = tid + 512 * i; const int j = e >> 4, p0 = (e & 15) * 4;
        float x[8], y[8]; ld8(hin + (t0 + j) * DINP + col0 + 2 * p0, x);
#pragma unroll
        for (int k = 0; k < 4; ++k) { const float ang = (float)(pos0 + j) * theta[p0 + k];
            const float n = rintf(ang * 0.15915494309189535f); float r = fmaf(-n, 6.28125f, ang); r = fmaf(-n, 1.9353071795864769e-3f, r);
            const float sn = __sinf(r), cs = __cosf(r);
            y[2 * k] = (x[2 * k] * cs - x[2 * k + 1] * sn) * scale; y[2 * k + 1] = (x[2 * k] * sn + x[2 * k + 1] * cs) * scale; }
        st8(dst + j * LP + 2 * p0, y); }
}
__device__ __forceinline__ void fill_theta(float* theta) { if (otid() < 64) theta[otid()] = exp2f(-(float)otid() * (13.287712379549449f / 63.0f)); }

__device__ void hg_state_item(const Params& p, int l, int item, float* lds) {
    const int c = item & 255, h = (item >> 8) & 3, b = item >> 10; const int tid = otid();
    const bf16_t* hin = (const bf16_t*)(pws() + WS_HIN); const size_t t0 = (size_t)b * SEQ + c * 64;
    float* KD = lds; float* VV = lds + 64 * LP; float* BB = lds + 2 * 64 * LP; const float* lbl = pin(10);
#pragma unroll
    for (int i = 0; i < 2; ++i) { const int e = tid + 512 * i, j = e >> 4, d0 = (e & 15) * 8;
        float z[8], v[8], lb[8], bb[8], kk[8]; ld8(hin + (t0 + j) * DINP + C_HF + h * 128 + d0, z); ld8(hin + (t0 + j) * DINP + C_HI + h * 128 + d0, v); hg_lb8(lbl, l, h * 128 + d0, lb);
#pragma unroll
        for (int k = 0; k < 8; ++k) { const float sn = __builtin_amdgcn_rcpf(1.f + __expf(z[k])), sg = 1.f - sn; bb[k] = __logf(lb[k] + (1.f - lb[k]) * sg); kk[k] = (1.f - lb[k]) * sn; }
        st8(BB + j * LP + d0, bb); st8(KD + j * LP + d0, kk); st8(VV + j * LP + d0, v); }
    __syncthreads();
    if (tid < 128) { float a = 0.f; for (int j = 0; j < 64; ++j) { a += BB[j * LP + tid]; BB[j * LP + tid] = a; } }
    __syncthreads();
#pragma unroll
    for (int i = 0; i < 2; ++i) { const int e = tid + 512 * i, j = e >> 4, d0 = (e & 15) * 8; float kk[8], bj[8], bl[8]; ldf8(KD + j * LP + d0, kk); ldf8(BB + j * LP + d0, bj); ldf8(BB + 63 * LP + d0, bl);
#pragma unroll
        for (int k = 0; k < 8; ++k) kk[k] *= __expf(bl[k] - bj[k]);
        st8(KD + j * LP + d0, kk); }
    if (tid < 128) ((float*)(pws() + WS_DECH))[(size_t)item * 128 + tid] = __expf(BB[63 * LP + tid]);
    __syncthreads();
    state_mm<128>(KD, VV, (bf16_t*)(pws() + WS_STH) + (size_t)item * 16384);
    __syncthreads();
}
__device__ void ssd_state_item(const Params& p, int l, int item, float* lds) {
    const int c = item & 255, h = (item >> 8) & 7, b = item >> 11, g = h >> 2; const int tid = otid();
    const bf16_t* hin = (const bf16_t*)(pws() + WS_HIN); const size_t t0 = (size_t)b * SEQ + c * 64;
    const bf16_t* xbc = (const bf16_t*)(pws() + WS_XBC);
    float* KD = lds; float* VV = lds + 64 * LP; float* AUX = lds + 2 * 64 * LP;
    if (tid < 64) { const float dtv = softplusf(bf2f(hin[(t0 + tid) * DINP + C_SDT + h]) + pin(22)[l * 8 + h]);
        AUX[tid] = dtv; AUX[64 + tid] = -dtv * __expf(pin(23)[l * 8 + h]); }
    __syncthreads();
    if (tid < 64) { float a = 0.f; for (int j = 0; j <= tid; ++j) a += AUX[64 + j]; AUX[128 + tid] = a; }
    __syncthreads();
    const float cl = AUX[128 + 63];
#pragma unroll
    for (int i = 0; i < 2; ++i) { const int e = tid + 512 * i, j = e >> 4, n0 = (e & 15) * 8; float x[8]; ld8(xbc + ((size_t)b * SEQ + c * 64 + j) * 1024 + 512 + g * 128 + n0, x); const float f = __expf(cl - AUX[128 + j]);
#pragma unroll
        for (int k = 0; k < 8; ++k) x[k] *= f;
        st8(KD + j * LP + n0, x); }
    { const int j = tid >> 3, pc0 = (tid & 7) * 8; float x[8]; ld8(xbc + ((size_t)b * SEQ + c * 64 + j) * 1024 + h * 64 + pc0, x); const float f = AUX[j];
#pragma unroll
      for (int k = 0; k < 8; ++k) x[k] *= f;
      st8(VV + j * LP + pc0, x); }
    if (tid == 0) ((float*)(pws() + WS_DECS))[item] = __expf(cl);
    __syncthreads();
    state_mm<64>(KD, VV, (bf16_t*)(pws() + WS_STS) + (size_t)item * 8192);
    __syncthreads();
}
__device__ __forceinline__ float ret_lg(int h) { return __logf(1.f - exp2f(-5.f - (float)h)); }
__device__ void ret_state_item(const Params& p, int l, int item, float* lds) {
    const int c = item & 255, h = (item >> 8) & 3, b = item >> 10; const int tid = otid();
    const bf16_t* hin = (const bf16_t*)(pws() + WS_HIN); const size_t t0 = (size_t)b * SEQ + c * 64;
    float* KD = lds; float* VV = lds + 64 * LP; float* TH = lds + 2 * 64 * LP;
    fill_theta(TH);
    __syncthreads();
    load_rotary(hin, t0, c * 64, C_RK + h * 128, 0.08838834764831845f, KD, TH);
#pragma unroll
    for (int i = 0; i < 2; ++i) { const int e = tid + 512 * i, j = e >> 4, d0 = (e & 15) * 8; float v[8]; ld8(hin + (t0 + j) * DINP + C_RV + h * 128 + d0, v); st8(VV + j * LP + d0, v); }
    __syncthreads();
    const float lg = ret_lg(h);
#pragma unroll 4
    for (int i = 0; i < 16; ++i) { const int e = tid + 512 * i, j = e >> 7, d = e & 127; KD[j * LP + d] *= __expf(lg * (float)(63 - j)); }
    __syncthreads();
    state_mm<128>(KD, VV, (bf16_t*)(pws() + WS_STR) + (size_t)item * 16384);
    __syncthreads();
}
__device__ void cmp_item(const Params& p, int l, int item, float* lds) {
    const int mb = item & 63, kv = (item >> 6) & 1, b = (item >> 7) & 1, which = item >> 8; const int tid = otid();
    const bf16_t* hin = (const bf16_t*)(pws() + WS_HIN);
    const float* pe = pin(which ? 15 : 12) + l * 2048; const float* w2 = pin(which ? 17 : 14) + l * 256 * 64;
    float* dst = (float*)(pws() + (which ? WS_VCMP : WS_KCMP)) + (size_t)(b * 2 + kv) * 1024 * 64;
    const int colx = (which ? C_NVC : C_NKC) + kv * 64;
    bf16_t* AF = (bf16_t*)lds; float* HID = lds + 16448;
    const bf16_t* w1t = (const bf16_t*)(pws() + WS_W1T) + (size_t)((l * 2 + which) * 256) * 2048;
    const int tok0 = mb * 256;
#pragma unroll 2
    for (int i = 0; i < 8; ++i) { const int e = tid + 512 * i, r = e >> 8, rem = e & 255, pos = rem >> 3, d8 = (rem & 7) * 8; const int s = tok0 + 16 * r + pos;
        float x[8], pe8[8]; ldf8(pe + pos * 64 + d8, pe8);
        if (s < SEQ) ld8(hin + ((size_t)b * SEQ + s) * DINP + colx + d8, x); else {
#pragma unroll
            for (int k = 0; k < 8; ++k) x[k] = 0.f; }
        u32x4 w; w.x = pk2(x[0] + pe8[0], x[1] + pe8[1]); w.y = pk2(x[2] + pe8[2], x[3] + pe8[3]); w.z = pk2(x[4] + pe8[4], x[5] + pe8[5]); w.w = pk2(x[6] + pe8[6], x[7] + pe8[7]);
        *(u32x4*)(AF + r * 2056 + pos * 64 + d8) = w; }
    __syncthreads();
    { const int wid = tid >> 6, lane = tid & 63, fr = lane & 15, fq = lane >> 4;
      f32x4 acc0 = (f32x4){0.f, 0.f, 0.f, 0.f}, acc1 = acc0;
      const bf16_t* bp0 = w1t + (size_t)((2 * wid) * 16 + fr) * 2048 + fq * 8; const bf16_t* bp1 = bp0 + 16 * 2048; const bf16_t* ap = AF + fr * 2056 + fq * 8;
#pragma unroll 8
      for (int ks = 0; ks < 64; ++ks) { const bf16x8 av = *(const bf16x8*)(ap + ks * 32), b0 = *(const bf16x8*)(bp0 + ks * 32), b1 = *(const bf16x8*)(bp1 + ks * 32);
          acc0 = MFMA16(av, b0, acc0); acc1 = MFMA16(av, b1, acc1); }
#pragma unroll
      for (int j = 0; j < 4; ++j) { HID[(fq * 4 + j) * 256 + (2 * wid) * 16 + fr] = siluf(acc0[j]); HID[(fq * 4 + j) * 256 + (2 * wid + 1) * 16 + fr] = siluf(acc1[j]); } }
    __syncthreads();
    { const int e = tid & 63, r0 = tid >> 6; float o0 = 0.f, o1 = 0.f;
      for (int nn = 0; nn < 256; ++nn) { const float w = w2[nn * 64 + e]; o0 += HID[r0 * 256 + nn] * w; o1 += HID[(r0 + 8) * 256 + nn] * w; }
      const int m0 = mb * 16 + r0; if (m0 < 1023) dst[(size_t)m0 * 64 + e] = o0; if (m0 + 8 < 1023) dst[(size_t)(m0 + 8) * 64 + e] = o1;
      const float z0 = m0 < 1023 ? o0 : 0.f, z1 = m0 + 8 < 1023 ? o1 : 0.f; const int m1 = m0 + 8;
      if (which == 0) { bf16_t* kb = (bf16_t*)(pws() + WS_KCB) + (size_t)(b * 2 + kv) * 1024 * 64; kb[(size_t)m0 * 64 + e] = (bf16_t)(pk2(z0, 0.f) & 0xffffu); kb[(size_t)m1 * 64 + e] = (bf16_t)(pk2(z1, 0.f) & 0xffffu); }
      else { bf16_t* vt = (bf16_t*)(pws() + WS_VCT) + (size_t)(b * 2 + kv) * 16 * 4096; vt[(size_t)(m0 >> 6) * 4096 + e * 64 + (m0 & 63)] = (bf16_t)(pk2(z0, 0.f) & 0xffffu); vt[(size_t)(m1 >> 6) * 4096 + e * 64 + (m1 & 63)] = (bf16_t)(pk2(z1, 0.f) & 0xffffu); } }
    __syncthreads();
}
__device__ void vtr_item(const Params& p, int item, float* lds) {
    const int blk = item & 255, kv = (item >> 8) & 1, b = (item >> 9) & 1, which = item >> 10; const int tid = otid();
    const bf16_t* hin = (const bf16_t*)(pws() + WS_HIN); bf16_t* T = (bf16_t*)lds;
    { const int key = tid >> 3, d8 = (tid & 7) * 8; const u32x4 w = *(const u32x4*)(hin + ((size_t)b * SEQ + blk * 64 + key) * DINP + (which ? C_NVW : C_NVS) + kv * 64 + d8);
      T[(d8 + 0) * 72 + key] = (bf16_t)(w.x & 0xffffu); T[(d8 + 1) * 72 + key] = (bf16_t)(w.x >> 16); T[(d8 + 2) * 72 + key] = (bf16_t)(w.y & 0xffffu); T[(d8 + 3) * 72 + key] = (bf16_t)(w.y >> 16);
      T[(d8 + 4) * 72 + key] = (bf16_t)(w.z & 0xffffu); T[(d8 + 5) * 72 + key] = (bf16_t)(w.z >> 16); T[(d8 + 6) * 72 + key] = (bf16_t)(w.w & 0xffffu); T[(d8 + 7) * 72 + key] = (bf16_t)(w.w >> 16); }
    if (which == 0) {
        const int key = tid >> 3, d8 = (tid & 7) * 8; const u32x4 w = *(const u32x4*)(hin + ((size_t)b * SEQ + blk * 64 + key) * DINP + C_NKS + kv * 64 + d8);
        float a = (bflo(w.x) * bflo(w.x) + bfhi(w.x) * bfhi(w.x)) + (bflo(w.y) * bflo(w.y) + bfhi(w.y) * bfhi(w.y)) + (bflo(w.z) * bflo(w.z) + bfhi(w.z) * bfhi(w.z)) + (bflo(w.w) * bflo(w.w) + bfhi(w.w) * bfhi(w.w));
        a += dppf<0xB1>(a); a += dppf<0x4E>(a); a += dppf<0x141>(a);
        a = wave_maxf(a);
        if ((tid & 63) == 0) lds[4096 + (tid >> 6)] = a;
    }
    __syncthreads();
    if (which == 0 && tid == 0) { float m = 0.f; for (int w8 = 0; w8 < 8; ++w8) m = fmaxf(m, lds[4096 + w8]); ((float*)(pws() + WS_KNORM))[(b * 2 + kv) * 256 + blk] = sqrtf(m); }
    { const int dv = tid >> 3, k8 = (tid & 7) * 8; bf16_t* dst = (bf16_t*)(pws() + (which ? WS_VWT : WS_VST)) + ((size_t)((b * 2 + kv) * 256 + blk)) * 4096;
      *(u32x4*)(dst + dv * 64 + k8) = *(const u32x4*)(T + dv * 72 + k8); }
    __syncthreads();
}
__device__ void mixer_phase_pre(const Params& p, int l, float* lds) {
    for (int it = obid(); it < 512 + 2048; it += gridDim.x) { if (it < 512) cmp_item(p, l, it, lds); else vtr_item(p, it - 512, lds); }
    conv_prepass(p, l);
}
__device__ void mixer_phase_a(const Params& p, int l, float* lds) {
    for (int it = obid() + 512; it < 8704; it += gridDim.x) {
        if (it < 512) { for (int r = 0; r < 1 + (AREP & 1); ++r) cmp_item(p, l, it, lds); }
        else if (it < 2560) { for (int r = 0; r < 1 + ((AREP >> 1) & 1); ++r) hg_state_item(p, l, it - 512, lds); }
        else if (it < 6656) { for (int r = 0; r < 1 + ((AREP >> 2) & 1); ++r) ssd_state_item(p, l, it - 2560, lds); }
        else { for (int r = 0; r < 1 + ((AREP >> 3) & 1); ++r) ret_state_item(p, l, it - 6656, lds); }
    }
}
__device__ void scan_phase(const Params& p) {
    for (int wt = obid() + (int)gridDim.x * (otid() >> 6); wt < 1536; wt += (int)gridDim.x * 8) {
        const int task = wt * 64 + (otid() & 63);
        const int br = task >> 15, r = task & 32767;
        bf16_t* base; size_t cstride; const float* decp = nullptr; int dstride = 0; float dconst = 0.f;
        if (br == 0) { const int bh = r >> 12, e4 = r & 4095; base = (bf16_t*)(pws() + WS_STH) + (size_t)bh * 256 * 16384 + e4 * 4; cstride = 16384;
            decp = (const float*)(pws() + WS_DECH) + (size_t)bh * 256 * 128 + ((e4 * 4) >> 7); dstride = 128; }
        else if (br == 1) { const int bh = r >> 11, e4 = r & 2047; base = (bf16_t*)(pws() + WS_STS) + (size_t)bh * 256 * 8192 + e4 * 4; cstride = 8192;
            decp = (const float*)(pws() + WS_DECS) + (size_t)bh * 256; dstride = 1; }
        else { const int bh = r >> 12, e4 = r & 4095; base = (bf16_t*)(pws() + WS_STR) + (size_t)bh * 256 * 16384 + e4 * 4; cstride = 16384; dconst = __expf(64.f * ret_lg(bh & 3)); }
        float s0 = 0.f, s1 = 0.f, s2 = 0.f, s3 = 0.f;
#pragma unroll 8
        for (int c = 0; c < 256; ++c) {
            u32x2* ptr = (u32x2*)(base + (size_t)c * cstride); const u32x2 w = *ptr; const float dec = decp ? decp[(size_t)c * dstride] : dconst;
            u32x2 o; o.x = pk2(s0, s1); o.y = pk2(s2, s3); *ptr = o;
            s0 = dec * s0 + bflo(w.x); s1 = dec * s1 + bfhi(w.x); s2 = dec * s2 + bflo(w.y); s3 = dec * s3 + bfhi(w.y);
        }
    }
}
constexpr int AP = 68;
__device__ __forceinline__ void scores_plain(const float* QS, const float* KS, float (&acc)[2][4]) {
    const int tid = otid(), ti = tid >> 4, tj = tid & 15;
#pragma unroll
    for (int a = 0; a < 2; ++a)
#pragma unroll
        for (int jj = 0; jj < 4; ++jj) acc[a][jj] = 0.f;
    for (int d = 0; d < 128; d += 4) {
        f32x4 q[2], k[4];
#pragma unroll
        for (int a = 0; a < 2; ++a) q[a] = *(const f32x4*)(QS + (ti + 32 * a) * LP + d);
#pragma unroll
        for (int jj = 0; jj < 4; ++jj) k[jj] = *(const f32x4*)(KS + (tj + 16 * jj) * LP + d);
#pragma unroll
        for (int a = 0; a < 2; ++a)
#pragma unroll
            for (int jj = 0; jj < 4; ++jj) { if (a == 0 && jj >= 2) continue;
                acc[a][jj] += (q[a][0] * k[jj][0] + q[a][1] * k[jj][1]) + (q[a][2] * k[jj][2] + q[a][3] * k[jj][3]); }
    }
}
__device__ __forceinline__ void scores_hg(const float* QS, const float* KS, const float* BB, float (&acc)[2][4]) {
    const int tid = otid(), ti = tid >> 4, tj = tid & 15;
#pragma unroll
    for (int a = 0; a < 2; ++a)
#pragma unroll
        for (int jj = 0; jj < 4; ++jj) acc[a][jj] = 0.f;
    for (int d = 0; d < 128; d += 4) {
        f32x4 q[2], bi[2], k[4], bj[4];
#pragma unroll
        for (int a = 0; a < 2; ++a) { q[a] = *(const f32x4*)(QS + (ti + 32 * a) * LP + d); bi[a] = *(const f32x4*)(BB + (ti + 32 * a) * LP + d); }
#pragma unroll
        for (int jj = 0; jj < 4; ++jj) { k[jj] = *(const f32x4*)(KS + (tj + 16 * jj) * LP + d); bj[jj] = *(const f32x4*)(BB + (tj + 16 * jj) * LP + d); }
#pragma unroll
        for (int a = 0; a < 2; ++a)
#pragma unroll
            for (int jj = 0; jj < 4; ++jj) { if (a == 0 && jj >= 2) continue;
#pragma unroll
                for (int x = 0; x < 4; ++x) acc[a][jj] += q[a][x] * k[jj][x] * __expf(fminf(bi[a][x] - bj[jj][x], 0.f)); }
    }
}
template <int DV> __device__ __forceinline__ void load_sprev(const bf16_t* src, float* SP) {
    const int tid = otid();
    for (int e = tid; e < 128 * DV / 4; e += 512) { const int d = e / (DV / 4), v4 = e % (DV / 4); const u32x2 w = *(const u32x2*)(src + (size_t)d * DV + v4 * 4);
        *(f32x4*)(SP + d * (DV + 4) + v4 * 4) = (f32x4){bflo(w.x), bfhi(w.x), bflo(w.y), bfhi(w.y)}; }
}
template <int DV, bool VBF> __device__ __forceinline__ void out_mm(const float* AA, const void* VVp, const float* QS, const float* SP, f32x4 (&intra)[2][DV / 64], f32x4 (&inter)[2][DV / 64]) {
    const int tid = otid(), ti = tid >> 4, tv = tid & 15; constexpr int NV = DV / 64;
#pragma unroll
    for (int a = 0; a < 2; ++a)
#pragma unroll
        for (int n = 0; n < NV; ++n) { intra[a][n] = (f32x4){0.f, 0.f, 0.f, 0.f}; inter[a][n] = (f32x4){0.f, 0.f, 0.f, 0.f}; }
    for (int j = 0; j < 64; j += 4) {
        f32x4 a4[2];
#pragma unroll
        for (int a = 0; a < 2; ++a) a4[a] = *(const f32x4*)(AA + (ti + 32 * a) * AP + j);
#pragma unroll
        for (int x = 0; x < 4; ++x)
#pragma unroll
            for (int n = 0; n < NV; ++n) { f32x4 v;
                if (VBF) { const u32x2 w = *(const u32x2*)((const bf16_t*)VVp + (j + x) * 136 + n * 64 + tv * 4); v = (f32x4){bflo(w.x), bfhi(w.x), bflo(w.y), bfhi(w.y)}; }
                else v = *(const f32x4*)((const float*)VVp + (j + x) * AP + n * 64 + tv * 4);
#pragma unroll
                for (int a = 0; a < 2; ++a) intra[a][n] += v * a4[a][x]; }
    }
    for (int d = 0; d < 128; d += 4) {
        f32x4 q4[2];
#pragma unroll
        for (int a = 0; a < 2; ++a) q4[a] = *(const f32x4*)(QS + (ti + 32 * a) * LP + d);
#pragma unroll
        for (int x = 0; x < 4; ++x)
#pragma unroll
            for (int n = 0; n < NV; ++n) { const f32x4 s = *(const f32x4*)(SP + (d + x) * (DV + 4) + n * 64 + tv * 4);
#pragma unroll
                for (int a = 0; a < 2; ++a) inter[a][n] += s * q4[a][x]; }
    }
}
__device__ __forceinline__ float red16(float v) { v += dppf<0xB1>(v); v += dppf<0x4E>(v); v += dppf<0x141>(v); v += dppf<0x140>(v); return v; }
__device__ __forceinline__ float max16(float v) { v = fmaxf(v, dppf<0xB1>(v)); v = fmaxf(v, dppf<0x4E>(v)); v = fmaxf(v, dppf<0x141>(v)); v = fmaxf(v, dppf<0x140>(v)); return v; }

__device__ void hg_out_item(const Params& p, int l, int item, float* lds) {
    const int c = item & 255, h = (item >> 8) & 3, b = item >> 10; const int tid = otid(), ti = tid >> 4, tj = tid & 15;
    const bf16_t* hin = (const bf16_t*)(pws() + WS_HIN); const size_t t0 = (size_t)b * SEQ + c * 64;
    float* QS = lds; float* KS = lds + 64 * LP; float* BB = lds + 2 * 64 * LP; float* AA = lds + 3 * 64 * LP; bf16_t* VV = (bf16_t*)(lds + 3 * 64 * LP + 64 * AP); float* SP = KS; const float* lbl = pin(10);
#pragma unroll
    for (int i = 0; i < 2; ++i) { const int e = tid + 512 * i, j = e >> 4, d0 = (e & 15) * 8;
        float z[8], q[8], lb[8], bb[8], kk[8]; ld8(hin + (t0 + j) * DINP + C_HF + h * 128 + d0, z); ld8(hin + (t0 + j) * DINP + C_HQ + h * 128 + d0, q); hg_lb8(lbl, l, h * 128 + d0, lb);
#pragma unroll
        for (int k = 0; k < 8; ++k) { const float sn = __builtin_amdgcn_rcpf(1.f + __expf(z[k])), sg = 1.f - sn; bb[k] = __logf(lb[k] + (1.f - lb[k]) * sg); kk[k] = (1.f - lb[k]) * sn; q[k] = siluf(q[k]); }
        st8(BB + j * LP + d0, bb); st8(KS + j * LP + d0, kk); st8(QS + j * LP + d0, q);
        *(u32x4*)(VV + j * 136 + d0) = *(const u32x4*)(hin + (t0 + j) * DINP + C_HI + h * 128 + d0); }
    __syncthreads();
    if (tid < 128) { float a = 0.f; for (int j = 0; j < 64; ++j) { a += BB[j * LP + tid]; BB[j * LP + tid] = a; } }
    __syncthreads();
    { float acc[2][4]; scores_hg(QS, KS, BB, acc);
#pragma unroll
      for (int a = 0; a < 2; ++a)
#pragma unroll
          for (int jj = 0; jj < 4; ++jj) { const int i = ti + 32 * a, j = tj + 16 * jj; AA[i * AP + j] = (j <= i) ? acc[a][jj] : 0.f; } }
    __syncthreads();
#pragma unroll 4
    for (int i = 0; i < 16; ++i) { const int e = tid + 512 * i, j = e >> 7, d = e & 127; QS[j * LP + d] *= __expf(BB[j * LP + d]); }
    __syncthreads();
    load_sprev<128>((const bf16_t*)(pws() + WS_STH) + (size_t)item * 16384, SP);
    __syncthreads();
    f32x4 intra[2][2], inter[2][2]; out_mm<128, true>(AA, VV, QS, SP, intra, inter);
    const int tv = tj; const float* ng = pin(11) + l * 512 + h * 128; bf16_t* mixed = (bf16_t*)(pws() + WS_XB);
#pragma unroll
    for (int a = 0; a < 2; ++a) { const int i = ti + 32 * a; f32x4 o[2]; float ss = 0.f;
#pragma unroll
        for (int n = 0; n < 2; ++n) { o[n] = intra[a][n] + inter[a][n]; ss += (o[n][0] * o[n][0] + o[n][1] * o[n][1]) + (o[n][2] * o[n][2] + o[n][3] * o[n][3]); }
        ss = red16(ss); const float r = rsqrtf(ss * (1.f / 128.f) + 1e-6f);
#pragma unroll
        for (int n = 0; n < 2; ++n) { const int v = n * 64 + tv * 4; const u32x2 gw = *(const u32x2*)(hin + (t0 + i) * DINP + C_HG + h * 128 + v); const f32x4 g4 = *(const f32x4*)(ng + v);
            const float r0 = o[n][0] * r * g4[0] * siluf(bflo(gw.x)), r1 = o[n][1] * r * g4[1] * siluf(bfhi(gw.x)), r2 = o[n][2] * r * g4[2] * siluf(bflo(gw.y)), r3 = o[n][3] * r * g4[3] * siluf(bfhi(gw.y));
            u32x2 w; w.x = pk2(r0, r1); w.y = pk2(r2, r3); *(u32x2*)(mixed + (t0 + i) * DM + h * 128 + v) = w; } }
    __syncthreads();
}
__device__ void ret_out_item(const Params& p, int l, int item, float* lds) {
    const int c = item & 255, h = (item >> 8) & 3, b = item >> 10; const int tid = otid(), ti = tid >> 4, tj = tid & 15;
    const bf16_t* hin = (const bf16_t*)(pws() + WS_HIN); const size_t t0 = (size_t)b * SEQ + c * 64;
    float* QS = lds; float* KS = lds + 64 * LP; float* AA = lds + 3 * 64 * LP; bf16_t* VV = (bf16_t*)(lds + 3 * 64 * LP + 64 * AP); float* SP = KS; float* TH = lds + 3 * 64 * LP + 64 * AP + 64 * AP;
    fill_theta(TH);
    __syncthreads();
    load_rotary(hin, t0, c * 64, C_RQ + h * 128, 1.0f, QS, TH);
    load_rotary(hin, t0, c * 64, C_RK + h * 128, 0.08838834764831845f, KS, TH);
#pragma unroll
    for (int i = 0; i < 2; ++i) { const int e = tid + 512 * i, j = e >> 4, d0 = (e & 15) * 8; *(u32x4*)(VV + j * 136 + d0) = *(const u32x4*)(hin + (t0 + j) * DINP + C_RV + h * 128 + d0); }
    __syncthreads();
    const float lg = ret_lg(h);
    { float acc[2][4]; scores_plain(QS, KS, acc);
#pragma unroll
      for (int a = 0; a < 2; ++a)
#pragma unroll
          for (int jj = 0; jj < 4; ++jj) { const int i = ti + 32 * a, j = tj + 16 * jj; AA[i * AP + j] = (j <= i) ? acc[a][jj] * __expf(lg * (float)(i - j)) : 0.f; } }
    __syncthreads();
    load_sprev<128>((const bf16_t*)(pws() + WS_STR) + (size_t)item * 16384, SP);
    __syncthreads();
    f32x4 intra[2][2], inter[2][2]; out_mm<128, true>(AA, VV, QS, SP, intra, inter);
    const int tv = tj; bf16_t* mixed = (bf16_t*)(pws() + WS_XB);
#pragma unroll
    for (int a = 0; a < 2; ++a) { const int i = ti + 32 * a; const float sc = __expf(lg * (float)(i + 1)); f32x4 o[2]; float s = 0.f;
#pragma unroll
        for (int n = 0; n < 2; ++n) { o[n] = intra[a][n] + inter[a][n] * sc; s += (o[n][0] + o[n][1]) + (o[n][2] + o[n][3]); }
        s = red16(s); const float mu = s * (1.f / 128.f); float q = 0.f;
#pragma unroll
        for (int n = 0; n < 2; ++n) { const f32x4 d = o[n] - mu; q += (d[0] * d[0] + d[1] * d[1]) + (d[2] * d[2] + d[3] * d[3]); }
        q = red16(q); const float r = rsqrtf(q * (1.f / 128.f) + 1e-5f);
#pragma unroll
        for (int n = 0; n < 2; ++n) { const int v = n * 64 + tv * 4; const u32x2 gw = *(const u32x2*)(hin + (t0 + i) * DINP + C_RG + h * 128 + v);
            const float r0 = (o[n][0] - mu) * r * siluf(bflo(gw.x)), r1 = (o[n][1] - mu) * r * siluf(bfhi(gw.x)), r2 = (o[n][2] - mu) * r * siluf(bflo(gw.y)), r3 = (o[n][3] - mu) * r * siluf(bfhi(gw.y));
            u32x2 w; w.x = pk2(r0, r1); w.y = pk2(r2, r3); *(u32x2*)(mixed + (t0 + i) * DM + 1536 + h * 128 + v) = w; } }
    __syncthreads();
}
__device__ void ssd_out_item(const Params& p, int l, int item, float* lds) {
    const int c = item & 255, g = (item >> 8) & 1, b = item >> 9; const int tid = otid(), ti = tid >> 4, tj = tid & 15, tv = tj;
    const bf16_t* hin = (const bf16_t*)(pws() + WS_HIN); const size_t t0 = (size_t)b * SEQ + c * 64;
    const bf16_t* xbc = (const bf16_t*)(pws() + WS_XBC);
    float* CM = lds; float* BM = lds + 8448; float* SP = BM; float* G = lds + 17152; float* AH = lds + 21504; float* VV = lds + 25856; float* XS = lds + 30208; float* AUX = lds + 34560;
    if (tid < 256) { const int hh = tid >> 6, j = tid & 63, h = g * 4 + hh; const float dtv = softplusf(bf2f(hin[(t0 + j) * DINP + C_SDT + h]) + pin(22)[l * 8 + h]);
        AUX[hh * 64 + j] = dtv; AUX[512 + hh * 64 + j] = -dtv * __expf(pin(23)[l * 8 + h]); }
#pragma unroll
    for (int i = 0; i < 2; ++i) { const int e = tid + 512 * i, j = e >> 4, n0 = (e & 15) * 8; float x[8];
        ld8(xbc + ((size_t)b * SEQ + c * 64 + j) * 1024 + 768 + g * 128 + n0, x); st8(CM + j * LP + n0, x);
        ld8(xbc + ((size_t)b * SEQ + c * 64 + j) * 1024 + 512 + g * 128 + n0, x); st8(BM + j * LP + n0, x); }
    __syncthreads();
    if (tid < 256) { const int hh = tid >> 6, j = tid & 63; float a = 0.f; for (int jj = 0; jj <= j; ++jj) a += AUX[512 + hh * 64 + jj]; AUX[256 + hh * 64 + j] = a; }
    { float acc[2][4]; scores_plain(CM, BM, acc);
#pragma unroll
      for (int a = 0; a < 2; ++a)
#pragma unroll
          for (int jj = 0; jj < 4; ++jj) G[(ti + 32 * a) * AP + tj + 16 * jj] = acc[a][jj]; }
    __syncthreads();
    float ss[2] = {0.f, 0.f}; bf16_t* mixed = (bf16_t*)(pws() + WS_XB);
#pragma unroll 1
    for (int hh = 0; hh < 4; ++hh) {
        const int h = g * 4 + hh; const float* dt = AUX + hh * 64; const float* cb = AUX + 256 + hh * 64;
#pragma unroll 2
        for (int i = 0; i < 8; ++i) { const int e = tid + 512 * i, ii = e >> 6, j = e & 63; AH[ii * AP + j] = (j <= ii) ? G[ii * AP + j] * __expf(cb[ii] - cb[j]) : 0.f; }
        { const int j = tid >> 3, pc0 = (tid & 7) * 8; float x[8]; ld8(xbc + ((size_t)b * SEQ + c * 64 + j) * 1024 + h * 64 + pc0, x); st8(XS + j * AP + pc0, x); const float f = dt[j];
#pragma unroll
          for (int k = 0; k < 8; ++k) x[k] *= f;
          st8(VV + j * AP + pc0, x); }
        load_sprev<64>((const bf16_t*)(pws() + WS_STS) + (size_t)(((b * 8 + h) << 8) + c) * 8192, SP);
        __syncthreads();
        f32x4 intra[2][1], inter[2][1]; out_mm<64, false>(AH, VV, CM, SP, intra, inter);
        const float dsk = pin(24)[l * 8 + h];
#pragma unroll
        for (int a = 0; a < 2; ++a) { const int i = ti + 32 * a; const f32x4 xs = *(const f32x4*)(XS + i * AP + tv * 4); const u32x2 zw = *(const u32x2*)(hin + (t0 + i) * DINP + C_SZ + h * 64 + tv * 4);
            f32x4 o = intra[a][0] + inter[a][0] * __expf(cb[i]) + xs * dsk;
            o[0] *= siluf(bflo(zw.x)); o[1] *= siluf(bfhi(zw.x)); o[2] *= siluf(bflo(zw.y)); o[3] *= siluf(bfhi(zw.y));
            ss[a] += (o[0] * o[0] + o[1] * o[1]) + (o[2] * o[2] + o[3] * o[3]);
            u32x2 w; w.x = pk2(o[0], o[1]); w.y = pk2(o[2], o[3]); *(u32x2*)(mixed + (t0 + i) * DM + 1024 + g * 256 + hh * 64 + tv * 4) = w; }
        __syncthreads();
    }
    const float* ng = pin(25) + l * 512 + g * 256;
#pragma unroll
    for (int a = 0; a < 2; ++a) { const int i = ti + 32 * a; const float r = rsqrtf(red16(ss[a]) * (1.f / 256.f) + 1e-6f);
#pragma unroll 1
        for (int hh = 0; hh < 4; ++hh) { const f32x4 g4 = *(const f32x4*)(ng + hh * 64 + tv * 4); u32x2* ptr = (u32x2*)(mixed + (t0 + i) * DM + 1024 + g * 256 + hh * 64 + tv * 4); const u32x2 yw = *ptr;
            const f32x4 o = (f32x4){bflo(yw.x), bfhi(yw.x), bflo(yw.y), bfhi(yw.y)} * r * g4;
            u32x2 w; w.x = pk2(o[0], o[1]); w.y = pk2(o[2], o[3]); *ptr = w; } }
    __syncthreads();
}
#ifndef WREP
#define WREP 1
#endif
#ifndef TREP
#define TREP 1
#endif
#ifndef SREP
#define SREP 1
#endif
__device__ __forceinline__ int t5_bucket(int dist) {
    if (dist < 16) return dist;
    const int lg = 16 + (int)(__log2f((float)dist * 0.0625f) * 2.2857142857142856f);
    return lg < 31 ? lg : 31;
}
__device__ __forceinline__ float dot64_bf(const float (&q)[64], const bf16_t* kp) {
    float s0 = 0.f, s1 = 0.f;
#pragma unroll
    for (int i = 0; i < 8; ++i) { const u32x4 w = *(const u32x4*)(kp + i * 8);
        s0 += (q[8 * i + 0] * bflo(w.x) + q[8 * i + 2] * bflo(w.y)) + (q[8 * i + 4] * bflo(w.z) + q[8 * i + 6] * bflo(w.w));
        s1 += (q[8 * i + 1] * bfhi(w.x) + q[8 * i + 3] * bfhi(w.y)) + (q[8 * i + 5] * bfhi(w.z) + q[8 * i + 7] * bfhi(w.w)); }
    return s0 + s1;
}
__device__ __forceinline__ float dot64_f(const float (&q)[64], const float* kp) {
    float s0 = 0.f, s1 = 0.f;
#pragma unroll
    for (int i = 0; i < 16; ++i) { const f32x4 w = *(const f32x4*)(kp + i * 4); s0 += q[4 * i] * w[0] + q[4 * i + 2] * w[2]; s1 += q[4 * i + 1] * w[1] + q[4 * i + 3] * w[3]; }
    return s0 + s1;
}
__device__ __forceinline__ float softmax_row(float* scr, int ks, int n, float mx_local) {
    const float mx = max16(mx_local); float sum = 0.f;
    for (int idx = ks; idx < n; idx += 16) { const float e = __expf(scr[idx] - mx); scr[idx] = e; sum += e; }
    sum = red16(sum);
    return n > 0 ? 1.f / sum : 0.f;
}
constexpr float NEG_BIG = -1.0e30f;
__device__ __forceinline__ bf16_t f2bf(float x) { return (bf16_t)(pk2(x, 0.f) & 0xffffu); }
__device__ __forceinline__ void ld_k(const bf16_t* kbase, int kpitch, int fr, int fq, bf16x8 (&kb)[4][2]) {
#pragma unroll
    for (int nt = 0; nt < 4; ++nt)
#pragma unroll
        for (int ks = 0; ks < 2; ++ks) kb[nt][ks] = *(const bf16x8*)(kbase + (nt * 16 + fr) * kpitch + ks * 32 + fq * 8);
}
__device__ __forceinline__ void ld_v(const bf16_t* vt, int fr, int fq, bf16x8 (&vb)[4][2]) {
#pragma unroll
    for (int nt = 0; nt < 4; ++nt)
#pragma unroll
        for (int ks = 0; ks < 2; ++ks) vb[nt][ks] = *(const bf16x8*)(vt + (nt * 16 + fr) * 64 + ks * 32 + fq * 8);
}
__device__ __forceinline__ void mma_qk(const bf16x8 (&qa)[2][2], const bf16x8 (&kb)[4][2], f32x4 (&s)[2][4]) {
#pragma unroll
    for (int mt = 0; mt < 2; ++mt)
#pragma unroll
        for (int nt = 0; nt < 4; ++nt) { f32x4 c = (f32x4){0.f, 0.f, 0.f, 0.f};
#pragma unroll
            for (int ks = 0; ks < 2; ++ks) c = MFMA16(qa[mt][ks], kb[nt][ks], c);
            s[mt][nt] = c; }
}
__device__ __forceinline__ void mma_pv(const bf16_t* Pl, const bf16x8 (&vb)[4][2], int fr, int fq, f32x4 (&o)[2][4]) {
    bf16x8 pa[2][2];
#pragma unroll
    for (int mt = 0; mt < 2; ++mt)
#pragma unroll
        for (int ks = 0; ks < 2; ++ks) pa[mt][ks] = *(const bf16x8*)(Pl + (mt * 16 + fr) * 72 + ks * 32 + fq * 8);
#pragma unroll
    for (int nt = 0; nt < 4; ++nt)
#pragma unroll
        for (int ks = 0; ks < 2; ++ks)
#pragma unroll
            for (int mt = 0; mt < 2; ++mt) o[mt][nt] = MFMA16(pa[mt][ks], vb[nt][ks], o[mt][nt]);
}
__device__ void nsa_unit(const Params& p, int l, int item, float* ldsf) {
    int b = item >> 8, qt = item & 255; if (b) qt = 255 - qt;
    const int tid = otid(), wid = tid >> 6, lane = tid & 63, fr = lane & 15, fq = lane >> 4;
    unsigned char* wb = (unsigned char*)ldsf + wid * 16384;
    bf16_t* Pl = (bf16_t*)wb; float* IMP = (float*)(wb + 4608); float* OSEL = IMP; float* PS = (float*)(wb + 12928); int* SEL = (int*)(wb + 15104); int* NSEL = (int*)(wb + 15616);
    float* RB = ldsf + 32768; float* LSUM = ldsf + 33024; float* BND = ldsf + 33280; unsigned long long* QM = (unsigned long long*)(ldsf + 33536); const unsigned char* BK = (const unsigned char*)(ldsf + 34048);
    if (tid < 256) RB[tid] = pin(19)[tid];
    { unsigned char* BKw = (unsigned char*)(ldsf + 34048);
#pragma unroll
      for (int k = 0; k < 4; ++k) BKw[tid * 4 + k] = (unsigned char)t5_bucket(tid * 4 + k); }
    __syncthreads();
    const bf16_t* hin = (const bf16_t*)(pws() + WS_HIN); bf16_t* mixed = (bf16_t*)(pws() + WS_XB);
    const int q0 = qt * 64 + wid * 8; const int tb = b * SEQ;
    float ss[2] = {0.f, 0.f};
#pragma unroll 1
    for (int kv = 0; kv < 2; ++kv) {
        if (tid < 256) QM[tid] = (unsigned long long)(unsigned)(tid >> 20);
        bf16x8 qa[2][2];
#pragma unroll
        for (int mt = 0; mt < 2; ++mt)
#pragma unroll
            for (int ks = 0; ks < 2; ++ks) qa[mt][ks] = *(const bf16x8*)(hin + (tb + q0 + mt * 4 + (fr >> 2)) * DINP + C_NQ + (kv * 4 + (fr & 3)) * 64 + ks * 32 + fq * 8);
        f32x4 ofin[2][4];
        {
            f32x4 (&o)[2][4] = ofin; float m[2][4], ls[2][4];
#pragma unroll
            for (int mt = 0; mt < 2; ++mt) {
#pragma unroll
                for (int nt = 0; nt < 4; ++nt) o[mt][nt] = (f32x4){0.f, 0.f, 0.f, 0.f};
#pragma unroll
                for (int j = 0; j < 4; ++j) { m[mt][j] = NEG_BIG; ls[mt][j] = 0.f; } }
            bf16x8 kb[4][2]; ld_k(hin + (tb + (qt >= 8 ? qt - 8 : 0) * 64) * DINP + C_NKW + kv * 64, DINP, fr, fq, kb);
#pragma unroll 1
            for (int kt = (qt >= 8 ? qt - 8 : 0); kt <= qt; ++kt) {
                bf16x8 vb[4][2]; ld_v((const bf16_t*)(pws() + WS_VWT) + ((size_t)((b * 2 + kv) * 256 + kt)) * 4096, fr, fq, vb);
                f32x4 s[2][4]; mma_qk(qa, kb, s);
#pragma unroll
                for (int mt = 0; mt < 2; ++mt) {
                    const int qpos = q0 + mt * 4 + fq; bool ok[4]; float tmax[4] = {NEG_BIG, NEG_BIG, NEG_BIG, NEG_BIG};
#pragma unroll
                    for (int nt = 0; nt < 4; ++nt) { const int dist = qpos - (kt * 64 + nt * 16 + fr); ok[nt] = dist >= 0 && dist < 512;
                        const f32x4 bias = *(const f32x4*)(RB + (int)BK[dist < 0 ? 0 : (dist > 2047 ? 2047 : dist)] * 8 + kv * 4);
#pragma unroll
                        for (int j = 0; j < 4; ++j) { const float v = ok[nt] ? s[mt][nt][j] * 0.125f + bias[j] : NEG_BIG; s[mt][nt][j] = v; tmax[j] = fmaxf(tmax[j], v); } }
#pragma unroll
                    for (int j = 0; j < 4; ++j) { const float mn = fmaxf(m[mt][j], max16(tmax[j])); const float alpha = __expf(m[mt][j] - mn); m[mt][j] = mn; float rs = 0.f;
#pragma unroll
                        for (int nt = 0; nt < 4; ++nt) { const float pe = ok[nt] ? __expf(s[mt][nt][j] - mn) : 0.f; rs += pe; Pl[(mt * 16 + fq * 4 + j) * 72 + nt * 16 + fr] = f2bf(pe); o[mt][nt][j] *= alpha; }
                        ls[mt][j] = ls[mt][j] * alpha + red16(rs); }
                }
                __builtin_amdgcn_wave_barrier();
                if (kt < qt) ld_k(hin + (tb + (kt + 1) * 64) * DINP + C_NKW + kv * 64, DINP, fr, fq, kb);
                mma_pv(Pl, vb, fr, fq, o);
                __builtin_amdgcn_wave_barrier();
            }
#pragma unroll
            for (int mt = 0; mt < 2; ++mt)
#pragma unroll
                for (int j = 0; j < 4; ++j) { const float g2 = sigmf(bf2f(hin[(tb + q0 + mt * 4 + fq) * DINP + C_NGATE + (kv * 4 + j) * 3 + 2])); const float sc = ls[mt][j] > 0.f ? g2 / ls[mt][j] : 0.f;
#pragma unroll
                    for (int nt = 0; nt < 4; ++nt) ofin[mt][nt][j] *= sc; }
        }
        {
            const int nct = (4 * qt + 3 + 63) >> 6;
            const bf16_t* kc = (const bf16_t*)(pws() + WS_KCB) + (size_t)(b * 2 + kv) * 1024 * 64; const bf16_t* vct = (const bf16_t*)(pws() + WS_VCT) + (size_t)(b * 2 + kv) * 16 * 4096;
            float m[2][4], ls[2][4];
#pragma unroll
            for (int mt = 0; mt < 2; ++mt)
#pragma unroll
                for (int j = 0; j < 4; ++j) { m[mt][j] = NEG_BIG; ls[mt][j] = 0.f; }
            for (int e = lane; e < 8 * 260; e += 64) IMP[e] = 0.f;
            bf16x8 kb[4][2]; ld_k(kc, 64, fr, fq, kb);
#pragma unroll 1
            for (int ct = 0; ct < nct; ++ct) {
                f32x4 s[2][4]; mma_qk(qa, kb, s);
                ld_k(kc + (size_t)(ct + 1 < nct ? ct + 1 : 0) * 64 * 64, 64, fr, fq, kb);
#pragma unroll
                for (int mt = 0; mt < 2; ++mt) {
                    const int qpos = q0 + mt * 4 + fq; bool ok[4]; float tmax[4] = {NEG_BIG, NEG_BIG, NEG_BIG, NEG_BIG};
#pragma unroll
                    for (int nt = 0; nt < 4; ++nt) { const int dist = qpos - (16 * (ct * 64 + nt * 16 + fr) + 31); ok[nt] = dist >= 0;
                        const f32x4 bias = *(const f32x4*)(RB + (int)BK[dist < 0 ? 0 : (dist > 2047 ? 2047 : dist)] * 8 + kv * 4);
#pragma unroll
                        for (int j = 0; j < 4; ++j) { const float v = ok[nt] ? s[mt][nt][j] * 0.125f + bias[j] : NEG_BIG; s[mt][nt][j] = v; tmax[j] = fmaxf(tmax[j], v); } }
#pragma unroll
                    for (int j = 0; j < 4; ++j) { const float mn = fmaxf(m[mt][j], max16(tmax[j])); const float alpha = __expf(m[mt][j] - mn); m[mt][j] = mn; float rs = 0.f;
#pragma unroll
                        for (int nt = 0; nt < 4; ++nt) rs += ok[nt] ? __expf(s[mt][nt][j] - mn) : 0.f;
                        ls[mt][j] = ls[mt][j] * alpha + red16(rs); }
                }
            }
            float inv[2][4];
#pragma unroll
            for (int mt = 0; mt < 2; ++mt)
#pragma unroll
                for (int j = 0; j < 4; ++j) inv[mt][j] = ls[mt][j] > 0.f ? 1.f / ls[mt][j] : 0.f;
            float g0[2][4];
#pragma unroll
            for (int mt = 0; mt < 2; ++mt)
#pragma unroll
                for (int j = 0; j < 4; ++j) g0[mt][j] = sigmf(bf2f(hin[(tb + q0 + mt * 4 + fq) * DINP + C_NGATE + (kv * 4 + j) * 3 + 0]));
            __builtin_amdgcn_wave_barrier();
#pragma unroll 1
            for (int ct = 0; ct < nct; ++ct) {
                bf16x8 vb[4][2]; ld_v(vct + (size_t)ct * 4096, fr, fq, vb);
                f32x4 s[2][4]; mma_qk(qa, kb, s);
#pragma unroll
                for (int mt = 0; mt < 2; ++mt) {
                    const int qpos = q0 + mt * 4 + fq;
#pragma unroll
                    for (int nt = 0; nt < 4; ++nt) { const int dist = qpos - (16 * (ct * 64 + nt * 16 + fr) + 31); const bool ok = dist >= 0;
                        const f32x4 bias = *(const f32x4*)(RB + (int)BK[dist < 0 ? 0 : (dist > 2047 ? 2047 : dist)] * 8 + kv * 4); float psum = 0.f;
#pragma unroll
                        for (int j = 0; j < 4; ++j) { const float pe = ok ? __expf(s[mt][nt][j] * 0.125f + bias[j] - m[mt][j]) * inv[mt][j] : 0.f; psum += pe; Pl[(mt * 16 + fq * 4 + j) * 72 + nt * 16 + fr] = f2bf(pe * g0[mt][j]); }
                        PS[(mt * 4 + fq) * 68 + nt * 16 + fr] = psum; }
                }
                __builtin_amdgcn_wave_barrier();
                { const int qi = lane >> 3, l8 = lane & 7; const float* pr = PS + qi * 68; float* ir = IMP + qi * 260 + ct * 16;
#pragma unroll
                  for (int x = 0; x < 2; ++x) { const int jb = l8 + 8 * x; const f32x4 v = *(const f32x4*)(pr + 4 * jb); float a = (v[0] + v[1]) + (v[2] + 0.5f * v[3]); if (jb > 0) a += 0.5f * pr[4 * jb - 1]; ir[jb] += a; }
                  if (l8 == 0) ir[16] += 0.5f * pr[63]; }
                if (ct + 1 < nct) ld_k(kc + (size_t)(ct + 1) * 64 * 64, 64, fr, fq, kb);
                mma_pv(Pl, vb, fr, fq, ofin);
                __builtin_amdgcn_wave_barrier();
            }
        }
        __syncthreads();
        float* QN = PS;
        {
            if (lane < 32) { const bf16_t* qp = hin + (tb + q0 + (lane >> 2)) * DINP + C_NQ + (kv * 4 + (lane & 3)) * 64; float a = 0.f;
#pragma unroll
                for (int i = 0; i < 8; ++i) { const u32x4 w = *(const u32x4*)(qp + i * 8);
                    a += (bflo(w.x) * bflo(w.x) + bfhi(w.x) * bfhi(w.x)) + (bflo(w.y) * bflo(w.y) + bfhi(w.y) * bfhi(w.y)) + (bflo(w.z) * bflo(w.z) + bfhi(w.z) * bfhi(w.z)) + (bflo(w.w) * bflo(w.w) + bfhi(w.w) * bfhi(w.w)); }
                QN[lane] = sqrtf(a); }
            if (lane < 4) { float bm = 0.f; for (int bk = 0; bk < 32; ++bk) bm = fmaxf(bm, fabsf(RB[bk * 8 + kv * 4 + lane])); QN[32 + lane] = bm; }
        }
        __builtin_amdgcn_wave_barrier();
        const float* KN = (const float*)(pws() + WS_KNORM) + (b * 2 + kv) * 256;
#pragma unroll 1
        for (int qi = 0; qi < 8; ++qi) {
            const int qpos = q0 + qi, cur = qpos >> 6; unsigned long long key[4];
#pragma unroll
            for (int jj = 0; jj < 4; ++jj) { const int j = lane + 64 * jj; unsigned long long kk = 0ull;
                if (j <= cur) { const float val = (j == 0 || j == cur || j == cur - 1) ? 5.0f : IMP[qi * 260 + j]; kk = ((unsigned long long)(__float_as_uint(val) + 1u) << 32) | (unsigned)(255 - j); }
                key[jj] = kk; }
            float knmax = 0.f;
            for (int it = 0; it < 16; ++it) {
                unsigned long long best = key[0] > key[1] ? key[0] : key[1]; { const unsigned long long b2 = key[2] > key[3] ? key[2] : key[3]; best = b2 > best ? b2 : best; }
                best = wave_max_u64(best);
                if ((best >> 32) == 0ull) break;
                const int jsel = 255 - (int)(unsigned)(best & 0xffffffffull);
                if (lane == it) { lds_or64(QM + jsel, 1ull << (wid * 8 + qi)); knmax = KN[jsel]; }
#pragma unroll
                for (int jj = 0; jj < 4; ++jj) if (key[jj] == best) key[jj] = 0ull;
            }
            const float bq = wave_maxf(knmax);
            if (lane < 4) BND[(wid * 8 + qi) * 4 + lane] = QN[qi * 4 + lane] * bq * (0.125f * 1.002f) + QN[32 + lane] + 1e-3f;
        }
        __builtin_amdgcn_wave_barrier();
        for (int e = lane; e < 2048; e += 64) OSEL[e] = 0.f;
        if (lane < 32) LSUM[wid * 32 + lane] = 0.f;
        __syncthreads();
#pragma unroll 1
        for (int j = wid; j <= qt; j += 8) {
            unsigned long long mask; { const unsigned long long mv = QM[j]; mask = ((unsigned long long)(unsigned)__builtin_amdgcn_readfirstlane((unsigned)(mv >> 32)) << 32) | (unsigned long long)(unsigned)__builtin_amdgcn_readfirstlane((unsigned)mv); }
            if (mask == 0ull) continue;
            bf16x8 kb[4][2], vb[4][2]; ld_k(hin + (tb + j * 64) * DINP + C_NKS + kv * 64, DINP, fr, fq, kb); ld_v((const bf16_t*)(pws() + WS_VST) + ((size_t)((b * 2 + kv) * 256 + j)) * 4096, fr, fq, vb);
            const bool far = (qt * 64 - (j * 64 + 63)) >= 1536;
#pragma unroll 1
            while (mask != 0ull) {
                int q4[4];
#pragma unroll
                for (int g = 0; g < 4; ++g) { if (mask != 0ull) { q4[g] = __builtin_ctzll(mask); mask &= mask - 1ull; } else q4[g] = -1; }
                const int ga = fr >> 2; const int myq = ga == 0 ? q4[0] : ga == 1 ? q4[1] : ga == 2 ? q4[2] : q4[3];
                const int rq = fq == 0 ? q4[0] : fq == 1 ? q4[1] : fq == 2 ? q4[2] : q4[3];
                bf16x8 qs[2];
#pragma unroll
                for (int ks = 0; ks < 2; ++ks) { qs[ks] = (bf16x8){0, 0, 0, 0, 0, 0, 0, 0}; if (myq >= 0) qs[ks] = *(const bf16x8*)(hin + (tb + qt * 64 + myq) * DINP + C_NQ + (kv * 4 + (fr & 3)) * 64 + ks * 32 + fq * 8); }
                f32x4 s[4];
#pragma unroll
                for (int nt = 0; nt < 4; ++nt) { f32x4 c = (f32x4){0.f, 0.f, 0.f, 0.f};
#pragma unroll
                    for (int ks = 0; ks < 2; ++ks) c = MFMA16(qs[ks], kb[nt][ks], c);
                    s[nt] = c; }
                const f32x4 bnd = *(const f32x4*)(BND + (rq >= 0 ? rq : 0) * 4); const int qpos = qt * 64 + rq; float rs[4] = {0.f, 0.f, 0.f, 0.f};
#pragma unroll
                for (int nt = 0; nt < 4; ++nt) { const int dist = qpos - (j * 64 + nt * 16 + fr); const bool ok = rq >= 0 && dist >= 0;
                    const f32x4 bias = *(const f32x4*)(RB + (far ? 31 : (int)BK[dist < 0 ? 0 : (dist > 2047 ? 2047 : dist)]) * 8 + kv * 4);
#pragma unroll
                    for (int jj = 0; jj < 4; ++jj) { const float pe = ok ? __expf(s[nt][jj] * 0.125f + bias[jj] - bnd[jj]) : 0.f; rs[jj] += pe; Pl[(fq * 4 + jj) * 72 + nt * 16 + fr] = f2bf(pe); } }
#pragma unroll
                for (int jj = 0; jj < 4; ++jj) { const float r = red16(rs[jj]); if (fr == 0 && rq >= 0) lds_addf(LSUM + rq * 4 + jj, r); }
                __builtin_amdgcn_wave_barrier();
                bf16x8 pa[2];
#pragma unroll
                for (int ks = 0; ks < 2; ++ks) pa[ks] = *(const bf16x8*)(Pl + fr * 72 + ks * 32 + fq * 8);
                { float* ob = ldsf + ((rq >= 0 ? rq : 0) >> 3) * 4096 + 1152 + ((rq >= 0 ? rq : 0) & 7) * 256;
#pragma unroll
                    for (int nt = 0; nt < 4; ++nt) { f32x4 c = (f32x4){0.f, 0.f, 0.f, 0.f};
#pragma unroll
                        for (int ks = 0; ks < 2; ++ks) c = MFMA16(pa[ks], vb[nt][ks], c);
                        if (rq >= 0) {
#pragma unroll
                            for (int jj = 0; jj < 4; ++jj) lds_addf(ob + jj * 64 + nt * 16 + fr, c[jj]); } } }
                __builtin_amdgcn_wave_barrier();
            }
        }
        __syncthreads();
#pragma unroll
        for (int mt = 0; mt < 2; ++mt) { const int trow = (tb + q0 + mt * 4 + fq) * DM + 512 + kv * 256;
#pragma unroll
            for (int j = 0; j < 4; ++j) { const float g1 = sigmf(bf2f(hin[(tb + q0 + mt * 4 + fq) * DINP + C_NGATE + (kv * 4 + j) * 3 + 1])); const float lsum = LSUM[(wid * 8 + mt * 4 + fq) * 4 + j]; const float scl = lsum > 0.f ? g1 / lsum : 0.f;
#pragma unroll
                for (int nt = 0; nt < 4; ++nt) { const float v = ofin[mt][nt][j] + OSEL[((mt * 4 + fq) * 4 + j) * 64 + nt * 16 + fr] * scl; ss[mt] += v * v; mixed[trow + j * 64 + nt * 16 + fr] = f2bf(v); } } }
        __syncthreads();
    }
    const float* ng = pin(18) + l * 512;
#pragma unroll
    for (int mt = 0; mt < 2; ++mt) { const float r = rsqrtf(red16(ss[mt]) * (1.f / 512.f) + 1e-6f); const int trow = (tb + q0 + mt * 4 + fq) * DM + 512;
#pragma unroll 4
        for (int c = 0; c < 32; ++c) { const int col = c * 16 + fr; mixed[trow + col] = f2bf(bf2f(mixed[trow + col]) * r * ng[col]); } }
    __syncthreads();
}
#ifndef NSA_REP
#define NSA_REP 1
#endif
template <int PCM> __device__ __forceinline__ void mixer_phase_c_item(const Params& p, int l, int it, float* lds);
template <int PCM> __device__ __forceinline__ void mixer_phase_c(const Params& p, int l, float* lds) {
    if (PCM == 15) {
        unsigned* ctr = (unsigned*)(pws() + WS_BAR) + 16 + 16 * l;
        for (;;) {
            if (otid() == 0) ((volatile int*)lds)[36000] = (int)__hip_atomic_fetch_add(ctr, 1u, __ATOMIC_RELAXED, __HIP_MEMORY_SCOPE_AGENT);
            __syncthreads();
            const int it = __builtin_amdgcn_readfirstlane(((volatile int*)lds)[36000]);
            __syncthreads();
            if (it >= 5632) break;
            mixer_phase_c_item<PCM>(p, l, it, lds);
        }
        return;
    }
    for (int it = obid(); it < 5632; it += gridDim.x) mixer_phase_c_item<PCM>(p, l, it, lds);
}
template <int PCM> __device__ __forceinline__ void mixer_phase_c_item(const Params& p, int l, int it, float* lds) {
    {
        if (it < 512) { if (PCM & 1) { const int u = (it & 1) ? 256 + (it >> 1) : 255 - (it >> 1);
            for (int rep = 0; rep < NSA_REP; ++rep) nsa_unit(p, l, u, lds); } }
        else if (it < 1536) { if (PCM & 4) { for (int r = 0; r < 1 + ((CREP >> 1) & 1); ++r) ssd_out_item(p, l, it - 512, lds); } }
        else if (it < 3584) { if (PCM & 2) { for (int r = 0; r < 1 + (CREP & 1); ++r) hg_out_item(p, l, it - 1536, lds); } }
        else { if (PCM & 8) { for (int r = 0; r < 1 + ((CREP >> 2) & 1); ++r) ret_out_item(p, l, it - 3584, lds); } }
    }
}
#ifndef REPEAT_MASK
#define REPEAT_MASK 0
#endif
constexpr int NPHASE = 1 + 13 * NLAYER;
__device__ __forceinline__ void grid_bar(unsigned* ctr, unsigned target) {
    asm volatile("s_waitcnt vmcnt(0) lgkmcnt(0)" ::: "memory");
    __syncthreads();
    if (threadIdx.x == 0) {
        __builtin_amdgcn_fence(__ATOMIC_RELEASE, "agent");
        asm volatile("s_waitcnt vmcnt(0)" ::: "memory");
        __hip_atomic_fetch_add(ctr, 1u, __ATOMIC_RELAXED, __HIP_MEMORY_SCOPE_AGENT);
        unsigned spins = 0;
        while (__hip_atomic_load(ctr, __ATOMIC_RELAXED, __HIP_MEMORY_SCOPE_AGENT) < target) { __builtin_amdgcn_s_sleep(2); if (++spins > (1u << 22)) break; }
        __builtin_amdgcn_fence(__ATOMIC_ACQUIRE, "agent");
        asm volatile("s_waitcnt vmcnt(0)" ::: "memory");
    }
    __syncthreads();
}
template <int PHM> __global__ void __launch_bounds__(NTHREADS, 2) mega_fwd(Params p) {
    extern __shared__ __attribute__((aligned(16))) unsigned char lds_raw[];
    if (threadIdx.x == 0) {
#pragma unroll
        for (int k = 0; k < 31; ++k) g_ptab[k] = (unsigned long long)p.in[k];
        g_ptab[31] = (unsigned long long)p.out; g_ptab[32] = (unsigned long long)p.ws; }
    __syncthreads();
    float* ldsf = (float*)lds_raw; LAS unsigned char* ldsl = (LAS unsigned char*)lds_raw;
        unsigned nbar = 0;
    for (int ph = p.ph_lo; ph < p.ph_hi; ++ph) {
        if (ph == 0 && (PHM & 1)) { cvt_x(p); cvt_ffn(p, 0, 0, ldsf); cvt_mix(p, 0, ldsf); cvt_w1t(p, ldsf); }
        else {
            bf16_t* XB = (bf16_t*)(pws() + WS_XB); bf16_t* HIN = (bf16_t*)(pws() + WS_HIN);
            const int l = (ph - 1) / 13, s = (ph - 1) % 13;
            for (int rep = 0; rep < (((REPEAT_MASK >> s) & 1) ? 2 : 1); ++rep) {
            if ((s == 0 || s == 10) && (PHM & 2)) {
                pg8::Gemm g{XB, (const bf16_t*)(pws() + WS_WA), NTOK, 11264, DM}; pg8::StaticOrder S; S.init(NTOK, 11264, (int)gridDim.x, (int)obid());
                EpiUp E{HIN}; pg8::gemm_phase<EpiUp, pg8::StaticOrder>(ldsl, g, S, E, nullptr);
            } else if ((s == 1 || s == 11 || s == 8) && (PHM & 4)) {
                const bool mix = (s == 8);
                pg8::Gemm g{mix ? XB : HIN, (const bf16_t*)(pws() + (mix ? WS_WD : WS_WB)), NTOK, DM, mix ? DM : DFF}; pg8::StaticOrder S; S.init(NTOK, DM, (int)gridDim.x, (int)obid());
                EpiRes E{(l == 0 && s == 1) ? pin(0) : (mix ? (const float*)pout() : nullptr), XB, pout(), ALPHA, mix ? 1.0f : 0.5f}; pg8::gemm_phase<EpiRes, pg8::StaticOrder>(ldsl, g, S, E, nullptr);
            } else if (s == 3 && (PHM & 8)) {
                pg8::Gemm g{XB, (const bf16_t*)(pws() + WS_WC), NTOK, DINP, DM}; pg8::StaticOrder S; S.init(NTOK, DINP, (int)gridDim.x, (int)obid());
                pg8::EpiBf16<0> E{HIN, DINP, nullptr, 0, 0}; pg8::gemm_phase<pg8::EpiBf16<0>, pg8::StaticOrder>(ldsl, g, S, E, nullptr);
            } else if (s == 2 && (PHM & 16)) { ln_rows(pout(), XB, pin(1) + l * DM, pin(2) + l * DM, true); cvt_ffn(p, l, 1, ldsf); }
            else if (s == 9 && (PHM & 16)) { ln_rows(pout(), XB, pin(6) + l * DM, pin(7) + l * DM, false); }
            else if (s == 12 && (PHM & 16)) { ln_rows(pout(), XB, pin(26) + l * DM, pin(27) + l * DM, l + 1 == NLAYER); if (l + 1 < NLAYER) { cvt_ffn(p, l + 1, 0, ldsf); cvt_mix(p, l + 1, ldsf); } }
            else if (s == 4 && (PHM & 32)) mixer_phase_pre(p, l, ldsf);
            else if (s == 5 && (PHM & 32)) mixer_phase_a(p, l, ldsf);
            else if (s == 6 && (PHM & 64)) scan_phase(p);
            else if (s == 7 && (PHM & 384)) mixer_phase_c<((PHM & 128) ? 1 : 0) | ((PHM & 256) ? 14 : 0)>(p, l, ldsf);
            }
        }
        if (ph + 1 < p.ph_hi) { if (ph == p.ph_lo) cg::this_grid().sync(); else grid_bar((unsigned*)(pws() + WS_BAR), (++nbar) * gridDim.x); }
    }
}

#ifndef HOST_REPEAT
#define HOST_REPEAT 0
#endif
#ifndef MULTI_LAUNCH
#define MULTI_LAUNCH 0
#endif
static int phase_mask(int ph) { if (ph == 0) return 1; const int s = (ph - 1) % 13; return (s == 0 || s == 10) ? 2 : (s == 1 || s == 11 || s == 8) ? 4 : s == 3 ? 8 : (s == 2 || s == 9 || s == 12) ? 16 : (s == 4 || s == 5) ? 32 : s == 6 ? 64 : 128; }
template <int M> static bool setup_one(int* per_cu) {
    if (hipFuncSetAttribute((const void*)mega_fwd<M>, hipFuncAttributeMaxDynamicSharedMemorySize, LDS_BYTES) != hipSuccess) return false;
    int pc = 0; if (hipOccupancyMaxActiveBlocksPerMultiprocessor(&pc, (const void*)mega_fwd<M>, NTHREADS, LDS_BYTES) != hipSuccess) pc = 0; *per_cu = pc; return true;
}
extern "C" void kernel_launch(void* const* d_in, const int* in_sizes, int n_in, void* d_out, int out_size, void* d_ws, size_t ws_size, hipStream_t stream) {
    static int grid = 0;
    if (grid == 0) {
        if (n_in != 31 || out_size != NTOK * DM || ws_size < WS_END) { fprintf(stderr, "kernel_launch: unexpected shapes: n_in %d out %d ws %zu (need %zu)\n", n_in, out_size, ws_size, (size_t)WS_END); grid = -1; return; }
        int dev = 0, cus = 0, per_cu = 0; bool ok = true;
        (void)hipGetDevice(&dev); (void)hipDeviceGetAttribute(&cus, hipDeviceAttributeMultiprocessorCount, dev);
#if MULTI_LAUNCH
        ok = setup_one<1>(&per_cu) && setup_one<2>(&per_cu) && setup_one<4>(&per_cu) && setup_one<8>(&per_cu) && setup_one<16>(&per_cu) && setup_one<32>(&per_cu) && setup_one<64>(&per_cu) && setup_one<128>(&per_cu) && setup_one<256>(&per_cu);
#else
        ok = setup_one<511>(&per_cu);
#endif
        (void)hipGetLastError();
        if (!ok) { fprintf(stderr, "kernel_launch: hipFuncSetAttribute failed\n"); grid = -1; return; }
        grid = cus;
        fprintf(stderr, "kernel_launch: grid %d (cus %d, per_cu %d)\n", grid, cus, per_cu);
    }
    if (grid < 0) return;
    Params p{};
    for (int i = 0; i < 31; ++i) p.in[i] = (const float*)d_in[i];
    p.out = (float*)d_out; p.ws = (unsigned char*)d_ws;
#if MULTI_LAUNCH
    for (int ph = 0; ph < NPHASE; ++ph) { p.ph_lo = ph; p.ph_hi = ph + 1;
      for (int hrep = 0; hrep < ((ph > 0 && ((HOST_REPEAT >> ((ph - 1) % 13)) & 1)) ? 2 : 1); ++hrep)
        switch (phase_mask(ph)) {
            case 1: hipLaunchKernelGGL(mega_fwd<1>, dim3(grid), dim3(NTHREADS), LDS_BYTES, stream, p); break;
            case 2: hipLaunchKernelGGL(mega_fwd<2>, dim3(grid), dim3(NTHREADS), LDS_BYTES, stream, p); break;
            case 4: hipLaunchKernelGGL(mega_fwd<4>, dim3(grid), dim3(NTHREADS), LDS_BYTES, stream, p); break;
            case 8: hipLaunchKernelGGL(mega_fwd<8>, dim3(grid), dim3(NTHREADS), LDS_BYTES, stream, p); break;
            case 16: hipLaunchKernelGGL(mega_fwd<16>, dim3(grid), dim3(NTHREADS), LDS_BYTES, stream, p); break;
            case 32: hipLaunchKernelGGL(mega_fwd<32>, dim3(grid), dim3(NTHREADS), LDS_BYTES, stream, p); break;
            case 64: hipLaunchKernelGGL(mega_fwd<64>, dim3(grid), dim3(NTHREADS), LDS_BYTES, stream, p); break;
            default: hipLaunchKernelGGL(mega_fwd<128>, dim3(grid), dim3(NTHREADS), LDS_BYTES, stream, p); hipLaunchKernelGGL(mega_fwd<256>, dim3(grid), dim3(NTHREADS), LDS_BYTES, stream, p); break;
        }
    }
#else
    p.ph_lo = 0; p.ph_hi = NPHASE;
    (void)hipMemsetAsync((unsigned char*)d_ws + WS_BAR, 0, 256, stream);
    void* args[] = {&p};
    hipError_t e = hipLaunchCooperativeKernel((const void*)mega_fwd<511>, dim3(grid), dim3(NTHREADS), args, LDS_BYTES, stream);
    if (e != hipSuccess) fprintf(stderr, "kernel_launch: cooperative launch failed: %s (grid %d)\n", hipGetErrorString(e), grid);
#endif
}
```

```cpp
#include <hip/hip_runtime.h>
#include <hip/hip_cooperative_groups.h>
#include <cstdio>
namespace cg = cooperative_groups;
__device__ __forceinline__ int otid() { int t = (int)threadIdx.x; asm volatile("" : "+v"(t)); return t; }
__device__ __forceinline__ int obid() { int t = (int)blockIdx.x; asm volatile("" : "+s"(t)); return t; }
template <int CTRL> __device__ __forceinline__ float dppf(float v) { return __int_as_float(__builtin_amdgcn_mov_dpp(__float_as_int(v), CTRL, 0xf, 0xf, true)); }
template <int CTRL> __device__ __forceinline__ unsigned dppu(unsigned v) { return (unsigned)__builtin_amdgcn_mov_dpp((int)v, CTRL, 0xf, 0xf, true); }
template <int CTRL> __device__ __forceinline__ unsigned long long dppu64(unsigned long long v) { return ((unsigned long long)dppu<CTRL>((unsigned)(v >> 32)) << 32) | dppu<CTRL>((unsigned)v); }
template <int K> __device__ __forceinline__ int sxi(int v) {
    if constexpr (K < 32) return __builtin_amdgcn_ds_swizzle(v, (K << 10) | 0x1f);
    else return __builtin_amdgcn_ds_bpermute(((otid() & 63) ^ 32) << 2, v);
}
template <int K> __device__ __forceinline__ float sxf(float v) { return __int_as_float(sxi<K>(__float_as_int(v))); }
__device__ __forceinline__ float wave_sum(float v) { v += sxf<1>(v); v += sxf<2>(v); v += sxf<4>(v); v += sxf<8>(v); v += sxf<16>(v); v += sxf<32>(v); return v; }
template <int K> __device__ __forceinline__ unsigned long long sxu64(unsigned long long v) { const unsigned lo = (unsigned)sxi<K>((int)(unsigned)v), hi = (unsigned)sxi<K>((int)(unsigned)(v >> 32)); return ((unsigned long long)hi << 32) | lo; }
__device__ __forceinline__ unsigned long long wave_max_u64(unsigned long long b) { unsigned long long o;
    o = dppu64<0xB1>(b); b = o > b ? o : b; o = dppu64<0x4E>(b); b = o > b ? o : b; o = dppu64<0x141>(b); b = o > b ? o : b; o = dppu64<0x140>(b); b = o > b ? o : b; o = sxu64<16>(b); b = o > b ? o : b; o = sxu64<32>(b); b = o > b ? o : b; return b; }
__device__ __forceinline__ float wave_maxf(float v) { v = fmaxf(v, dppf<0xB1>(v)); v = fmaxf(v, dppf<0x4E>(v)); v = fmaxf(v, dppf<0x141>(v)); v = fmaxf(v, dppf<0x140>(v)); v = fmaxf(v, sxf<16>(v)); v = fmaxf(v, sxf<32>(v)); return v; }
__device__ __forceinline__ void lds_addf(float* p, float v) { __hip_atomic_fetch_add((__attribute__((address_space(3))) float*)p, v, __ATOMIC_RELAXED, __HIP_MEMORY_SCOPE_WORKGROUP); }
__device__ __forceinline__ void lds_or64(unsigned long long* p, unsigned long long v) { __hip_atomic_fetch_or((__attribute__((address_space(3))) unsigned long long*)p, v, __ATOMIC_RELAXED, __HIP_MEMORY_SCOPE_WORKGROUP); }
namespace pg8 {
#define PG8_LAS __attribute__((address_space(3)))
typedef unsigned short bf16_t;
typedef short bf16x8 __attribute__((ext_vector_type(8)));
typedef float f32x4 __attribute__((ext_vector_type(4)));
typedef unsigned u32x4 __attribute__((ext_vector_type(4)));
constexpr int BM = 256, BK = 64, HALF = 128, HTB = HALF * BK * 2  , STAGE_BYTES = 8 * HTB, NXCD = 8, WGM = 8;

__host__ __device__ __forceinline__ int lds_byte(int r, int c) { const int st = (r >> 4) * 2 + (c >> 5), rr = r & 15, cc = c & 31, ob = rr * 64 + cc * 2; return st * 1024 + (ob ^ (((ob >> 9) & 1) << 5)); }
__host__ __device__ __forceinline__ void stage_rc(int b, int& R, int& C) { const int st = b / 1024, sb = b % 1024, swz = sb ^ (((sb >> 9) & 1) << 5); R = (st >> 1) * 16 + swz / 64; C = (st & 1) * 32 + (swz % 64) / 2; }
__host__ __device__ __forceinline__ int perm32(int rho) { const int n = rho >> 4, i = rho & 15; return 8 * (i >> 2) + 4 * n + (i & 3); }

struct Unit { int pm, pn; };
struct Gemm { const bf16_t* A; const bf16_t* Bt; int M, N, K; };

struct StaticOrder {
    int nM, nN, nwg, G, c;
    __host__ __device__ void init(int M, int N, int G_, int c_) { nM = M / BM; nN = N / BM; nwg = nM * nN; G = G_; c = c_; }
    __host__ __device__ bool next(int i, Unit& u) const {
        const long L = (long)i * G + c; if (L >= nwg) return false;
        int wgid = (int)L; { const int q = nwg / NXCD, r = nwg % NXCD, xcd = wgid % NXCD, off = wgid / NXCD; wgid = (xcd < r ? xcd * (q + 1) : r * (q + 1) + (xcd - r) * q) + off; }
        const int nig = WGM * nN, gid = wgid / nig, fm = gid * WGM, gsz = (nM - fm) < WGM ? (nM - fm) : WGM;
        u.pm = fm + ((wgid % nig) % gsz); u.pn = (wgid % nig) / gsz; return true;
    }
    __device__ __forceinline__ void a_ready(const Unit&) const {}
    __device__ __forceinline__ void done(const Unit&) const {}
};
struct CountedOrder : StaticOrder {
    const unsigned* ready; unsigned need; unsigned* tmo;
    __device__ __forceinline__ void a_ready(const Unit& u) const {
        if (threadIdx.x < 64) {
            const unsigned long long t0 = __builtin_amdgcn_s_memrealtime(); unsigned polls = 0;
            while ((unsigned)__builtin_amdgcn_readfirstlane(__hip_atomic_load(ready + 64 * u.pm, __ATOMIC_RELAXED, __HIP_MEMORY_SCOPE_AGENT)) < need) {
                if ((++polls & 255u) == 0u && __builtin_amdgcn_readfirstlane(__hip_atomic_load(tmo, __ATOMIC_RELAXED, __HIP_MEMORY_SCOPE_AGENT)) != 0u) break;
                if (__builtin_amdgcn_s_memrealtime() - t0 > 2000000ull) {
                    if (threadIdx.x == 0) { unsigned expect = 0u; __hip_atomic_compare_exchange_strong(tmo + 1, &expect, 0x600u | (unsigned)(u.pm & 0xff), __ATOMIC_RELAXED, __ATOMIC_RELAXED, __HIP_MEMORY_SCOPE_AGENT); __hip_atomic_store(tmo, 1u, __ATOMIC_RELAXED, __HIP_MEMORY_SCOPE_AGENT); }
                    break; }
                __builtin_amdgcn_s_sleep(2); }
            __builtin_amdgcn_fence(__ATOMIC_ACQUIRE, "agent");
            asm volatile("s_waitcnt vmcnt(0)" ::: "memory");
        }
#if !defined(BROKEN_HOOK_NO_BARRIER)
        asm volatile("" ::: "memory"); __builtin_amdgcn_s_barrier(); asm volatile("" ::: "memory");
#endif
    }
};

__device__ __forceinline__ unsigned cvt_pk_bf16(float lo, float hi) { unsigned r; asm volatile("v_cvt_pk_bf16_f32 %0, %1, %2" : "=v"(r) : "v"(lo), "v"(hi)); return r; }
typedef float f32x2 __attribute__((ext_vector_type(2)));
__device__ __forceinline__ f32x2 gelu_pk(f32x2 v) {
    const f32x2 av = __builtin_elementwise_abs(v), d = av * 0.2316418882f + 1.0f;
    f32x2 t; t.x = __builtin_amdgcn_rcpf(d.x); t.y = __builtin_amdgcn_rcpf(d.y);
    f32x2 q = t * 0.5307027145f + (-0.7265760135f); q = q * t + 0.7107068705f; q = q * t + (-0.142248368f); q = q * t + 0.127414796f; q = q * t;
    const f32x2 s = (v * v) * (-0.72134752044f);
    f32x2 e; e.x = __builtin_amdgcn_exp2f(s.x); e.y = __builtin_amdgcn_exp2f(s.y);
    const f32x2 m = v * (q * e), r = v - m;
    f32x2 o; o.x = v.x < 0.f ? m.x : r.x; o.y = v.y < 0.f ? m.y : r.y; return o;
}

struct EpiF32 {
    static constexpr bool PERM = false, AFTER_DRAIN = false;
    float* C; int ldc; const float* bias;
    __device__ __forceinline__ void operator()(const f32x4 (&acc)[2][2][4][2], const Unit& u, int wr, int wc, int fr, int fq) const {
        const int row0 = u.pm * BM + wr * 64 + fr, col0 = u.pn * BM + wc * 32 + 4 * fq;
        f32x4 bv[2][2];
#pragma unroll
        for (int bj = 0; bj < 2; ++bj)
#pragma unroll
            for (int n = 0; n < 2; ++n) bv[bj][n] = bias ? *(const f32x4*)(bias + col0 + bj * HALF + n * 16) : (f32x4){0.f, 0.f, 0.f, 0.f};
#pragma unroll
        for (int ai = 0; ai < 2; ++ai)
#pragma unroll
            for (int m = 0; m < 4; ++m) { float* rowp = C + (size_t)(row0 + ai * HALF + m * 16) * ldc + col0;
#pragma unroll
                for (int bj = 0; bj < 2; ++bj)
#pragma unroll
                    for (int n = 0; n < 2; ++n) *(f32x4*)(rowp + bj * HALF + n * 16) = acc[ai][bj][m][n] + bv[bj][n]; }
    }
};
template <int ACT  > struct EpiBf16 {
    static constexpr bool PERM = true, AFTER_DRAIN = false;
    bf16_t* O; int ldc; const float* bias; int split_cols; size_t split_stride;
    __device__ __forceinline__ void operator()(const f32x4 (&acc)[2][2][4][2], const Unit& u, int wr, int wc, int fr, int fq) const {
        const int row0 = u.pm * BM + wr * 64 + fr; int colt = u.pn * BM; bf16_t* base = O;
        if (split_cols) { const int t = colt / split_cols; base += (size_t)t * split_stride; colt -= t * split_cols; }
        const int col0 = colt + wc * 32 + 8 * fq, bcol0 = u.pn * BM + wc * 32 + 8 * fq;
        f32x4 bv[2][2];
#pragma unroll
        for (int bj = 0; bj < 2; ++bj)
#pragma unroll
            for (int n = 0; n < 2; ++n) bv[bj][n] = bias ? *(const f32x4*)(bias + bcol0 + bj * HALF + 4 * n) : (f32x4){0.f, 0.f, 0.f, 0.f};
#pragma unroll
        for (int ai = 0; ai < 2; ++ai)
#pragma unroll
            for (int m = 0; m < 4; ++m) { bf16_t* rowp = base + (size_t)(row0 + ai * HALF + m * 16) * ldc + col0;
#pragma unroll
                for (int bj = 0; bj < 2; ++bj) { f32x4 v0 = acc[ai][bj][m][0] + bv[bj][0], v1 = acc[ai][bj][m][1] + bv[bj][1];
                    if (ACT == 1) { f32x2 a = gelu_pk((f32x2){v0[0], v0[1]}), b = gelu_pk((f32x2){v0[2], v0[3]}), c = gelu_pk((f32x2){v1[0], v1[1]}), d = gelu_pk((f32x2){v1[2], v1[3]});
                        v0 = (f32x4){a.x, a.y, b.x, b.y}; v1 = (f32x4){c.x, c.y, d.x, d.y}; }
                    if (ACT == 2) {
#pragma unroll
                        for (int j = 0; j < 4; ++j) { v0[j] = 0.5f * v0[j] * (1.0f + erff(v0[j] * 0.70710678f)); v1[j] = 0.5f * v1[j] * (1.0f + erff(v1[j] * 0.70710678f)); } }
                    u32x4 w; w.x = cvt_pk_bf16(v0[0], v0[1]); w.y = cvt_pk_bf16(v0[2], v0[3]); w.z = cvt_pk_bf16(v1[0], v1[1]); w.w = cvt_pk_bf16(v1[2], v1[3]);
                    *(u32x4*)(rowp + bj * HALF) = w; } }
    }
};
template <class Epi, class Sched, bool STAMP = false>
__device__ __forceinline__ void gemm_phase(PG8_LAS unsigned char* lds, const Gemm g, const Sched& S, const Epi& E, unsigned long long* stamps) {
    const int tid = otid(), wid = __builtin_amdgcn_readfirstlane(tid >> 6), lane = tid & 63, wr = wid >> 2, wc = wid & 3, fr = lane & 15, fq = lane >> 4;
    const int K = g.K, nt = K / BK;
    int ts_lo = 0, ts_hi = 0, nts = 0; const unsigned long long rt_entry = STAMP ? (unsigned long long)wall_clock64() : 0ull;
#define PG8_STAMP() do { if (STAMP && wid == 0 && nts < 64) { const unsigned long long _c = (unsigned long long)clock64(); \
        ts_lo = (lane == nts) ? (int)(unsigned)_c : ts_lo; ts_hi = (lane == nts) ? (int)(unsigned)(_c >> 32) : ts_hi; ++nts; } } while (0)
    PG8_STAMP();
    unsigned voffA[2], voffB[2];
#pragma unroll
    for (int i = 0; i < 2; ++i) { int R, C; stage_rc(tid * 16 + i * 8192, R, C); const int Rb = Epi::PERM ? ((R & ~31) + perm32(R & 31)) : R;
        voffA[i] = (unsigned)(R * K + C) * 2u; voffB[i] = (unsigned)(Rb * K + C) * 2u; }
    const size_t kstep = (size_t)(BK * 2);
    const size_t hstep = (size_t)HALF * K * 2;
    const size_t tstep = 2 * hstep;
    const unsigned ldsw = (unsigned)wid * 1024u;
    const int aoff = lds_byte(wr * 64 + fr, fq * 8), boff = lds_byte(wc * 32 + fr, fq * 8);
#define PG8_SA(b, h) (((b) * 2 + (h)) * HTB)
#define PG8_SB(b, h) ((4 + (b) * 2 + (h)) * HTB)
#define PG8_STAGE(bufoff, gbase, voff) do { _Pragma("unroll") for (int _i = 0; _i < 2; ++_i) \
        __builtin_amdgcn_global_load_lds((const unsigned*)((const char*)(gbase) + (voff)[_i]), (PG8_LAS unsigned*)(lds + (bufoff) + ldsw + _i * 8192), 16, 0, 0); } while (0)
#define PG8_LDA(dst, b, h) do { _Pragma("unroll") for (int m = 0; m < 4; ++m) _Pragma("unroll") for (int k = 0; k < 2; ++k) dst[m][k] = *(const PG8_LAS bf16x8*)(lds + PG8_SA(b, h) + aoff + m * 2048 + k * 1024); } while (0)
#define PG8_LDB(dst, b, h) do { _Pragma("unroll") for (int n = 0; n < 2; ++n) _Pragma("unroll") for (int k = 0; k < 2; ++k) dst[n][k] = *(const PG8_LAS bf16x8*)(lds + PG8_SB(b, h) + boff + n * 2048 + k * 1024); } while (0)
#define PG8_MMA(ai, bj, At, Bt) do { __builtin_amdgcn_s_setprio(1); _Pragma("unroll") for (int m = 0; m < 4; ++m) _Pragma("unroll") for (int n = 0; n < 2; ++n) _Pragma("unroll") for (int k = 0; k < 2; ++k) \
        acc[ai][bj][m][n] = __builtin_amdgcn_mfma_f32_16x16x32_bf16(Bt[n][k], At[m][k], acc[ai][bj][m][n], 0, 0, 0); __builtin_amdgcn_s_setprio(0); } while (0)
#define PG8_WAIT_V(n) asm volatile("s_waitcnt vmcnt(" #n ")" ::: "memory")
#define PG8_WAIT_L(n) asm volatile("s_waitcnt lgkmcnt(" #n ")" ::: "memory")
#define PG8_BAR __builtin_amdgcn_s_barrier()
#define PG8_SCHED __builtin_amdgcn_sched_barrier(0)
    Unit cur, nxt; int ui = 0;
    if (!S.next(0, cur)) return;
    f32x4 acc[2][2][4][2];
#pragma unroll
    for (int a = 0; a < 2; ++a)
#pragma unroll
        for (int b = 0; b < 2; ++b)
#pragma unroll
            for (int m = 0; m < 4; ++m)
#pragma unroll
                for (int n = 0; n < 2; ++n) acc[a][b][m][n] = (f32x4){0.f, 0.f, 0.f, 0.f};
    bf16x8 At[4][2], B0[2][2], B1[2][2];
    const char* cA = (const char*)g.A + (size_t)cur.pm * tstep; const char* cB = (const char*)g.Bt + (size_t)cur.pn * tstep;
    S.a_ready(cur);
    PG8_STAGE(PG8_SB(0, 0), cB, voffB); PG8_STAGE(PG8_SA(0, 0), cA, voffA); PG8_STAGE(PG8_SB(0, 1), cB + hstep, voffB); PG8_STAGE(PG8_SA(0, 1), cA + hstep, voffA);
    if (wr == 1) PG8_BAR;
    PG8_WAIT_V(4); PG8_BAR;
    PG8_STAGE(PG8_SB(1, 0), cB + kstep, voffB); PG8_STAGE(PG8_SA(1, 0), cA + kstep, voffA); PG8_STAGE(PG8_SB(1, 1), cB + hstep + kstep, voffB);
    PG8_WAIT_V(6); PG8_BAR;
    PG8_STAMP();
    for (;;) {
        const bool has_next = S.next(ui + 1, nxt);
        const char* nA = has_next ? (const char*)g.A + (size_t)nxt.pm * tstep : cA; const char* nB = has_next ? (const char*)g.Bt + (size_t)nxt.pn * tstep : cB;
        for (int t = 0; t < nt; t += 2) {
            const bool last = (t == nt - 2);
            const char* a1 = cA + (size_t)(t + 1) * kstep;
            const char* a2 = last ? nA : cA + (size_t)(t + 2) * kstep; const char* b2 = last ? nB : cB + (size_t)(t + 2) * kstep;
            const char* a3 = a2 + kstep; const char* b3 = b2 + kstep;
            if (last && has_next) S.a_ready(nxt);
            PG8_LDB(B0, 0, 0); PG8_SCHED; PG8_LDA(At, 0, 0); PG8_STAGE(PG8_SA(1, 1), a1 + hstep, voffA);
            PG8_WAIT_L(8); PG8_BAR; PG8_WAIT_L(0); PG8_MMA(0, 0, At, B0); PG8_BAR; PG8_SCHED;
            PG8_LDB(B1, 0, 1); PG8_STAGE(PG8_SB(0, 0), b2, voffB);
            PG8_BAR; PG8_WAIT_L(0); PG8_MMA(0, 1, At, B1); PG8_BAR;
            PG8_LDA(At, 0, 1); PG8_STAGE(PG8_SA(0, 0), a2, voffA);
            PG8_BAR; PG8_WAIT_L(0); PG8_MMA(1, 0, At, B0); PG8_BAR; PG8_SCHED;
            PG8_STAGE(PG8_SB(0, 1), b2 + hstep, voffB);
            PG8_WAIT_V(6); PG8_BAR; PG8_MMA(1, 1, At, B1); PG8_BAR;
            PG8_LDB(B0, 1, 0); PG8_SCHED; PG8_LDA(At, 1, 0); PG8_STAGE(PG8_SA(0, 1), a2 + hstep, voffA);
            PG8_WAIT_L(8); PG8_BAR; PG8_WAIT_L(0); PG8_MMA(0, 0, At, B0); PG8_BAR; PG8_SCHED;
            PG8_LDB(B1, 1, 1); PG8_STAGE(PG8_SB(1, 0), b3, voffB);
            PG8_BAR; PG8_WAIT_L(0); PG8_MMA(0, 1, At, B1); PG8_BAR;
            PG8_LDA(At, 1, 1); PG8_STAGE(PG8_SA(1, 0), a3, voffA);
            PG8_BAR; PG8_WAIT_L(0); PG8_MMA(1, 0, At, B0); PG8_BAR; PG8_SCHED;
            PG8_STAGE(PG8_SB(1, 1), b3 + hstep, voffB);
            PG8_WAIT_V(6); PG8_BAR; PG8_MMA(1, 1, At, B1); PG8_BAR;
        }
        PG8_STAMP();
        if constexpr (!Epi::AFTER_DRAIN) { E(acc, cur, wr, wc, fr, fq); S.done(cur); }
        PG8_STAMP();
        if (!has_next) break;
#pragma unroll
        for (int a = 0; a < 2; ++a)
#pragma unroll
            for (int b = 0; b < 2; ++b)
#pragma unroll
                for (int m = 0; m < 4; ++m)
#pragma unroll
                    for (int n = 0; n < 2; ++n) acc[a][b][m][n] = (f32x4){0.f, 0.f, 0.f, 0.f};
        cur = nxt; cA = nA; cB = nB; ++ui;
    }
    PG8_WAIT_V(0);
    if (wr == 0) PG8_BAR;
    PG8_BAR;
    if constexpr (Epi::AFTER_DRAIN) { E.fused(acc, cur, wr, wc, fr, fq, lds, wid, lane); S.done(cur); }
    PG8_STAMP();
    if (STAMP && wid == 0) { stamps[lane] = lane < nts ? (((unsigned long long)(unsigned)ts_hi << 32) | (unsigned)ts_lo) : 0ull;
        if (lane == 62) stamps[62] = rt_entry; if (lane == 63) stamps[63] = (unsigned long long)wall_clock64(); }
#undef PG8_STAMP
#undef PG8_SA
#undef PG8_SB
#undef PG8_STAGE
#undef PG8_LDA
#undef PG8_LDB
#undef PG8_MMA
#undef PG8_WAIT_V
#undef PG8_WAIT_L
#undef PG8_BAR
#undef PG8_SCHED
}
}
typedef unsigned short bf16_t;
typedef float f32x4 __attribute__((ext_vector_type(4)));
typedef unsigned u32x4 __attribute__((ext_vector_type(4)));
typedef unsigned u32x2 __attribute__((ext_vector_type(2)));
typedef short bf16x8 __attribute__((ext_vector_type(8)));
#define MFMA16(a, b, c) __builtin_amdgcn_mfma_f32_16x16x32_bf16((a), (b), (c), 0, 0, 0)
#define LAS __attribute__((address_space(3)))

constexpr int SEQ = 16384, NBATCH = 2, NTOK = 32768, DM = 2048, DFF = 5632, DIN = 6944, DINP = 7168, NLAYER = 2;
constexpr int C_HQ = 0, C_HF = 512, C_HI = 1024, C_HG = 1536, C_NQ = 2048, C_NKC = 2560, C_NVC = 2688, C_NKS = 2816, C_NVS = 2944,
              C_NKW = 3072, C_NVW = 3200, C_NGATE = 3328, C_SZ = 3352, C_SXBC = 3864, C_SDT = 4888, C_RQ = 4896, C_RK = 5408, C_RV = 5920, C_RG = 6432;
constexpr float ALPHA = 1.41421356237f;
constexpr int LDS_BYTES = 147456;
constexpr int NTHREADS = 512;

constexpr size_t WS_WA = 0;
constexpr size_t WS_WB = WS_WA + (size_t)11264 * 2048 * 2;
constexpr size_t WS_WC = WS_WB + (size_t)2048 * 5632 * 2;
constexpr size_t WS_WD = WS_WC + (size_t)7168 * 2048 * 2;
constexpr size_t WS_XB = WS_WD + (size_t)2048 * 2048 * 2;
constexpr size_t WS_HIN = WS_XB + (size_t)NTOK * 2048 * 2;
constexpr size_t WS_STH = WS_HIN + (size_t)NTOK * DINP * 2;
constexpr size_t WS_STS = WS_STH + (size_t)2048 * 16384 * 2;
constexpr size_t WS_STR = WS_STS + (size_t)4096 * 8192 * 2;
constexpr size_t WS_DECH = WS_STR + (size_t)2048 * 16384 * 2;
constexpr size_t WS_DECS = WS_DECH + (size_t)2048 * 128 * 4;
constexpr size_t WS_KCMP = WS_DECS + (size_t)4096 * 4;
constexpr size_t WS_VCMP = WS_KCMP + (size_t)4 * 1024 * 64 * 4;
constexpr size_t WS_VST = WS_VCMP + (size_t)4 * 1024 * 64 * 4;
constexpr size_t WS_VWT = WS_VST + (size_t)4 * 256 * 4096 * 2;
constexpr size_t WS_KCB = WS_VWT + (size_t)4 * 256 * 4096 * 2;
constexpr size_t WS_VCT = WS_KCB + (size_t)4 * 1024 * 64 * 2;
constexpr size_t WS_XBC = WS_VCT + (size_t)4 * 16 * 4096 * 2;
constexpr size_t WS_KNORM = WS_XBC + (size_t)NTOK * 1024 * 2;
constexpr size_t WS_BAR = WS_KNORM + (size_t)4 * 256 * 4;
constexpr size_t WS_W1T = WS_BAR + 256;
constexpr size_t WS_END = WS_W1T + (size_t)4 * 256 * 2048 * 2;

struct Params {
    const float* in[31];
    float* out;
    unsigned char* ws;
    int ph_lo, ph_hi;
};

__shared__ unsigned long long g_ptab[40];
__device__ __forceinline__ unsigned long long ptab_get(int k) { const unsigned long long v = *(volatile LAS unsigned long long*)((LAS unsigned long long*)g_ptab + k);
    unsigned lo = __builtin_amdgcn_readfirstlane((unsigned)v), hi = __builtin_amdgcn_readfirstlane((unsigned)(v >> 32)); asm volatile("" : "+s"(lo), "+s"(hi)); return ((unsigned long long)hi << 32) | lo; }
#define GAS __attribute__((address_space(1)))
__device__ __forceinline__ const float* pin(int k) { return (const float*)(GAS const float*)ptab_get(k); }
__device__ __forceinline__ float* pout() { return (float*)(GAS float*)ptab_get(31); }
__device__ __forceinline__ unsigned char* pws() { return (unsigned char*)(GAS unsigned char*)ptab_get(32); }
__device__ __forceinline__ float bf2f(bf16_t v) { return __uint_as_float(((unsigned)v) << 16); }
__device__ __forceinline__ float bflo(unsigned w) { return __uint_as_float(w << 16); }
__device__ __forceinline__ float bfhi(unsigned w) { return __uint_as_float(w & 0xffff0000u); }
__device__ __forceinline__ unsigned pk2(float lo, float hi) { return pg8::cvt_pk_bf16(lo, hi); }
__device__ __forceinline__ void ld8(const bf16_t* p, float (&x)[8]) { const u32x4 w = *(const u32x4*)p; x[0] = bflo(w.x); x[1] = bfhi(w.x); x[2] = bflo(w.y); x[3] = bfhi(w.y); x[4] = bflo(w.z); x[5] = bfhi(w.z); x[6] = bflo(w.w); x[7] = bfhi(w.w); }
__device__ __forceinline__ void st8(float* p, const float (&x)[8]) { *(f32x4*)p = (f32x4){x[0], x[1], x[2], x[3]}; *(f32x4*)(p + 4) = (f32x4){x[4], x[5], x[6], x[7]}; }
__device__ __forceinline__ void ldf8(const float* p, float (&x)[8]) { const f32x4 a = *(const f32x4*)p, b = *(const f32x4*)(p + 4); x[0] = a[0]; x[1] = a[1]; x[2] = a[2]; x[3] = a[3]; x[4] = b[0]; x[5] = b[1]; x[6] = b[2]; x[7] = b[3]; }
__device__ __forceinline__ float siluf(float x) { return x * __builtin_amdgcn_rcpf(1.f + __expf(-x)); }
__device__ __forceinline__ float sigmf(float x) { return __builtin_amdgcn_rcpf(1.f + __expf(-x)); }
__device__ __forceinline__ float softplusf(float x) { const float e = __expf(-fabsf(x)); const float l1 = e < 0.01f ? e * (1.f - e * (0.5f - e * (1.f / 3.f))) : __logf(1.f + e); return fmaxf(x, 0.f) + l1; }

__device__ __forceinline__ void cvt_tile(const float* s0, const float* s1, bf16_t* dstp, int K, int N, int mode, int tile, float* tl) {
    const int nkb = K >> 6; const int rb = tile / nkb, kb = tile - rb * nkb;
    const int r0 = rb * 128; const float* src = s0; int col0 = r0;
    if (mode == 1) { const int pn = r0 >> 8, bj = (r0 >> 7) & 1; src = bj ? s1 : s0; col0 = pn * 128; }
    const int tid = otid();
    { const int n = tid & 127, k0 = tid >> 7; const bool ok = (col0 + n) < N; const float* sp = src + (size_t)(kb * 64 + k0) * N + col0 + n;
#pragma unroll
      for (int i = 0; i < 16; ++i) tl[(k0 + 4 * i) * 129 + n] = ok ? __builtin_nontemporal_load(sp + (size_t)(4 * i) * N) : 0.f; }
    __syncthreads();
    { const int k8 = (tid & 7) * 8;
#pragma unroll
      for (int i = 0; i < 2; ++i) { const int n = (tid >> 3) + 64 * i; const float* c = tl + k8 * 129 + n;
          u32x4 w; w.x = pk2(c[0], c[129]); w.y = pk2(c[2 * 129], c[3 * 129]); w.z = pk2(c[4 * 129], c[5 * 129]); w.w = pk2(c[6 * 129], c[7 * 129]);
          *(u32x4*)(dstp + (size_t)(r0 + n) * K + kb * 64 + k8) = w; } }
    __syncthreads();
}
__device__ void cvt_ffn(const Params& p, int l, int which  , float* tl) {
    const float* w1 = pin(which ? 28 : 3) + (size_t)l * DM * DFF; const float* w3 = pin(which ? 29 : 4) + (size_t)l * DM * DFF; const float* w2 = pin(which ? 30 : 5) + (size_t)l * DFF * DM;
    constexpr int n0 = (11264 / 128) * (DM / 64), n1 = (DM / 128) * (DFF / 64);
    for (int g = obid(); g < n0 + n1; g += gridDim.x) { const bool f = g < n0;
        cvt_tile(f ? w1 : w2, w3, (bf16_t*)(pws() + (f ? WS_WA : WS_WB)), f ? DM : DFF, f ? DFF : DM, f ? 1 : 0, f ? g : g - n0, tl); }
}
__device__ void cvt_mix(const Params& p, int l, float* tl) {
    constexpr int n0 = (DINP / 128) * (DM / 64), n1 = (DM / 128) * (DM / 64);
    for (int g = obid(); g < n0 + n1; g += gridDim.x) { const bool f = g < n0;
        cvt_tile(f ? pin(8) + (size_t)l * DM * DIN : pin(9) + (size_t)l * DM * DM, nullptr, (bf16_t*)(pws() + (f ? WS_WC : WS_WD)), DM, f ? DIN : DM, 0, f ? g : g - n0, tl); }
}
__device__ void cvt_w1t(const Params& p, float* tl) {
    for (int g = obid(); g < 256; g += gridDim.x) { const int job = g >> 6, l = job >> 1, which = job & 1;
        cvt_tile(pin(which ? 16 : 13) + (size_t)l * 2048 * 256, nullptr, (bf16_t*)(pws() + WS_W1T) + (size_t)job * 256 * 2048, 2048, 256, 0, g & 63, tl); }
}
__device__ void cvt_x(const Params& p) {
    const f32x4* x = (const f32x4*)pin(0); u32x2* xb = (u32x2*)(pws() + WS_XB);
    for (size_t i = (size_t)obid() * NTHREADS + otid(); i < (size_t)NTOK * DM / 4; i += (size_t)gridDim.x * NTHREADS) {
        const f32x4 v = __builtin_nontemporal_load(x + i); u32x2 w; w.x = pk2(v[0], v[1]); w.y = pk2(v[2], v[3]); xb[i] = w; }
}

struct EpiUp {
    static constexpr bool PERM = true, AFTER_DRAIN = false;
    bf16_t* H;
    __device__ __forceinline__ void operator()(const pg8::f32x4 (&acc)[2][2][4][2], const pg8::Unit& u, int wr, int wc, int fr, int fq) const {
        const int row0 = u.pm * 256 + wr * 64 + fr, col0 = u.pn * 128 + wc * 32 + 8 * fq;
#pragma unroll
        for (int ai = 0; ai < 2; ++ai)
#pragma unroll
            for (int m = 0; m < 4; ++m) { bf16_t* rowp = H + (size_t)(row0 + ai * 128 + m * 16) * DFF + col0;
                const pg8::f32x4 a0 = acc[ai][0][m][0], a1 = acc[ai][0][m][1], b0 = acc[ai][1][m][0], b1 = acc[ai][1][m][1];
                float v0[4], v1[4];
#pragma unroll
                for (int j = 0; j < 4; ++j) { v0[j] = siluf(a0[j]) * b0[j]; v1[j] = siluf(a1[j]) * b1[j]; }
                pg8::u32x4 w; w.x = pk2(v0[0], v0[1]); w.y = pk2(v0[2], v0[3]); w.z = pk2(v1[0], v1[1]); w.w = pk2(v1[2], v1[3]);
                *(pg8::u32x4*)rowp = w; }
    }
};
struct EpiRes {
    static constexpr bool PERM = false, AFTER_DRAIN = false;
    const float* res32; const bf16_t* res16; float* out; float alpha, scale;
    __device__ __forceinline__ void operator()(const pg8::f32x4 (&acc)[2][2][4][2], const pg8::Unit& u, int wr, int wc, int fr, int fq) const {
        const int row0 = u.pm * 256 + wr * 64 + fr, col0 = u.pn * 256 + wc * 32 + 4 * fq;
#pragma unroll
        for (int ai = 0; ai < 2; ++ai)
#pragma unroll
            for (int m = 0; m < 4; ++m) { const size_t off = (size_t)(row0 + ai * 128 + m * 16) * DM + col0;
#pragma unroll
                for (int bj = 0; bj < 2; ++bj)
#pragma unroll
                    for (int n = 0; n < 2; ++n) { pg8::f32x4 r;
                        if (res32) r = *(const pg8::f32x4*)(res32 + off + bj * 128 + n * 16);
                        else { const u32x2 w = *(const u32x2*)(res16 + off + bj * 128 + n * 16); r = (pg8::f32x4){bflo(w.x), bfhi(w.x), bflo(w.y), bfhi(w.y)}; }
                        *(pg8::f32x4*)(out + off + bj * 128 + n * 16) = r * alpha + acc[ai][bj][m][n] * scale; } }
    }
};

__device__ void ln_rows(float* X, bf16_t* xb, const float* g, const float* b, bool write_f32) {
    const int wid = otid() >> 6, lane = otid() & 63;
    for (int row = obid() * 8 + wid; row < NTOK; row += gridDim.x * 8) {
        float* xr = X + (size_t)row * DM; f32x4 v[8]; float s = 0.f;
#pragma unroll
        for (int i = 0; i < 8; ++i) { v[i] = *(const f32x4*)(xr + i * 256 + lane * 4); s += (v[i][0] + v[i][1]) + (v[i][2] + v[i][3]); }
        s = wave_sum(s);
        const float mean = s * (1.f / DM); float q = 0.f;
#pragma unroll
        for (int i = 0; i < 8; ++i) { const f32x4 d = v[i] - mean; q += (d[0] * d[0] + d[1] * d[1]) + (d[2] * d[2] + d[3] * d[3]); }
        q = wave_sum(q);
        const float rstd = rsqrtf(q * (1.f / DM) + 1e-5f);
#pragma unroll
        for (int i = 0; i < 8; ++i) { const int c = i * 256 + lane * 4; const f32x4 gg = *(const f32x4*)(g + c), bb = *(const f32x4*)(b + c);
            const f32x4 o = (v[i] - mean) * rstd * gg + bb; if (write_f32) *(f32x4*)(xr + c) = o;
            u32x2 w; w.x = pk2(o[0], o[1]); w.y = pk2(o[2], o[3]); *(u32x2*)(xb + (size_t)row * DM + c) = w; }
    }
}
#ifndef AREP
#define AREP 0
#endif
#ifndef CREP
#define CREP 0
#endif
constexpr int LP = 132;
__device__ __forceinline__ float hg_lb(const float* lg, int l, int idx) {
    if (l == 0) return 0.f; const float a0 = lg[idx], a1 = lg[512 + idx]; return 1.f / (1.f + __expf(a0 - a1));
}
__device__ __forceinline__ void hg_lb8(const float* lg, int l, int idx, float (&lb)[8]) {
    if (l == 0) {
#pragma unroll
        for (int k = 0; k < 8; ++k) lb[k] = 0.f;
    } else { float a0[8], a1[8]; ldf8(lg + idx, a0); ldf8(lg + 512 + idx, a1);
#pragma unroll
        for (int k = 0; k < 8; ++k) lb[k] = __builtin_amdgcn_rcpf(1.f + __expf(a0[k] - a1[k])); }
}
template <int DV> __device__ __forceinline__ void state_mm(const float* KD, const float* VV, bf16_t* dst) {
    const int tid = otid(), td = tid >> 4, tv = tid & 15;
    constexpr int NV = DV / 64;
    f32x4 acc[4][NV];
#pragma unroll
    for (int a = 0; a < 4; ++a)
#pragma unroll
        for (int n = 0; n < NV; ++n) acc[a][n] = (f32x4){0.f, 0.f, 0.f, 0.f};
    for (int j = 0; j < 64; ++j) {
        f32x4 v[NV];
#pragma unroll
        for (int n = 0; n < NV; ++n) v[n] = *(const f32x4*)(VV + j * LP + n * 64 + tv * 4);
#pragma unroll
        for (int a = 0; a < 4; ++a) { const float kd = KD[j * LP + td + 32 * a];
#pragma unroll
            for (int n = 0; n < NV; ++n) acc[a][n] += v[n] * kd; }
    }
#pragma unroll
    for (int a = 0; a < 4; ++a)
#pragma unroll
        for (int n = 0; n < NV; ++n) { u32x2 w; w.x = pk2(acc[a][n][0], acc[a][n][1]); w.y = pk2(acc[a][n][2], acc[a][n][3]);
            *(u32x2*)(dst + (size_t)(td + 32 * a) * DV + n * 64 + tv * 4) = w; }
}
__device__ __forceinline__ float ssd_act(const bf16_t* xbc, int b, int s, int ch) { return bf2f(xbc[((size_t)b * SEQ + s) * 1024 + ch]); }
__device__ void conv_prepass(const Params& p, int l) {
    const int tid = otid(), cg8 = (tid & 127) * 8, slot = tid >> 7;
    const bf16_t* hin = (const bf16_t*)(pws() + WS_HIN); bf16_t* xbc = (bf16_t*)(pws() + WS_XBC); const float* cw = pin(20) + l * 4096; const float* cb = pin(21) + l * 1024;
    float w[4][8], bias[8];
#pragma unroll
    for (int c = 0; c < 8; ++c) { bias[c] = cb[cg8 + c];
#pragma unroll
        for (int t = 0; t < 4; ++t) w[t][c] = cw[t * 1024 + cg8 + c]; }
    for (int tok = obid() * 4 + slot; tok < NTOK; tok += gridDim.x * 4) {
        const int s = tok & (SEQ - 1); float acc[8];
#pragma unroll
        for (int c = 0; c < 8; ++c) acc[c] = bias[c];
#pragma unroll
        for (int t = 0; t < 4; ++t) { if (s - 3 + t >= 0) { const u32x4 x = *(const u32x4*)(hin + (size_t)(tok - 3 + t) * DINP + C_SXBC + cg8);
            acc[0] += w[t][0] * bflo(x.x); acc[1] += w[t][1] * bfhi(x.x); acc[2] += w[t][2] * bflo(x.y); acc[3] += w[t][3] * bfhi(x.y);
            acc[4] += w[t][4] * bflo(x.z); acc[5] += w[t][5] * bfhi(x.z); acc[6] += w[t][6] * bflo(x.w); acc[7] += w[t][7] * bfhi(x.w); } }
        u32x4 o; o.x = pk2(siluf(acc[0]), siluf(acc[1])); o.y = pk2(siluf(acc[2]), siluf(acc[3])); o.z = pk2(siluf(acc[4]), siluf(acc[5])); o.w = pk2(siluf(acc[6]), siluf(acc[7]));
        *(u32x4*)(xbc + (size_t)tok * 1024 + cg8) = o;
    }
}
__device__ __forceinline__ void load_rotary(const bf16_t* hin, size_t t0, int pos0, int col0, float scale, float* dst, const float* theta) {
    const int tid = otid();
#pragma unroll
    for (int i = 0; i < 2; ++i) { const int e = tid + 512 * i; const int j = e >> 4, p0 = (e & 15) * 4;
        float x[8], y[8]; ld8(hin + (t0 + j) * DINP + col0 + 2 * p0, x);
#pragma unroll
        for (int k = 0; k < 4; ++k) { const float ang = (float)(pos0 + j) * theta[p0 + k];
            const float n = rintf(ang * 0.15915494309189535f); float r = fmaf(-n, 6.28125f, ang); r = fmaf(-n, 1.9353071795864769e-3f, r);
            const float sn = __sinf(r), cs = __cosf(r);
            y[2 * k] = (x[2 * k] * cs - x[2 * k + 1] * sn) * scale; y[2 * k + 1] = (x[2 * k] * sn + x[2 * k + 1] * cs) * scale; }
        st8(dst + j * LP + 2 * p0, y); }
}
__device__ __forceinline__ void fill_theta(float* theta) { if (otid() < 64) theta[otid()] = exp2f(-(float)otid() * (13.287712379549449f / 63.0f)); }

__device__ void hg_state_item(const Params& p, int l, int item, float* lds) {
    const int c = item & 255, h = (item >> 8) & 3, b = item >> 10; const int tid = otid();
    const bf16_t* hin = (const bf16_t*)(pws() + WS_HIN); const size_t t0 = (size_t)b * SEQ + c * 64;
    float* KD = lds; float* VV = lds + 64 * LP; float* BB = lds + 2 * 64 * LP; const float* lbl = pin(10);
#pragma unroll
    for (int i = 0; i < 2; ++i) { const int e = tid + 512 * i, j = e >> 4, d0 = (e & 15) * 8;
        float z[8], v[8], lb[8], bb[8], kk[8]; ld8(hin + (t0 + j) * DINP + C_HF + h * 128 + d0, z); ld8(hin + (t0 + j) * DINP + C_HI + h * 128 + d0, v); hg_lb8(lbl, l, h * 128 + d0, lb);
#pragma unroll
        for (int k = 0; k < 8; ++k) { const float sn = __builtin_amdgcn_rcpf(1.f + __expf(z[k])), sg = 1.f - sn; bb[k] = __logf(lb[k] + (1.f - lb[k]) * sg); kk[k] = (1.f - lb[k]) * sn; }
        st8(BB + j * LP + d0, bb); st8(KD + j * LP + d0, kk); st8(VV + j * LP + d0, v); }
    __syncthreads();
    if (tid < 128) { float a = 0.f; for (int j = 0; j < 64; ++j) { a += BB[j * LP + tid]; BB[j * LP + tid] = a; } }
    __syncthreads();
#pragma unroll
    for (int i = 0; i < 2; ++i) { const int e = tid + 512 * i, j = e >> 4, d0 = (e & 15) * 8; float kk[8], bj[8], bl[8]; ldf8(KD + j * LP + d0, kk); ldf8(BB + j * LP + d0, bj); ldf8(BB + 63 * LP + d0, bl);
#pragma unroll
        for (int k = 0; k < 8; ++k) kk[k] *= __expf(bl[k] - bj[k]);
        st8(KD + j * LP + d0, kk); }
    if (tid < 128) ((float*)(pws() + WS_DECH))[(size_t)item * 128 + tid] = __expf(BB[63 * LP + tid]);
    __syncthreads();
    state_mm<128>(KD, VV, (bf16_t*)(pws() + WS_STH) + (size_t)item * 16384);
    __syncthreads();
}
__device__ void ssd_state_item(const Params& p, int l, int item, float* lds) {
    const int c = item & 255, h = (item >> 8) & 7, b = item >> 11, g = h >> 2; const int tid = otid();
    const bf16_t* hin = (const bf16_t*)(pws() + WS_HIN); const size_t t0 = (size_t)b * SEQ + c * 64;
    const bf16_t* xbc = (const bf16_t*)(pws() + WS_XBC);
    float* KD = lds; float* VV = lds + 64 * LP; float* AUX = lds + 2 * 64 * LP;
    if (tid < 64) { const float dtv = softplusf(bf2f(hin[(t0 + tid) * DINP + C_SDT + h]) + pin(22)[l * 8 + h]);
        AUX[tid] = dtv; AUX[64 + tid] = -dtv * __expf(pin(23)[l * 8 + h]); }
    __syncthreads();
    if (tid < 64) { float a = 0.f; for (int j = 0; j <= tid; ++j) a += AUX[64 + j]; AUX[128 + tid] = a; }
    __syncthreads();
    const float cl = AUX[128 + 63];
#pragma unroll
    for (int i = 0; i < 2; ++i) { const int e = tid + 512 * i, j = e >> 4, n0 = (e & 15) * 8; float x[8]; ld8(xbc + ((size_t)b * SEQ + c * 64 + j) * 1024 + 512 + g * 128 + n0, x); const float f = __expf(cl - AUX[128 + j]);
#pragma unroll
        for (int k = 0; k < 8; ++k) x[k] *= f;
        st8(KD + j * LP + n0, x); }
    { const int j = tid >> 3, pc0 = (tid & 7) * 8; float x[8]; ld8(xbc + ((size_t)b * SEQ + c * 64 + j) * 1024 + h * 64 + pc0, x); const float f = AUX[j];
#pragma unroll
      for (int k = 0; k < 8; ++k) x[k] *= f;
      st8(VV + j * LP + pc0, x); }
    if (tid == 0) ((float*)(pws() + WS_DECS))[item] = __expf(cl);
    __syncthreads();
    state_mm<64>(KD, VV, (bf16_t*)(pws() + WS_STS) + (size_t)item * 8192);
    __syncthreads();
}
__device__ __forceinline__ float ret_lg(int h) { return __logf(1.f - exp2f(-5.f - (float)h)); }
__device__ void ret_state_item(const Params& p, int l, int item, float* lds) {
    const int c = item & 255, h = (item >> 8) & 3, b = item >> 10; const int tid = otid();
    const bf16_t* hin = (const bf16_t*)(pws() + WS_HIN); const size_t t0 = (size_t)b * SEQ + c * 64;
    float* KD = lds; float* VV = lds + 64 * LP; float* TH = lds + 2 * 64 * LP;
    fill_theta(TH);
    __syncthreads();
    load_rotary(hin, t0, c * 64, C_RK + h * 128, 0.08838834764831845f, KD, TH);
#pragma unroll
    for (int i = 0; i < 2; ++i) { const int e = tid + 512 * i, j = e >> 4, d0 = (e & 15) * 8; float v[8]; ld8(hin + (t0 + j) * DINP + C_RV + h * 128 + d0, v); st8(VV + j * LP + d0, v); }
    __syncthreads();
    const float lg = ret_lg(h);
#pragma unroll 4
    for (int i = 0; i < 16; ++i) { const int e = tid + 512 * i, j = e >> 7, d = e & 127; KD[j * LP + d] *= __expf(lg * (float)(63 - j)); }
    __syncthreads();
    state_mm<128>(KD, VV, (bf16_t*)(pws() + WS_STR) + (size_t)item * 16384);
    __syncthreads();
}
__device__ void cmp_item(const Params& p, int l, int item, float* lds) {
    const int mb = item & 63, kv = (item >> 6) & 1, b = (item >> 7) & 1, which = item >> 8; const int tid = otid();
    const bf16_t* hin = (const bf16_t*)(pws() + WS_HIN);
    const float* pe = pin(which ? 15 : 12) + l * 2048; const float* w2 = pin(which ? 17 : 14) + l * 256 * 64;
    float* dst = (float*)(pws() + (which ? WS_VCMP : WS_KCMP)) + (size_t)(b * 2 + kv) * 1024 * 64;
    const int colx = (which ? C_NVC : C_NKC) + kv * 64;
    bf16_t* AF = (bf16_t*)lds; float* HID = lds + 16448;
    const bf16_t* w1t = (const bf16_t*)(pws() + WS_W1T) + (size_t)((l * 2 + which) * 256) * 2048;
    const int tok0 = mb * 256;
#pragma unroll 2
    for (int i = 0; i < 8; ++i) { const int e = tid + 512 * i, r = e >> 8, rem = e & 255, pos = rem >> 3, d8 = (rem & 7) * 8; const int s = tok0 + 16 * r + pos;
        float x[8], pe8[8]; ldf8(pe + pos * 64 + d8, pe8);
        if (s < SEQ) ld8(hin + ((size_t)b * SEQ + s) * DINP + colx + d8, x); else {
#pragma unroll
            for (int k = 0; k < 8; ++k) x[k] = 0.f; }
        u32x4 w; w.x = pk2(x[0] + pe8[0], x[1] + pe8[1]); w.y = pk2(x[2] + pe8[2], x[3] + pe8[3]); w.z = pk2(x[4] + pe8[4], x[5] + pe8[5]); w.w = pk2(x[6] + pe8[6], x[7] + pe8[7]);
        *(u32x4*)(AF + r * 2056 + pos * 64 + d8) = w; }
    __syncthreads();
    { const int wid = tid >> 6, lane = tid & 63, fr = lane & 15, fq = lane >> 4;
      f32x4 acc0 = (f32x4){0.f, 0.f, 0.f, 0.f}, acc1 = acc0;
      const bf16_t* bp0 = w1t + (size_t)((2 * wid) * 16 + fr) * 2048 + fq * 8; const bf16_t* bp1 = bp0 + 16 * 2048; const bf16_t* ap = AF + fr * 2056 + fq * 8;
#pragma unroll 8
      for (int ks = 0; ks < 64; ++ks) { const bf16x8 av = *(const bf16x8*)(ap + ks * 32), b0 = *(const bf16x8*)(bp0 + ks * 32), b1 = *(const bf16x8*)(bp1 + ks * 32);
          acc0 = MFMA16(av, b0, acc0); acc1 = MFMA16(av, b1, acc1); }
#pragma unroll
      for (int j = 0; j < 4; ++j) { HID[(fq * 4 + j) * 256 + (2 * wid) * 16 + fr] = siluf(acc0[j]); HID[(fq * 4 + j) * 256 + (2 * wid + 1) * 16 + fr] = siluf(acc1[j]); } }
    __syncthreads();
    { const int e = tid & 63, r0 = tid >> 6; float o0 = 0.f, o1 = 0.f;
      for (int nn = 0; nn < 256; ++nn) { const float w = w2[nn * 64 + e]; o0 += HID[r0 * 256 + nn] * w; o1 += HID[(r0 + 8) * 256 + nn] * w; }
      const int m0 = mb * 16 + r0; if (m0 < 1023) dst[(size_t)m0 * 64 + e] = o0; if (m0 + 8 < 1023) dst[(size_t)(m0 + 8) * 64 + e] = o1;
      const float z0 = m0 < 1023 ? o0 : 0.f, z1 = m0 + 8 < 1023 ? o1 : 0.f; const int m1 = m0 + 8;
      if (which == 0) { bf16_t* kb = (bf16_t*)(pws() + WS_KCB) + (size_t)(b * 2 + kv) * 1024 * 64; kb[(size_t)m0 * 64 + e] = (bf16_t)(pk2(z0, 0.f) & 0xffffu); kb[(size_t)m1 * 64 + e] = (bf16_t)(pk2(z1, 0.f) & 0xffffu); }
      else { bf16_t* vt = (bf16_t*)(pws() + WS_VCT) + (size_t)(b * 2 + kv) * 16 * 4096; vt[(size_t)(m0 >> 6) * 4096 + e * 64 + (m0 & 63)] = (bf16_t)(pk2(z0, 0.f) & 0xffffu); vt[(size_t)(m1 >> 6) * 4096 + e * 64 + (m1 & 63)] = (bf16_t)(pk2(z1, 0.f) & 0xffffu); } }
    __syncthreads();
}
__device__ void vtr_item(const Params& p, int item, float* lds) {
    const int blk = item & 255, kv = (item >> 8) & 1, b = (item >> 9) & 1, which = item >> 10; const int tid = otid();
    const bf16_t* hin = (const bf16_t*)(pws() + WS_HIN); bf16_t* T = (bf16_t*)lds;
    { const int key = tid >> 3, d8 = (tid & 7) * 8; const u32x4 w = *(const u32x4*)(hin + ((size_t)b * SEQ + blk * 64 + key) * DINP + (which ? C_NVW : C_NVS) + kv * 64 + d8);
      T[(d8 + 0) * 72 + key] = (bf16_t)(w.x & 0xffffu); T[(d8 + 1) * 72 + key] = (bf16_t)(w.x >> 16); T[(d8 + 2) * 72 + key] = (bf16_t)(w.y & 0xffffu); T[(d8 + 3) * 72 + key] = (bf16_t)(w.y >> 16);
      T[(d8 + 4) * 72 + key] = (bf16_t)(w.z & 0xffffu); T[(d8 + 5) * 72 + key] = (bf16_t)(w.z >> 16); T[(d8 + 6) * 72 + key] = (bf16_t)(w.w & 0xffffu); T[(d8 + 7) * 72 + key] = (bf16_t)(w.w >> 16); }
    if (which == 0) {
        const int key = tid >> 3, d8 = (tid & 7) * 8; const u32x4 w = *(const u32x4*)(hin + ((size_t)b * SEQ + blk * 64 + key) * DINP + C_NKS + kv * 64 + d8);
        float a = (bflo(w.x) * bflo(w.x) + bfhi(w.x) * bfhi(w.x)) + (bflo(w.y) * bflo(w.y) + bfhi(w.y) * bfhi(w.y)) + (bflo(w.z) * bflo(w.z) + bfhi(w.z) * bfhi(w.z)) + (bflo(w.w) * bflo(w.w) + bfhi(w.w) * bfhi(w.w));
        a += dppf<0xB1>(a); a += dppf<0x4E>(a); a += dppf<0x141>(a);
        a = wave_maxf(a);
        if ((tid & 63) == 0) lds[4096 + (tid >> 6)] = a;
    }
    __syncthreads();
    if (which == 0 && tid == 0) { float m = 0.f; for (int w8 = 0; w8 < 8; ++w8) m = fmaxf(m, lds[4096 + w8]); ((float*)(pws() + WS_KNORM))[(b * 2 + kv) * 256 + blk] = sqrtf(m); }
    { const int dv = tid >> 3, k8 = (tid & 7) * 8; bf16_t* dst = (bf16_t*)(pws() + (which ? WS_VWT : WS_VST)) + ((size_t)((b * 2 + kv) * 256 + blk)) * 4096;
      *(u32x4*)(dst + dv * 64 + k8) = *(const u32x4*)(T + dv * 72 + k8); }
    __syncthreads();
}
__device__ void mixer_phase_pre(const Params& p, int l, float* lds) {
    for (int it = obid(); it < 512 + 2048; it += gridDim.x) { if (it < 512) cmp_item(p, l, it, lds); else vtr_item(p, it - 512, lds); }
    conv_prepass(p, l);
}
__device__ void mixer_phase_a(const Params& p, int l, float* lds) {
    for (int it = obid() + 512; it < 8704; it += gridDim.x) {
        if (it < 512) { for (int r = 0; r < 1 + (AREP & 1); ++r) cmp_item(p, l, it, lds); }
        else if (it < 2560) { for (int r = 0; r < 1 + ((AREP >> 1) & 1); ++r) hg_state_item(p, l, it - 512, lds); }
        else if (it < 6656) { for (int r = 0; r < 1 + ((AREP >> 2) & 1); ++r) ssd_state_item(p, l, it - 2560, lds); }
        else { for (int r = 0; r < 1 + ((AREP >> 3) & 1); ++r) ret_state_item(p, l, it - 6656, lds); }
    }
}
__device__ void scan_phase(const Params& p) {
    for (int wt = obid() + (int)gridDim.x * (otid() >> 6); wt < 1536; wt += (int)gridDim.x * 8) {
        const int task = wt * 64 + (otid() & 63);
        const int br = task >> 15, r = task & 32767;
        bf16_t* base; size_t cstride; const float* decp = nullptr; int dstride = 0; float dconst = 0.f;
        if (br == 0) { const int bh = r >> 12, e4 = r & 4095; base = (bf16_t*)(pws() + WS_STH) + (size_t)bh * 256 * 16384 + e4 * 4; cstride = 16384;
            decp = (const float*)(pws() + WS_DECH) + (size_t)bh * 256 * 128 + ((e4 * 4) >> 7); dstride = 128; }
        else if (br == 1) { const int bh = r >> 11, e4 = r & 2047; base = (bf16_t*)(pws() + WS_STS) + (size_t)bh * 256 * 8192 + e4 * 4; cstride = 8192;
            decp = (const float*)(pws() + WS_DECS) + (size_t)bh * 256; dstride = 1; }
        else { const int bh = r >> 12, e4 = r & 4095; base = (bf16_t*)(pws() + WS_STR) + (size_t)bh * 256 * 16384 + e4 * 4; cstride = 16384; dconst = __expf(64.f * ret_lg(bh & 3)); }
        float s0 = 0.f, s1 = 0.f, s2 = 0.f, s3 = 0.f;
#pragma unroll 8
        for (int c = 0; c < 256; ++c) {
            u32x2* ptr = (u32x2*)(base + (size_t)c * cstride); const u32x2 w = *ptr; const float dec = decp ? decp[(size_t)c * dstride] : dconst;
            u32x2 o; o.x = pk2(s0, s1); o.y = pk2(s2, s3); *ptr = o;
            s0 = dec * s0 + bflo(w.x); s1 = dec * s1 + bfhi(w.x); s2 = dec * s2 + bflo(w.y); s3 = dec * s3 + bfhi(w.y);
        }
    }
}
constexpr int AP = 68;
__device__ __forceinline__ void scores_plain(const float* QS, const float* KS, float (&acc)[2][4]) {
    const int tid = otid(), ti = tid >> 4, tj = tid & 15;
#pragma unroll
    for (int a = 0; a < 2; ++a)
#pragma unroll
        for (int jj = 0; jj < 4; ++jj) acc[a][jj] = 0.f;
    for (int d = 0; d < 128; d += 4) {
        f32x4 q[2], k[4];
#pragma unroll
        for (int a = 0; a < 2; ++a) q[a] = *(const f32x4*)(QS + (ti + 32 * a) * LP + d);
#pragma unroll
        for (int jj = 0; jj < 4; ++jj) k[jj] = *(const f32x4*)(KS + (tj + 16 * jj) * LP + d);
#pragma unroll
        for (int a = 0; a < 2; ++a)
#pragma unroll
            for (int jj = 0; jj < 4; ++jj) { if (a == 0 && jj >= 2) continue;
                acc[a][jj] += (q[a][0] * k[jj][0] + q[a][1] * k[jj][1]) + (q[a][2] * k[jj][2] + q[a][3] * k[jj][3]); }
    }
}
__device__ __forceinline__ void scores_hg(const float* QS, const float* KS, const float* BB, float (&acc)[2][4]) {
    const int tid = otid(), ti = tid >> 4, tj = tid & 15;
#pragma unroll
    for (int a = 0; a < 2; ++a)
#pragma unroll
        for (int jj = 0; jj < 4; ++jj) acc[a][jj] = 0.f;
    for (int d = 0; d < 128; d += 4) {
        f32x4 q[2], bi[2], k[4], bj[4];
#pragma unroll
        for (int a = 0; a < 2; ++a) { q[a] = *(const f32x4*)(QS + (ti + 32 * a) * LP + d); bi[a] = *(const f32x4*)(BB + (ti + 32 * a) * LP + d); }
#pragma unroll
        for (int jj = 0; jj < 4; ++jj) { k[jj] = *(const f32x4*)(KS + (tj + 16 * jj) * LP + d); bj[jj] = *(const f32x4*)(BB + (tj + 16 * jj) * LP + d); }
#pragma unroll
        for (int a = 0; a < 2; ++a)
#pragma unroll
            for (int jj = 0; jj < 4; ++jj) { if (a == 0 && jj >= 2) continue;
#pragma unroll
                for (int x = 0; x < 4; ++x) acc[a][jj] += q[a][x] * k[jj][x] * __expf(fminf(bi[a][x] - bj[jj][x], 0.f)); }
    }
}
template <int DV> __device__ __forceinline__ void load_sprev(const bf16_t* src, float* SP) {
    const int tid = otid();
    for (int e = tid; e < 128 * DV / 4; e += 512) { const int d = e / (DV / 4), v4 = e % (DV / 4); const u32x2 w = *(const u32x2*)(src + (size_t)d * DV + v4 * 4);
        *(f32x4*)(SP + d * (DV + 4) + v4 * 4) = (f32x4){bflo(w.x), bfhi(w.x), bflo(w.y), bfhi(w.y)}; }
}
template <int DV, bool VBF> __device__ __forceinline__ void out_mm(const float* AA, const void* VVp, const float* QS, const float* SP, f32x4 (&intra)[2][DV / 64], f32x4 (&inter)[2][DV / 64]) {
    const int tid = otid(), ti = tid >> 4, tv = tid & 15; constexpr int NV = DV / 64;
#pragma unroll
    for (int a = 0; a < 2; ++a)
#pragma unroll
        for (int n = 0; n < NV; ++n) { intra[a][n] = (f32x4){0.f, 0.f, 0.f, 0.f}; inter[a][n] = (f32x4){0.f, 0.f, 0.f, 0.f}; }
    for (int j = 0; j < 64; j += 4) {
        f32x4 a4[2];
#pragma unroll
        for (int a = 0; a < 2; ++a) a4[a] = *(const f32x4*)(AA + (ti + 32 * a) * AP + j);
#pragma unroll
        for (int x = 0; x < 4; ++x)
#pragma unroll
            for (int n = 0; n < NV; ++n) { f32x4 v;
                if (VBF) { const u32x2 w = *(const u32x2*)((const bf16_t*)VVp + (j + x) * 136 + n * 64 + tv * 4); v = (f32x4){bflo(w.x), bfhi(w.x), bflo(w.y), bfhi(w.y)}; }
                else v = *(const f32x4*)((const float*)VVp + (j + x) * AP + n * 64 + tv * 4);
#pragma unroll
                for (int a = 0; a < 2; ++a) intra[a][n] += v * a4[a][x]; }
    }
    for (int d = 0; d < 128; d += 4) {
        f32x4 q4[2];
#pragma unroll
        for (int a = 0; a < 2; ++a) q4[a] = *(const f32x4*)(QS + (ti + 32 * a) * LP + d);
#pragma unroll
        for (int x = 0; x < 4; ++x)
#pragma unroll
            for (int n = 0; n < NV; ++n) { const f32x4 s = *(const f32x4*)(SP + (d + x) * (DV + 4) + n * 64 + tv * 4);
#pragma unroll
                for (int a = 0; a < 2; ++a) inter[a][n] += s * q4[a][x]; }
    }
}
__device__ __forceinline__ float red16(float v) { v += dppf<0xB1>(v); v += dppf<0x4E>(v); v += dppf<0x141>(v); v += dppf<0x140>(v); return v; }
__device__ __forceinline__ float max16(float v) { v = fmaxf(v, dppf<0xB1>(v)); v = fmaxf(v, dppf<0x4E>(v)); v = fmaxf(v, dppf<0x141>(v)); v = fmaxf(v, dppf<0x140>(v)); return v; }

__device__ void hg_out_item(const Params& p, int l, int item, float* lds) {
    const int c = item & 255, h = (item >> 8) & 3, b = item >> 10; const int tid = otid(), ti = tid >> 4, tj = tid & 15;
    const bf16_t* hin = (const bf16_t*)(pws() + WS_HIN); const size_t t0 = (size_t)b * SEQ + c * 64;
    float* QS = lds; float* KS = lds + 64 * LP; float* BB = lds + 2 * 64 * LP; float* AA = lds + 3 * 64 * LP; bf16_t* VV = (bf16_t*)(lds + 3 * 64 * LP + 64 * AP); float* SP = KS; const float* lbl = pin(10);
#pragma unroll
    for (int i = 0; i < 2; ++i) { const int e = tid + 512 * i, j = e >> 4, d0 = (e & 15) * 8;
        float z[8], q[8], lb[8], bb[8], kk[8]; ld8(hin + (t0 + j) * DINP + C_HF + h * 128 + d0, z); ld8(hin + (t0 + j) * DINP + C_HQ + h * 128 + d0, q); hg_lb8(lbl, l, h * 128 + d0, lb);
#pragma unroll
        for (int k = 0; k < 8; ++k) { const float sn = __builtin_amdgcn_rcpf(1.f + __expf(z[k])), sg = 1.f - sn; bb[k] = __logf(lb[k] + (1.f - lb[k]) * sg); kk[k] = (1.f - lb[k]) * sn; q[k] = siluf(q[k]); }
        st8(BB + j * LP + d0, bb); st8(KS + j * LP + d0, kk); st8(QS + j * LP + d0, q);
        *(u32x4*)(VV + j * 136 + d0) = *(const u32x4*)(hin + (t0 + j) * DINP + C_HI + h * 128 + d0); }
    __syncthreads();
    if (tid < 128) { float a = 0.f; for (int j = 0; j < 64; ++j) { a += BB[j * LP + tid]; BB[j * LP + tid] = a; } }
    __syncthreads();
    { float acc[2][4]; scores_hg(QS, KS, BB, acc);
#pragma unroll
      for (int a = 0; a < 2; ++a)
#pragma unroll
          for (int jj = 0; jj < 4; ++jj) { const int i = ti + 32 * a, j = tj + 16 * jj; AA[i * AP + j] = (j <= i) ? acc[a][jj] : 0.f; } }
    __syncthreads();
#pragma unroll 4
    for (int i = 0; i < 16; ++i) { const int e = tid + 512 * i, j = e >> 7, d = e & 127; QS[j * LP + d] *= __expf(BB[j * LP + d]); }
    __syncthreads();
    load_sprev<128>((const bf16_t*)(pws() + WS_STH) + (size_t)item * 16384, SP);
    __syncthreads();
    f32x4 intra[2][2], inter[2][2]; out_mm<128, true>(AA, VV, QS, SP, intra, inter);
    const int tv = tj; const float* ng = pin(11) + l * 512 + h * 128; bf16_t* mixed = (bf16_t*)(pws() + WS_XB);
#pragma unroll
    for (int a = 0; a < 2; ++a) { const int i = ti + 32 * a; f32x4 o[2]; float ss = 0.f;
#pragma unroll
        for (int n = 0; n < 2; ++n) { o[n] = intra[a][n] + inter[a][n]; ss += (o[n][0] * o[n][0] + o[n][1] * o[n][1]) + (o[n][2] * o[n][2] + o[n][3] * o[n][3]); }
        ss = red16(ss); const float r = rsqrtf(ss * (1.f / 128.f) + 1e-6f);
#pragma unroll
        for (int n = 0; n < 2; ++n) { const int v = n * 64 + tv * 4; const u32x2 gw = *(const u32x2*)(hin + (t0 + i) * DINP + C_HG + h * 128 + v); const f32x4 g4 = *(const f32x4*)(ng + v);
            const float r0 = o[n][0] * r * g4[0] * siluf(bflo(gw.x)), r1 = o[n][1] * r * g4[1] * siluf(bfhi(gw.x)), r2 = o[n][2] * r * g4[2] * siluf(bflo(gw.y)), r3 = o[n][3] * r * g4[3] * siluf(bfhi(gw.y));
            u32x2 w; w.x = pk2(r0, r1); w.y = pk2(r2, r3); *(u32x2*)(mixed + (t0 + i) * DM + h * 128 + v) = w; } }
    __syncthreads();
}
__device__ void ret_out_item(const Params& p, int l, int item, float* lds) {
    const int c = item & 255, h = (item >> 8) & 3, b = item >> 10; const int tid = otid(), ti = tid >> 4, tj = tid & 15;
    const bf16_t* hin = (const bf16_t*)(pws() + WS_HIN); const size_t t0 = (size_t)b * SEQ + c * 64;
    float* QS = lds; float* KS = lds + 64 * LP; float* AA = lds + 3 * 64 * LP; bf16_t* VV = (bf16_t*)(lds + 3 * 64 * LP + 64 * AP); float* SP = KS; float* TH = lds + 3 * 64 * LP + 64 * AP + 64 * AP;
    fill_theta(TH);
    __syncthreads();
    load_rotary(hin, t0, c * 64, C_RQ + h * 128, 1.0f, QS, TH);
    load_rotary(hin, t0, c * 64, C_RK + h * 128, 0.08838834764831845f, KS, TH);
#pragma unroll
    for (int i = 0; i < 2; ++i) { const int e = tid + 512 * i, j = e >> 4, d0 = (e & 15) * 8; *(u32x4*)(VV + j * 136 + d0) = *(const u32x4*)(hin + (t0 + j) * DINP + C_RV + h * 128 + d0); }
    __syncthreads();
    const float lg = ret_lg(h);
    { float acc[2][4]; scores_plain(QS, KS, acc);
#pragma unroll
      for (int a = 0; a < 2; ++a)
#pragma unroll
          for (int jj = 0; jj < 4; ++jj) { const int i = ti + 32 * a, j = tj + 16 * jj; AA[i * AP + j] = (j <= i) ? acc[a][jj] * __expf(lg * (float)(i - j)) : 0.f; } }
    __syncthreads();
    load_sprev<128>((const bf16_t*)(pws() + WS_STR) + (size_t)item * 16384, SP);
    __syncthreads();
    f32x4 intra[2][2], inter[2][2]; out_mm<128, true>(AA, VV, QS, SP, intra, inter);
    const int tv = tj; bf16_t* mixed = (bf16_t*)(pws() + WS_XB);
#pragma unroll
    for (int a = 0; a < 2; ++a) { const int i = ti + 32 * a; const float sc = __expf(lg * (float)(i + 1)); f32x4 o[2]; float s = 0.f;
#pragma unroll
        for (int n = 0; n < 2; ++n) { o[n] = intra[a][n] + inter[a][n] * sc; s += (o[n][0] + o[n][1]) + (o[n][2] + o[n][3]); }
        s = red16(s); const float mu = s * (1.f / 128.f); float q = 0.f;
#pragma unroll
        for (int n = 0; n < 2; ++n) { const f32x4 d = o[n] - mu; q += (d[0] * d[0] + d[1] * d[1]) + (d[2] * d[2] + d[3] * d[3]); }
        q = red16(q); const float r = rsqrtf(q * (1.f / 128.f) + 1e-5f);
#pragma unroll
        for (int n = 0; n < 2; ++n) { const int v = n * 64 + tv * 4; const u32x2 gw = *(const u32x2*)(hin + (t0 + i) * DINP + C_RG + h * 128 + v);
            const float r0 = (o[n][0] - mu) * r * siluf(bflo(gw.x)), r1 = (o[n][1] - mu) * r * siluf(bfhi(gw.x)), r2 = (o[n][2] - mu) * r * siluf(bflo(gw.y)), r3 = (o[n][3] - mu) * r * siluf(bfhi(gw.y));
            u32x2 w; w.x = pk2(r0, r1); w.y = pk2(r2, r3); *(u32x2*)(mixed + (t0 + i) * DM + 1536 + h * 128 + v) = w; } }
    __syncthreads();
}
__device__ void ssd_out_item(const Params& p, int l, int item, float* lds) {
    const int c = item & 255, g = (item >> 8) & 1, b = item >> 9; const int tid = otid(), ti = tid >> 4, tj = tid & 15, tv = tj;
    const bf16_t* hin = (const bf16_t*)(pws() + WS_HIN); const size_t t0 = (size_t)b * SEQ + c * 64;
    const bf16_t* xbc = (const bf16_t*)(pws() + WS_XBC);
    float* CM = lds; float* BM = lds + 8448; float* SP = BM; float* G = lds + 17152; float* AH = lds + 21504; float* VV = lds + 25856; float* XS = lds + 30208; float* AUX = lds + 34560;
    if (tid < 256) { const int hh = tid >> 6, j = tid & 63, h = g * 4 + hh; const float dtv = softplusf(bf2f(hin[(t0 + j) * DINP + C_SDT + h]) + pin(22)[l * 8 + h]);
        AUX[hh * 64 + j] = dtv; AUX[512 + hh * 64 + j] = -dtv * __expf(pin(23)[l * 8 + h]); }
#pragma unroll
    for (int i = 0; i < 2; ++i) { const int e = tid + 512 * i, j = e >> 4, n0 = (e & 15) * 8; float x[8];
        ld8(xbc + ((size_t)b * SEQ + c * 64 + j) * 1024 + 768 + g * 128 + n0, x); st8(CM + j * LP + n0, x);
        ld8(xbc + ((size_t)b * SEQ + c * 64 + j) * 1024 + 512 + g * 128 + n0, x); st8(BM + j * LP + n0, x); }
    __syncthreads();
    if (tid < 256) { const int hh = tid >> 6, j = tid & 63; float a = 0.f; for (int jj = 0; jj <= j; ++jj) a += AUX[512 + hh * 64 + jj]; AUX[256 + hh * 64 + j] = a; }
    { float acc[2][4]; scores_plain(CM, BM, acc);
#pragma unroll
      for (int a = 0; a < 2; ++a)
#pragma unroll
          for (int jj = 0; jj < 4; ++jj) G[(ti + 32 * a) * AP + tj + 16 * jj] = acc[a][jj]; }
    __syncthreads();
    float ss[2] = {0.f, 0.f}; bf16_t* mixed = (bf16_t*)(pws() + WS_XB);
#pragma unroll 1
    for (int hh = 0; hh < 4; ++hh) {
        const int h = g * 4 + hh; const float* dt = AUX + hh * 64; const float* cb = AUX + 256 + hh * 64;
#pragma unroll 2
        for (int i = 0; i < 8; ++i) { const int e = tid + 512 * i, ii = e >> 6, j = e & 63; AH[ii * AP + j] = (j <= ii) ? G[ii * AP + j] * __expf(cb[ii] - cb[j]) : 0.f; }
        { const int j = tid >> 3, pc0 = (tid & 7) * 8; float x[8]; ld8(xbc + ((size_t)b * SEQ + c * 64 + j) * 1024 + h * 64 + pc0, x); st8(XS + j * AP + pc0, x); const float f = dt[j];
#pragma unroll
          for (int k = 0; k < 8; ++k) x[k] *= f;
          st8(VV + j * AP + pc0, x); }
        load_sprev<64>((const bf16_t*)(pws() + WS_STS) + (size_t)(((b * 8 + h) << 8) + c) * 8192, SP);
        __syncthreads();
        f32x4 intra[2][1], inter[2][1]; out_mm<64, false>(AH, VV, CM, SP, intra, inter);
        const float dsk = pin(24)[l * 8 + h];
#pragma unroll
        for (int a = 0; a < 2; ++a) { const int i = ti + 32 * a; const f32x4 xs = *(const f32x4*)(XS + i * AP + tv * 4); const u32x2 zw = *(const u32x2*)(hin + (t0 + i) * DINP + C_SZ + h * 64 + tv * 4);
            f32x4 o = intra[a][0] + inter[a][0] * __expf(cb[i]) + xs * dsk;
            o[0] *= siluf(bflo(zw.x)); o[1] *= siluf(bfhi(zw.x)); o[2] *= siluf(bflo(zw.y)); o[3] *= siluf(bfhi(zw.y));
            ss[a] += (o[0] * o[0] + o[1] * o[1]) + (o[2] * o[2] + o[3] * o[3]);
            u32x2 w; w.x = pk2(o[0], o[1]); w.y = pk2(o[2], o[3]); *(u32x2*)(mixed + (t0 + i) * DM + 1024 + g * 256 + hh * 64 + tv * 4) = w; }
        __syncthreads();
    }
    const float* ng = pin(25) + l * 512 + g * 256;
#pragma unroll
    for (int a = 0; a < 2; ++a) { const int i = ti + 32 * a; const float r = rsqrtf(red16(ss[a]) * (1.f / 256.f) + 1e-6f);
#pragma unroll 1
        for (int hh = 0; hh < 4; ++hh) { const f32x4 g4 = *(const f32x4*)(ng + hh * 64 + tv * 4); u32x2* ptr = (u32x2*)(mixed + (t0 + i) * DM + 1024 + g * 256 + hh * 64 + tv * 4); const u32x2 yw = *ptr;
            const f32x4 o = (f32x4){bflo(yw.x), bfhi(yw.x), bflo(yw.y), bfhi(yw.y)} * r * g4;
            u32x2 w; w.x = pk2(o[0], o[1]); w.y = pk2(o[2], o[3]); *ptr = w; } }
    __syncthreads();
}
#ifndef WREP
#define WREP 1
#endif
#ifndef TREP
#define TREP 1
#endif
#ifndef SREP
#define SREP 1
#endif
__device__ __forceinline__ int t5_bucket(int dist) {
    if (dist < 16) return dist;
    const int lg = 16 + (int)(__log2f((float)dist * 0.0625f) * 2.2857142857142856f);
    return lg < 31 ? lg : 31;
}
__device__ __forceinline__ float dot64_bf(const float (&q)[64], const bf16_t* kp) {
    float s0 = 0.f, s1 = 0.f;
#pragma unroll
    for (int i = 0; i < 8; ++i) { const u32x4 w = *(const u32x4*)(kp + i * 8);
        s0 += (q[8 * i + 0] * bflo(w.x) + q[8 * i + 2] * bflo(w.y)) + (q[8 * i + 4] * bflo(w.z) + q[8 * i + 6] * bflo(w.w));
        s1 += (q[8 * i + 1] * bfhi(w.x) + q[8 * i + 3] * bfhi(w.y)) + (q[8 * i + 5] * bfhi(w.z) + q[8 * i + 7] * bfhi(w.w)); }
    return s0 + s1;
}
__device__ __forceinline__ float dot64_f(const float (&q)[64], const float* kp) {
    float s0 = 0.f, s1 = 0.f;
#pragma unroll
    for (int i = 0; i < 16; ++i) { const f32x4 w = *(const f32x4*)(kp + i * 4); s0 += q[4 * i] * w[0] + q[4 * i + 2] * w[2]; s1 += q[4 * i + 1] * w[1] + q[4 * i + 3] * w[3]; }
    return s0 + s1;
}
__device__ __forceinline__ float softmax_row(float* scr, int ks, int n, float mx_local) {
    const float mx = max16(mx_local); float sum = 0.f;
    for (int idx = ks; idx < n; idx += 16) { const float e = __expf(scr[idx] - mx); scr[idx] = e; sum += e; }
    sum = red16(sum);
    return n > 0 ? 1.f / sum : 0.f;
}
constexpr float NEG_BIG = -1.0e30f;
__device__ __forceinline__ bf16_t f2bf(float x) { return (bf16_t)(pk2(x, 0.f) & 0xffffu); }
__device__ __forceinline__ void ld_k(const bf16_t* kbase, int kpitch, int fr, int fq, bf16x8 (&kb)[4][2]) {
#pragma unroll
    for (int nt = 0; nt < 4; ++nt)
#pragma unroll
        for (int ks = 0; ks < 2; ++ks) kb[nt][ks] = *(const bf16x8*)(kbase + (nt * 16 + fr) * kpitch + ks * 32 + fq * 8);
}
__device__ __forceinline__ void ld_v(const bf16_t* vt, int fr, int fq, bf16x8 (&vb)[4][2]) {
#pragma unroll
    for (int nt = 0; nt < 4; ++nt)
#pragma unroll
        for (int ks = 0; ks < 2; ++ks) vb[nt][ks] = *(const bf16x8*)(vt + (nt * 16 + fr) * 64 + ks * 32 + fq * 8);
}
__device__ __forceinline__ void mma_qk(const bf16x8 (&qa)[2][2], const bf16x8 (&kb)[4][2], f32x4 (&s)[2][4]) {
#pragma unroll
    for (int mt = 0; mt < 2; ++mt)
#pragma unroll
        for (int nt = 0; nt < 4; ++nt) { f32x4 c = (f32x4){0.f, 0.f, 0.f, 0.f};
#pragma unroll
            for (int ks = 0; ks < 2; ++ks) c = MFMA16(qa[mt][ks], kb[nt][ks], c);
            s[mt][nt] = c; }
}
__device__ __forceinline__ void mma_pv(const bf16_t* Pl, const bf16x8 (&vb)[4][2], int fr, int fq, f32x4 (&o)[2][4]) {
    bf16x8 pa[2][2];
#pragma unroll
    for (int mt = 0; mt < 2; ++mt)
#pragma unroll
        for (int ks = 0; ks < 2; ++ks) pa[mt][ks] = *(const bf16x8*)(Pl + (mt * 16 + fr) * 72 + ks * 32 + fq * 8);
#pragma unroll
    for (int nt = 0; nt < 4; ++nt)
#pragma unroll
        for (int ks = 0; ks < 2; ++ks)
#pragma unroll
            for (int mt = 0; mt < 2; ++mt) o[mt][nt] = MFMA16(pa[mt][ks], vb[nt][ks], o[mt][nt]);
}
__device__ void nsa_unit(const Params& p, int l, int item, float* ldsf) {
    int b = item >> 8, qt = item & 255; if (b) qt = 255 - qt;
    const int tid = otid(), wid = tid >> 6, lane = tid & 63, fr = lane & 15, fq = lane >> 4;
    unsigned char* wb = (unsigned char*)ldsf + wid * 16384;
    bf16_t* Pl = (bf16_t*)wb; float* IMP = (float*)(wb + 4608); float* OSEL = IMP; float* PS = (float*)(wb + 12928); int* SEL = (int*)(wb + 15104); int* NSEL = (int*)(wb + 15616);
    float* RB = ldsf + 32768; float* LSUM = ldsf + 33024; float* BND = ldsf + 33280; unsigned long long* QM = (unsigned long long*)(ldsf + 33536); const unsigned char* BK = (const unsigned char*)(ldsf + 34048);
    if (tid < 256) RB[tid] = pin(19)[tid];
    { unsigned char* BKw = (unsigned char*)(ldsf + 34048);
#pragma unroll
      for (int k = 0; k < 4; ++k) BKw[tid * 4 + k] = (unsigned char)t5_bucket(tid * 4 + k); }
    __syncthreads();
    const bf16_t* hin = (const bf16_t*)(pws() + WS_HIN); bf16_t* mixed = (bf16_t*)(pws() + WS_XB);
    const int q0 = qt * 64 + wid * 8; const int tb = b * SEQ;
    float ss[2] = {0.f, 0.f};
#pragma unroll 1
    for (int kv = 0; kv < 2; ++kv) {
        if (tid < 256) QM[tid] = (unsigned long long)(unsigned)(tid >> 20);
        bf16x8 qa[2][2];
#pragma unroll
        for (int mt = 0; mt < 2; ++mt)
#pragma unroll
            for (int ks = 0; ks < 2; ++ks) qa[mt][ks] = *(const bf16x8*)(hin + (tb + q0 + mt * 4 + (fr >> 2)) * DINP + C_NQ + (kv * 4 + (fr & 3)) * 64 + ks * 32 + fq * 8);
        f32x4 ofin[2][4];
        {
            f32x4 (&o)[2][4] = ofin; float m[2][4], ls[2][4];
#pragma unroll
            for (int mt = 0; mt < 2; ++mt) {
#pragma unroll
                for (int nt = 0; nt < 4; ++nt) o[mt][nt] = (f32x4){0.f, 0.f, 0.f, 0.f};
#pragma unroll
                for (int j = 0; j < 4; ++j) { m[mt][j] = NEG_BIG; ls[mt][j] = 0.f; } }
            bf16x8 kb[4][2]; ld_k(hin + (tb + (qt >= 8 ? qt - 8 : 0) * 64) * DINP + C_NKW + kv * 64, DINP, fr, fq, kb);
#pragma unroll 1
            for (int kt = (qt >= 8 ? qt - 8 : 0); kt <= qt; ++kt) {
                bf16x8 vb[4][2]; ld_v((const bf16_t*)(pws() + WS_VWT) + ((size_t)((b * 2 + kv) * 256 + kt)) * 4096, fr, fq, vb);
                f32x4 s[2][4]; mma_qk(qa, kb, s);
#pragma unroll
                for (int mt = 0; mt < 2; ++mt) {
                    const int qpos = q0 + mt * 4 + fq; bool ok[4]; float tmax[4] = {NEG_BIG, NEG_BIG, NEG_BIG, NEG_BIG};
#pragma unroll
                    for (int nt = 0; nt < 4; ++nt) { const int dist = qpos - (kt * 64 + nt * 16 + fr); ok[nt] = dist >= 0 && dist < 512;
                        const f32x4 bias = *(const f32x4*)(RB + (int)BK[dist < 0 ? 0 : (dist > 2047 ? 2047 : dist)] * 8 + kv * 4);
#pragma unroll
                        for (int j = 0; j < 4; ++j) { const float v = ok[nt] ? s[mt][nt][j] * 0.125f + bias[j] : NEG_BIG; s[mt][nt][j] = v; tmax[j] = fmaxf(tmax[j], v); } }
#pragma unroll
                    for (int j = 0; j < 4; ++j) { const float mn = fmaxf(m[mt][j], max16(tmax[j])); const float alpha = __expf(m[mt][j] - mn); m[mt][j] = mn; float rs = 0.f;
#pragma unroll
                        for (int nt = 0; nt < 4; ++nt) { const float pe = ok[nt] ? __expf(s[mt][nt][j] - mn) : 0.f; rs += pe; Pl[(mt * 16 + fq * 4 + j) * 72 + nt * 16 + fr] = f2bf(pe); o[mt][nt][j] *= alpha; }
                        ls[mt][j] = ls[mt][j] * alpha + red16(rs); }
                }
                __builtin_amdgcn_wave_barrier();
                if (kt < qt) ld_k(hin + (tb + (kt + 1) * 64) * DINP + C_NKW + kv * 64, DINP, fr, fq, kb);
                mma_pv(Pl, vb, fr, fq, o);
                __builtin_amdgcn_wave_barrier();
            }
#pragma unroll
            for (int mt = 0; mt < 2; ++mt)
#pragma unroll
                for (int j = 0; j < 4; ++j) { const float g2 = sigmf(bf2f(hin[(tb + q0 + mt * 4 + fq) * DINP + C_NGATE + (kv * 4 + j) * 3 + 2])); const float sc = ls[mt][j] > 0.f ? g2 / ls[mt][j] : 0.f;
#pragma unroll
                    for (int nt = 0; nt < 4; ++nt) ofin[mt][nt][j] *= sc; }
        }
        {
            const int nct = (4 * qt + 3 + 63) >> 6;
            const bf16_t* kc = (const bf16_t*)(pws() + WS_KCB) + (size_t)(b * 2 + kv) * 1024 * 64; const bf16_t* vct = (const bf16_t*)(pws() + WS_VCT) + (size_t)(b * 2 + kv) * 16 * 4096;
            float m[2][4], ls[2][4];
#pragma unroll
            for (int mt = 0; mt < 2; ++mt)
#pragma unroll
                for (int j = 0; j < 4; ++j) { m[mt][j] = NEG_BIG; ls[mt][j] = 0.f; }
            for (int e = lane; e < 8 * 260; e += 64) IMP[e] = 0.f;
            bf16x8 kb[4][2]; ld_k(kc, 64, fr, fq, kb);
#pragma unroll 1
            for (int ct = 0; ct < nct; ++ct) {
                f32x4 s[2][4]; mma_qk(qa, kb, s);
                ld_k(kc + (size_t)(ct + 1 < nct ? ct + 1 : 0) * 64 * 64, 64, fr, fq, kb);
#pragma unroll
                for (int mt = 0; mt < 2; ++mt) {
                    const int qpos = q0 + mt * 4 + fq; bool ok[4]; float tmax[4] = {NEG_BIG, NEG_BIG, NEG_BIG, NEG_BIG};
#pragma unroll
                    for (int nt = 0; nt < 4; ++nt) { const int dist = qpos - (16 * (ct * 64 + nt * 16 + fr) + 31); ok[nt] = dist >= 0;
                        const f32x4 bias = *(const f32x4*)(RB + (int)BK[dist < 0 ? 0 : (dist > 2047 ? 2047 : dist)] * 8 + kv * 4);
#pragma unroll
                        for (int j = 0; j < 4; ++j) { const float v = ok[nt] ? s[mt][nt][j] * 0.125f + bias[j] : NEG_BIG; s[mt][nt][j] = v; tmax[j] = fmaxf(tmax[j], v); } }
#pragma unroll
                    for (int j = 0; j < 4; ++j) { const float mn = fmaxf(m[mt][j], max16(tmax[j])); const float alpha = __expf(m[mt][j] - mn); m[mt][j] = mn; float rs = 0.f;
#pragma unroll
                        for (int nt = 0; nt < 4; ++nt) rs += ok[nt] ? __expf(s[mt][nt][j] - mn) : 0.f;
                        ls[mt][j] = ls[mt][j] * alpha + red16(rs); }
                }
            }
            float inv[2][4];
#pragma unroll
            for (int mt = 0; mt < 2; ++mt)
#pragma unroll
                for (int j = 0; j < 4; ++j) inv[mt][j] = ls[mt][j] > 0.f ? 1.f / ls[mt][j] : 0.f;
            float g0[2][4];
#pragma unroll
            for (int mt = 0; mt < 2; ++mt)
#pragma unroll
                for (int j = 0; j < 4; ++j) g0[mt][j] = sigmf(bf2f(hin[(tb + q0 + mt * 4 + fq) * DINP + C_NGATE + (kv * 4 + j) * 3 + 0]));
            __builtin_amdgcn_wave_barrier();
#pragma unroll 1
            for (int ct = 0; ct < nct; ++ct) {
                bf16x8 vb[4][2]; ld_v(vct + (size_t)ct * 4096, fr, fq, vb);
                f32x4 s[2][4]; mma_qk(qa, kb, s);
#pragma unroll
                for (int mt = 0; mt < 2; ++mt) {
                    const int qpos = q0 + mt * 4 + fq;
#pragma unroll
                    for (int nt = 0; nt < 4; ++nt) { const int dist = qpos - (16 * (ct * 64 + nt * 16 + fr) + 31); const bool ok = dist >= 0;
                        const f32x4 bias = *(const f32x4*)(RB + (int)BK[dist < 0 ? 0 : (dist > 2047 ? 2047 : dist)] * 8 + kv * 4); float psum = 0.f;
#pragma unroll
                        for (int j = 0; j < 4; ++j) { const float pe = ok ? __expf(s[mt][nt][j] * 0.125f + bias[j] - m[mt][j]) * inv[mt][j] : 0.f; psum += pe; Pl[(mt * 16 + fq * 4 + j) * 72 + nt * 16 + fr] = f2bf(pe * g0[mt][j]); }
                        PS[(mt * 4 + fq) * 68 + nt * 16 + fr] = psum; }
                }
                __builtin_amdgcn_wave_barrier();
                { const int qi = lane >> 3, l8 = lane & 7; const float* pr = PS + qi * 68; float* ir = IMP + qi * 260 + ct * 16;
#pragma unroll
                  for (int x = 0; x < 2; ++x) { const int jb = l8 + 8 * x; const f32x4 v = *(const f32x4*)(pr + 4 * jb); float a = (v[0] + v[1]) + (v[2] + 0.5f * v[3]); if (jb > 0) a += 0.5f * pr[4 * jb - 1]; ir[jb] += a; }
                  if (l8 == 0) ir[16] += 0.5f * pr[63]; }
                if (ct + 1 < nct) ld_k(kc + (size_t)(ct + 1) * 64 * 64, 64, fr, fq, kb);
                mma_pv(Pl, vb, fr, fq, ofin);
                __builtin_amdgcn_wave_barrier();
            }
        }
        __syncthreads();
        float* QN = PS;
        {
            if (lane < 32) { const bf16_t* qp = hin + (tb + q0 + (lane >> 2)) * DINP + C_NQ + (kv * 4 + (lane & 3)) * 64; float a = 0.f;
#pragma unroll
                for (int i = 0; i < 8; ++i) { const u32x4 w = *(const u32x4*)(qp + i * 8);
                    a += (bflo(w.x) * bflo(w.x) + bfhi(w.x) * bfhi(w.x)) + (bflo(w.y) * bflo(w.y) + bfhi(w.y) * bfhi(w.y)) + (bflo(w.z) * bflo(w.z) + bfhi(w.z) * bfhi(w.z)) + (bflo(w.w) * bflo(w.w) + bfhi(w.w) * bfhi(w.w)); }
                QN[lane] = sqrtf(a); }
            if (lane < 4) { float bm = 0.f; for (int bk = 0; bk < 32; ++bk) bm = fmaxf(bm, fabsf(RB[bk * 8 + kv * 4 + lane])); QN[32 + lane] = bm; }
        }
        __builtin_amdgcn_wave_barrier();
        const float* KN = (const float*)(pws() + WS_KNORM) + (b * 2 + kv) * 256;
#pragma unroll 1
        for (int qi = 0; qi < 8; ++qi) {
            const int qpos = q0 + qi, cur = qpos >> 6; unsigned long long key[4];
#pragma unroll
            for (int jj = 0; jj < 4; ++jj) { const int j = lane + 64 * jj; unsigned long long kk = 0ull;
                if (j <= cur) { const float val = (j == 0 || j == cur || j == cur - 1) ? 5.0f : IMP[qi * 260 + j]; kk = ((unsigned long long)(__float_as_uint(val) + 1u) << 32) | (unsigned)(255 - j); }
                key[jj] = kk; }
            float knmax = 0.f;
            for (int it = 0; it < 16; ++it) {
                unsigned long long best = key[0] > key[1] ? key[0] : key[1]; { const unsigned long long b2 = key[2] > key[3] ? key[2] : key[3]; best = b2 > best ? b2 : best; }
                best = wave_max_u64(best);
                if ((best >> 32) == 0ull) break;
                const int jsel = 255 - (int)(unsigned)(best & 0xffffffffull);
                if (lane == it) { lds_or64(QM + jsel, 1ull << (wid * 8 + qi)); knmax = KN[jsel]; }
#pragma unroll
                for (int jj = 0; jj < 4; ++jj) if (key[jj] == best) key[jj] = 0ull;
            }
            const float bq = wave_maxf(knmax);
            if (lane < 4) BND[(wid * 8 + qi) * 4 + lane] = QN[qi * 4 + lane] * bq * (0.125f * 1.002f) + QN[32 + lane] + 1e-3f;
        }
        __builtin_amdgcn_wave_barrier();
        for (int e = lane; e < 2048; e += 64) OSEL[e] = 0.f;
        if (lane < 32) LSUM[wid * 32 + lane] = 0.f;
        __syncthreads();
#pragma unroll 1
        for (int j = wid; j <= qt; j += 8) {
            unsigned long long mask; { const unsigned long long mv = QM[j]; mask = ((unsigned long long)(unsigned)__builtin_amdgcn_readfirstlane((unsigned)(mv >> 32)) << 32) | (unsigned long long)(unsigned)__builtin_amdgcn_readfirstlane((unsigned)mv); }
            if (mask == 0ull) continue;
            bf16x8 kb[4][2], vb[4][2]; ld_k(hin + (tb + j * 64) * DINP + C_NKS + kv * 64, DINP, fr, fq, kb); ld_v((const bf16_t*)(pws() + WS_VST) + ((size_t)((b * 2 + kv) * 256 + j)) * 4096, fr, fq, vb);
            const bool far = (qt * 64 - (j * 64 + 63)) >= 1536;
#pragma unroll 1
            while (mask != 0ull) {
                int q4[4];
#pragma unroll
                for (int g = 0; g < 4; ++g) { if (mask != 0ull) { q4[g] = __builtin_ctzll(mask); mask &= mask - 1ull; } else q4[g] = -1; }
                const int ga = fr >> 2; const int myq = ga == 0 ? q4[0] : ga == 1 ? q4[1] : ga == 2 ? q4[2] : q4[3];
                const int rq = fq == 0 ? q4[0] : fq == 1 ? q4[1] : fq == 2 ? q4[2] : q4[3];
                bf16x8 qs[2];
#pragma unroll
                for (int ks = 0; ks < 2; ++ks) { qs[ks] = (bf16x8){0, 0, 0, 0, 0, 0, 0, 0}; if (myq >= 0) qs[ks] = *(const bf16x8*)(hin + (tb + qt * 64 + myq) * DINP + C_NQ + (kv * 4 + (fr & 3)) * 64 + ks * 32 + fq * 8); }
                f32x4 s[4];
#pragma unroll
                for (int nt = 0; nt < 4; ++nt) { f32x4 c = (f32x4){0.f, 0.f, 0.f, 0.f};
#pragma unroll
                    for (int ks = 0; ks < 2; ++ks) c = MFMA16(qs[ks], kb[nt][ks], c);
                    s[nt] = c; }
                const f32x4 bnd = *(const f32x4*)(BND + (rq >= 0 ? rq : 0) * 4); const int qpos = qt * 64 + rq; float rs[4] = {0.f, 0.f, 0.f, 0.f};
#pragma unroll
                for (int nt = 0; nt < 4; ++nt) { const int dist = qpos - (j * 64 + nt * 16 + fr); const bool ok = rq >= 0 && dist >= 0;
                    const f32x4 bias = *(const f32x4*)(RB + (far ? 31 : (int)BK[dist < 0 ? 0 : (dist > 2047 ? 2047 : dist)]) * 8 + kv * 4);
#pragma unroll
                    for (int jj = 0; jj < 4; ++jj) { const float pe = ok ? __expf(s[nt][jj] * 0.125f + bias[jj] - bnd[jj]) : 0.f; rs[jj] += pe; Pl[(fq * 4 + jj) * 72 + nt * 16 + fr] = f2bf(pe); } }
#pragma unroll
                for (int jj = 0; jj < 4; ++jj) { const float r = red16(rs[jj]); if (fr == 0 && rq >= 0) lds_addf(LSUM + rq * 4 + jj, r); }
                __builtin_amdgcn_wave_barrier();
                bf16x8 pa[2];
#pragma unroll
                for (int ks = 0; ks < 2; ++ks) pa[ks] = *(const bf16x8*)(Pl + fr * 72 + ks * 32 + fq * 8);
                { float* ob = ldsf + ((rq >= 0 ? rq : 0) >> 3) * 4096 + 1152 + ((rq >= 0 ? rq : 0) & 7) * 256;
#pragma unroll
                    for (int nt = 0; nt < 4; ++nt) { f32x4 c = (f32x4){0.f, 0.f, 0.f, 0.f};
#pragma unroll
                        for (int ks = 0; ks < 2; ++ks) c = MFMA16(pa[ks], vb[nt][ks], c);
                        if (rq >= 0) {
#pragma unroll
                            for (int jj = 0; jj < 4; ++jj) lds_addf(ob + jj * 64 + nt * 16 + fr, c[jj]); } } }
                __builtin_amdgcn_wave_barrier();
            }
        }
        __syncthreads();
#pragma unroll
        for (int mt = 0; mt < 2; ++mt) { const int trow = (tb + q0 + mt * 4 + fq) * DM + 512 + kv * 256;
#pragma unroll
            for (int j = 0; j < 4; ++j) { const float g1 = sigmf(bf2f(hin[(tb + q0 + mt * 4 + fq) * DINP + C_NGATE + (kv * 4 + j) * 3 + 1])); const float lsum = LSUM[(wid * 8 + mt * 4 + fq) * 4 + j]; const float scl = lsum > 0.f ? g1 / lsum : 0.f;
#pragma unroll
                for (int nt = 0; nt < 4; ++nt) { const float v = ofin[mt][nt][j] + OSEL[((mt * 4 + fq) * 4 + j) * 64 + nt * 16 + fr] * scl; ss[mt] += v * v; mixed[trow + j * 64 + nt * 16 + fr] = f2bf(v); } } }
        __syncthreads();
    }
    const float* ng = pin(18) + l * 512;
#pragma unroll
    for (int mt = 0; mt < 2; ++mt) { const float r = rsqrtf(red16(ss[mt]) * (1.f / 512.f) + 1e-6f); const int trow = (tb + q0 + mt * 4 + fq) * DM + 512;
#pragma unroll 4
        for (int c = 0; c < 32; ++c) { const int col = c * 16 + fr; mixed[trow + col] = f2bf(bf2f(mixed[trow + col]) * r * ng[col]); } }
    __syncthreads();
}
#ifndef NSA_REP
#define NSA_REP 1
#endif
template <int PCM> __device__ __forceinline__ void mixer_phase_c_item(const Params& p, int l, int it, float* lds);
template <int PCM> __device__ __forceinline__ void mixer_phase_c(const Params& p, int l, float* lds) {
    if (PCM == 15) {
        unsigned* ctr = (unsigned*)(pws() + WS_BAR) + 16 + 16 * l;
        for (;;) {
            if (otid() == 0) ((volatile int*)lds)[36000] = (int)__hip_atomic_fetch_add(ctr, 1u, __ATOMIC_RELAXED, __HIP_MEMORY_SCOPE_AGENT);
            __syncthreads();
            const int it = __builtin_amdgcn_readfirstlane(((volatile int*)lds)[36000]);
            __syncthreads();
            if (it >= 5632) break;
            mixer_phase_c_item<PCM>(p, l, it, lds);
        }
        return;
    }
    for (int it = obid(); it < 5632; it += gridDim.x) mixer_phase_c_item<PCM>(p, l, it, lds);
}
template <int PCM> __device__ __forceinline__ void mixer_phase_c_item(const Params& p, int l, int it, float* lds) {
    {
        if (it < 512) { if (PCM & 1) { const int u = (it & 1) ? 256 + (it >> 1) : 255 - (it >> 1);
            for (int rep = 0; rep < NSA_REP; ++rep) nsa_unit(p, l, u, lds); } }
        else if (it < 1536) { if (PCM & 4) { for (int r = 0; r < 1 + ((CREP >> 1) & 1); ++r) ssd_out_item(p, l, it - 512, lds); } }
        else if (it < 3584) { if (PCM & 2) { for (int r = 0; r < 1 + (CREP & 1); ++r) hg_out_item(p, l, it - 1536, lds); } }
        else { if (PCM & 8) { for (int r = 0; r < 1 + ((CREP >> 2) & 1); ++r) ret_out_item(p, l, it - 3584, lds); } }
    }
}
#ifndef REPEAT_MASK
#define REPEAT_MASK 0
#endif
constexpr int NPHASE = 1 + 13 * NLAYER;
__device__ __forceinline__ void grid_bar(unsigned* ctr, unsigned target) {
    asm volatile("s_waitcnt vmcnt(0) lgkmcnt(0)" ::: "memory");
    __syncthreads();
    if (threadIdx.x == 0) {
        __builtin_amdgcn_fence(__ATOMIC_RELEASE, "agent");
        asm volatile("s_waitcnt vmcnt(0)" ::: "memory");
        __hip_atomic_fetch_add(ctr, 1u, __ATOMIC_RELAXED, __HIP_MEMORY_SCOPE_AGENT);
        unsigned spins = 0;
        while (__hip_atomic_load(ctr, __ATOMIC_RELAXED, __HIP_MEMORY_SCOPE_AGENT) < target) { __builtin_amdgcn_s_sleep(2); if (++spins > (1u << 22)) break; }
        __builtin_amdgcn_fence(__ATOMIC_ACQUIRE, "agent");
        asm volatile("s_waitcnt vmcnt(0)" ::: "memory");
    }
    __syncthreads();
}
template <int PHM> __global__ void __launch_bounds__(NTHREADS, 2) mega_fwd(Params p) {
    extern __shared__ __attribute__((aligned(16))) unsigned char lds_raw[];
    if (threadIdx.x == 0) {
#pragma unroll
        for (int k = 0; k < 31; ++k) g_ptab[k] = (unsigned long long)p.in[k];
        g_ptab[31] = (unsigned long long)p.out; g_ptab[32] = (unsigned long long)p.ws; }
    __syncthreads();
    float* ldsf = (float*)lds_raw; LAS unsigned char* ldsl = (LAS unsigned char*)lds_raw;
        unsigned nbar = 0;
    for (int ph = p.ph_lo; ph < p.ph_hi; ++ph) {
        if (ph == 0 && (PHM & 1)) { cvt_x(p); cvt_ffn(p, 0, 0, ldsf); cvt_mix(p, 0, ldsf); cvt_w1t(p, ldsf); }
        else {
            bf16_t* XB = (bf16_t*)(pws() + WS_XB); bf16_t* HIN = (bf16_t*)(pws() + WS_HIN);
            const int l = (ph - 1) / 13, s = (ph - 1) % 13;
            for (int rep = 0; rep < (((REPEAT_MASK >> s) & 1) ? 2 : 1); ++rep) {
            if ((s == 0 || s == 10) && (PHM & 2)) {
                pg8::Gemm g{XB, (const bf16_t*)(pws() + WS_WA), NTOK, 11264, DM}; pg8::StaticOrder S; S.init(NTOK, 11264, (int)gridDim.x, (int)obid());
                EpiUp E{HIN}; pg8::gemm_phase<EpiUp, pg8::StaticOrder>(ldsl, g, S, E, nullptr);
            } else if ((s == 1 || s == 11 || s == 8) && (PHM & 4)) {
                const bool mix = (s == 8);
                pg8::Gemm g{mix ? XB : HIN, (const bf16_t*)(pws() + (mix ? WS_WD : WS_WB)), NTOK, DM, mix ? DM : DFF}; pg8::StaticOrder S; S.init(NTOK, DM, (int)gridDim.x, (int)obid());
                EpiRes E{(l == 0 && s == 1) ? pin(0) : (mix ? (const float*)pout() : nullptr), XB, pout(), ALPHA, mix ? 1.0f : 0.5f}; pg8::gemm_phase<EpiRes, pg8::StaticOrder>(ldsl, g, S, E, nullptr);
            } else if (s == 3 && (PHM & 8)) {
                pg8::Gemm g{XB, (const bf16_t*)(pws() + WS_WC), NTOK, DINP, DM}; pg8::StaticOrder S; S.init(NTOK, DINP, (int)gridDim.x, (int)obid());
                pg8::EpiBf16<0> E{HIN, DINP, nullptr, 0, 0}; pg8::gemm_phase<pg8::EpiBf16<0>, pg8::StaticOrder>(ldsl, g, S, E, nullptr);
            } else if (s == 2 && (PHM & 16)) { ln_rows(pout(), XB, pin(1) + l * DM, pin(2) + l * DM, true); cvt_ffn(p, l, 1, ldsf); }
            else if (s == 9 && (PHM & 16)) { ln_rows(pout(), XB, pin(6) + l * DM, pin(7) + l * DM, false); }
            else if (s == 12 && (PHM & 16)) { ln_rows(pout(), XB, pin(26) + l * DM, pin(27) + l * DM, l + 1 == NLAYER); if (l + 1 < NLAYER) { cvt_ffn(p, l + 1, 0, ldsf); cvt_mix(p, l + 1, ldsf); } }
            else if (s == 4 && (PHM & 32)) mixer_phase_pre(p, l, ldsf);
            else if (s == 5 && (PHM & 32)) mixer_phase_a(p, l, ldsf);
            else if (s == 6 && (PHM & 64)) scan_phase(p);
            else if (s == 7 && (PHM & 384)) mixer_phase_c<((PHM & 128) ? 1 : 0) | ((PHM & 256) ? 14 : 0)>(p, l, ldsf);
            }
        }
        if (ph + 1 < p.ph_hi) { if (ph == p.ph_lo) cg::this_grid().sync(); else grid_bar((unsigned*)(pws() + WS_BAR), (++nbar) * gridDim.x); }
    }
}

#ifndef HOST_REPEAT
#define HOST_REPEAT 0
#endif
#ifndef MULTI_LAUNCH
#define MULTI_LAUNCH 0
#endif
static int phase_mask(int ph) { if (ph == 0) return 1; const int s = (ph - 1) % 13; return (s == 0 || s == 10) ? 2 : (s == 1 || s == 11 || s == 8) ? 4 : s == 3 ? 8 : (s == 2 || s == 9 || s == 12) ? 16 : (s == 4 || s == 5) ? 32 : s == 6 ? 64 : 128; }
template <int M> static bool setup_one(int* per_cu) {
    if (hipFuncSetAttribute((const void*)mega_fwd<M>, hipFuncAttributeMaxDynamicSharedMemorySize, LDS_BYTES) != hipSuccess) return false;
    int pc = 0; if (hipOccupancyMaxActiveBlocksPerMultiprocessor(&pc, (const void*)mega_fwd<M>, NTHREADS, LDS_BYTES) != hipSuccess) pc = 0; *per_cu = pc; return true;
}
extern "C" void kernel_launch(void* const* d_in, const int* in_sizes, int n_in, void* d_out, int out_size, void* d_ws, size_t ws_size, hipStream_t stream) {
    static int grid = 0;
    if (grid == 0) {
        if (n_in != 31 || out_size != NTOK * DM || ws_size < WS_END) { fprintf(stderr, "kernel_launch: unexpected shapes: n_in %d out %d ws %zu (need %zu)\n", n_in, out_size, ws_size, (size_t)WS_END); grid = -1; return; }
        int dev = 0, cus = 0, per_cu = 0; bool ok = true;
        (void)hipGetDevice(&dev); (void)hipDeviceGetAttribute(&cus, hipDeviceAttributeMultiprocessorCount, dev);
#if MULTI_LAUNCH
        ok = setup_one<1>(&per_cu) && setup_one<2>(&per_cu) && setup_one<4>(&per_cu) && setup_one<8>(&per_cu) && setup_one<16>(&per_cu) && setup_one<32>(&per_cu) && setup_one<64>(&per_cu) && setup_one<128>(&per_cu) && setup_one<256>(&per_cu);
#else
        ok = setup_one<511>(&per_cu);
#endif
        (void)hipGetLastError();
        if (!ok) { fprintf(stderr, "kernel_launch: hipFuncSetAttribute failed\n"); grid = -1; return; }
        grid = cus;
        fprintf(stderr, "kernel_launch: grid %d (cus %d, per_cu %d)\n", grid, cus, per_cu);
    }
    if (grid < 0) return;
    Params p{};
    for (int i = 0; i < 31; ++i) p.in[i] = (const float*)d_in[i];
    p.out = (float*)d_out; p.ws = (unsigned char*)d_ws;
#if MULTI_LAUNCH
    for (int ph = 0; ph < NPHASE; ++ph) { p.ph_lo = ph; p.ph_hi = ph + 1;
      for (int hrep = 0; hrep < ((ph > 0 && ((HOST_REPEAT >> ((ph - 1) % 13)) & 1)) ? 2 : 1); ++hrep)
        switch (phase_mask(ph)) {
            case 1: hipLaunchKernelGGL(mega_fwd<1>, dim3(grid), dim3(NTHREADS), LDS_BYTES, stream, p); break;
            case 2: hipLaunchKernelGGL(mega_fwd<2>, dim3(grid), dim3(NTHREADS), LDS_BYTES, stream, p); break;
            case 4: hipLaunchKernelGGL(mega_fwd<4>, dim3(grid), dim3(NTHREADS), LDS_BYTES, stream, p); break;
            case 8: hipLaunchKernelGGL(mega_fwd<8>, dim3(grid), dim3(NTHREADS), LDS_BYTES, stream, p); break;
            case 16: hipLaunchKernelGGL(mega_fwd<16>, dim3(grid), dim3(NTHREADS), LDS_BYTES, stream, p); break;
            case 32: hipLaunchKernelGGL(mega_fwd<32>, dim3(grid), dim3(NTHREADS), LDS_BYTES, stream, p); break;
            case 64: hipLaunchKernelGGL(mega_fwd<64>, dim3(grid), dim3(NTHREADS), LDS_BYTES, stream, p); break;
            default: hipLaunchKernelGGL(mega_fwd<128>, dim3(grid), dim3(NTHREADS), LDS_BYTES, stream, p); hipLaunchKernelGGL(mega_fwd<256>, dim3(grid), dim3(NTHREADS), LDS_BYTES, stream, p); break;
        }
    }
#else
    p.ph_lo = 0; p.ph_hi = NPHASE;
    (void)hipMemsetAsync((unsigned char*)d_ws + WS_BAR, 0, 256, stream);
    void* args[] = {&p};
    hipError_t e = hipLaunchCooperativeKernel((const void*)mega_fwd<511>, dim3(grid), dim3(NTHREADS), args, LDS_BYTES, stream);
    if (e != hipSuccess) fprintf(stderr, "kernel_launch: cooperative launch failed: %s (grid %d)\n", hipGetErrorString(e), grid);
#endif
}
```

```cpp
#include <hip/hip_runtime.h>
#include <hip/hip_cooperative_groups.h>
#include <cstdio>
namespace cg = cooperative_groups;
__device__ __forceinline__ int otid() { int t = (int)threadIdx.x; asm volatile("" : "+v"(t)); return t; }
__device__ __forceinline__ int obid() { int t = (int)blockIdx.x; asm volatile("" : "+s"(t)); return t; }
template <int CTRL> __device__ __forceinline__ float dppf(float v) { return __int_as_float(__builtin_amdgcn_mov_dpp(__float_as_int(v), CTRL, 0xf, 0xf, true)); }
template <int CTRL> __device__ __forceinline__ unsigned dppu(unsigned v) { return (unsigned)__builtin_amdgcn_mov_dpp((int)v, CTRL, 0xf, 0xf, true); }
template <int CTRL> __device__ __forceinline__ unsigned long long dppu64(unsigned long long v) { return ((unsigned long long)dppu<CTRL>((unsigned)(v >> 32)) << 32) | dppu<CTRL>((unsigned)v); }
template <int K> __device__ __forceinline__ int sxi(int v) {
    if constexpr (K < 32) return __builtin_amdgcn_ds_swizzle(v, (K << 10) | 0x1f);
    else return __builtin_amdgcn_ds_bpermute(((otid() & 63) ^ 32) << 2, v);
}
template <int K> __device__ __forceinline__ float sxf(float v) { return __int_as_float(sxi<K>(__float_as_int(v))); }
__device__ __forceinline__ float wave_sum(float v) { v += sxf<1>(v); v += sxf<2>(v); v += sxf<4>(v); v += sxf<8>(v); v += sxf<16>(v); v += sxf<32>(v); return v; }
template <int K> __device__ __forceinline__ unsigned long long sxu64(unsigned long long v) { const unsigned lo = (unsigned)sxi<K>((int)(unsigned)v), hi = (unsigned)sxi<K>((int)(unsigned)(v >> 32)); return ((unsigned long long)hi << 32) | lo; }
__device__ __forceinline__ unsigned long long wave_max_u64(unsigned long long b) { unsigned long long o;
    o = dppu64<0xB1>(b); b = o > b ? o : b; o = dppu64<0x4E>(b); b = o > b ? o : b; o = dppu64<0x141>(b); b = o > b ? o : b; o = dppu64<0x140>(b); b = o > b ? o : b; o = sxu64<16>(b); b = o > b ? o : b; o = sxu64<32>(b); b = o > b ? o : b; return b; }
__device__ __forceinline__ float wave_maxf(float v) { v = fmaxf(v, dppf<0xB1>(v)); v = fmaxf(v, dppf<0x4E>(v)); v = fmaxf(v, dppf<0x141>(v)); v = fmaxf(v, dppf<0x140>(v)); v = fmaxf(v, sxf<16>(v)); v = fmaxf(v, sxf<32>(v)); return v; }
__device__ __forceinline__ void lds_addf(float* p, float v) { __hip_atomic_fetch_add((__attribute__((address_space(3))) float*)p, v, __ATOMIC_RELAXED, __HIP_MEMORY_SCOPE_WORKGROUP); }
__device__ __forceinline__ void lds_or64(unsigned long long* p, unsigned long long v) { __hip_atomic_fetch_or((__attribute__((address_space(3))) unsigned long long*)p, v, __ATOMIC_RELAXED, __HIP_MEMORY_SCOPE_WORKGROUP); }
namespace pg8 {
#define PG8_LAS __attribute__((address_space(3)))
typedef unsigned short bf16_t;
typedef short bf16x8 __attribute__((ext_vector_type(8)));
typedef float f32x4 __attribute__((ext_vector_type(4)));
typedef unsigned u32x4 __attribute__((ext_vector_type(4)));
constexpr int BM = 256, BK = 64, HALF = 128, HTB = HALF * BK * 2  , STAGE_BYTES = 8 * HTB, NXCD = 8, WGM = 8;

__host__ __device__ __forceinline__ int lds_byte(int r, int c) { const int st = (r >> 4) * 2 + (c >> 5), rr = r & 15, cc = c & 31, ob = rr * 64 + cc * 2; return st * 1024 + (ob ^ (((ob >> 9) & 1) << 5)); }
__host__ __device__ __forceinline__ void stage_rc(int b, int& R, int& C) { const int st = b / 1024, sb = b % 1024, swz = sb ^ (((sb >> 9) & 1) << 5); R = (st >> 1) * 16 + swz / 64; C = (st & 1) * 32 + (swz % 64) / 2; }
__host__ __device__ __forceinline__ int perm32(int rho) { const int n = rho >> 4, i = rho & 15; return 8 * (i >> 2) + 4 * n + (i & 3); }

struct Unit { int pm, pn; };
struct Gemm { const bf16_t* A; const bf16_t* Bt; int M, N, K; };

struct StaticOrder {
    int nM, nN, nwg, G, c;
    __host__ __device__ void init(int M, int N, int G_, int c_) { nM = M / BM; nN = N / BM; nwg = nM * nN; G = G_; c = c_; }
    __host__ __device__ bool next(int i, Unit& u) const {
        const long L = (long)i * G + c; if (L >= nwg) return false;
        int wgid = (int)L; { const int q = nwg / NXCD, r = nwg % NXCD, xcd = wgid % NXCD, off = wgid / NXCD; wgid = (xcd < r ? xcd * (q + 1) : r * (q + 1) + (xcd - r) * q) + off; }
        const int nig = WGM * nN, gid = wgid / nig, fm = gid * WGM, gsz = (nM - fm) < WGM ? (nM - fm) : WGM;
        u.pm = fm + ((wgid % nig) % gsz); u.pn = (wgid % nig) / gsz; return true;
    }
    __device__ __forceinline__ void a_ready(const Unit&) const {}
    __device__ __forceinline__ void done(const Unit&) const {}
};
struct CountedOrder : StaticOrder {
    const unsigned* ready; unsigned need; unsigned* tmo;
    __device__ __forceinline__ void a_ready(const Unit& u) const {
        if (threadIdx.x < 64) {
            const unsigned long long t0 = __builtin_amdgcn_s_memrealtime(); unsigned polls = 0;
            while ((unsigned)__builtin_amdgcn_readfirstlane(__hip_atomic_load(ready + 64 * u.pm, __ATOMIC_RELAXED, __HIP_MEMORY_SCOPE_AGENT)) < need) {
                if ((++polls & 255u) == 0u && __builtin_amdgcn_readfirstlane(__hip_atomic_load(tmo, __ATOMIC_RELAXED, __HIP_MEMORY_SCOPE_AGENT)) != 0u) break;
                if (__builtin_amdgcn_s_memrealtime() - t0 > 2000000ull) {
                    if (threadIdx.x == 0) { unsigned expect = 0u; __hip_atomic_compare_exchange_strong(tmo + 1, &expect, 0x600u | (unsigned)(u.pm & 0xff), __ATOMIC_RELAXED, __ATOMIC_RELAXED, __HIP_MEMORY_SCOPE_AGENT); __hip_atomic_store(tmo, 1u, __ATOMIC_RELAXED, __HIP_MEMORY_SCOPE_AGENT); }
                    break; }
                __builtin_amdgcn_s_sleep(2); }
            __builtin_amdgcn_fence(__ATOMIC_ACQUIRE, "agent");
            asm volatile("s_waitcnt vmcnt(0)" ::: "memory");
        }
#if !defined(BROKEN_HOOK_NO_BARRIER)
        asm volatile("" ::: "memory"); __builtin_amdgcn_s_barrier(); asm volatile("" ::: "memory");
#endif
    }
};

__device__ __forceinline__ unsigned cvt_pk_bf16(float lo, float hi) { unsigned r; asm volatile("v_cvt_pk_bf16_f32 %0, %1, %2" : "=v"(r) : "v"(lo), "v"(hi)); return r; }
typedef float f32x2 __attribute__((ext_vector_type(2)));
__device__ __forceinline__ f32x2 gelu_pk(f32x2 v) {
    const f32x2 av = __builtin_elementwise_abs(v), d = av * 0.2316418882f + 1.0f;
    f32x2 t; t.x = __builtin_amdgcn_rcpf(d.x); t.y = __builtin_amdgcn_rcpf(d.y);
    f32x2 q = t * 0.5307027145f + (-0.7265760135f); q = q * t + 0.7107068705f; q = q * t + (-0.142248368f); q = q * t + 0.127414796f; q = q * t;
    const f32x2 s = (v * v) * (-0.72134752044f);
    f32x2 e; e.x = __builtin_amdgcn_exp2f(s.x); e.y = __builtin_amdgcn_exp2f(s.y);
    const f32x2 m = v * (q * e), r = v - m;
    f32x2 o; o.x = v.x < 0.f ? m.x : r.x; o.y = v.y < 0.f ? m.y : r.y; return o;
}

struct EpiF32 {
    static constexpr bool PERM = false, AFTER_DRAIN = false;
    float* C; int ldc; const float* bias;
    __device__ __forceinline__ void operator()(const f32x4 (&acc)[2][2][4][2], const Unit& u, int wr, int wc, int fr, int fq) const {
        const int row0 = u.pm * BM + wr * 64 + fr, col0 = u.pn * BM + wc * 32 + 4 * fq;
        f32x4 bv[2][2];
#pragma unroll
        for (int bj = 0; bj < 2; ++bj)
#pragma unroll
            for (int n = 0; n < 2; ++n) bv[bj][n] = bias ? *(const f32x4*)(bias + col0 + bj * HALF + n * 16) : (f32x4){0.f, 0.f, 0.f, 0.f};
#pragma unroll
        for (int ai = 0; ai < 2; ++ai)
#pragma unroll
            for (int m = 0; m < 4; ++m) { float* rowp = C + (size_t)(row0 + ai * HALF + m * 16) * ldc + col0;
#pragma unroll
                for (int bj = 0; bj < 2; ++bj)
#pragma unroll
                    for (int n = 0; n < 2; ++n) *(f32x4*)(rowp + bj * HALF + n * 16) = acc[ai][bj][m][n] + bv[bj][n]; }
    }
};
template <int ACT  > struct EpiBf16 {
    static constexpr bool PERM = true, AFTER_DRAIN = false;
    bf16_t* O; int ldc; const float* bias; int split_cols; size_t split_stride;
    __device__ __forceinline__ void operator()(const f32x4 (&acc)[2][2][4][2], const Unit& u, int wr, int wc, int fr, int fq) const {
        const int row0 = u.pm * BM + wr * 64 + fr; int colt = u.pn * BM; bf16_t* base = O;
        if (split_cols) { const int t = colt / split_cols; base += (size_t)t * split_stride; colt -= t * split_cols; }
        const int col0 = colt + wc * 32 + 8 * fq, bcol0 = u.pn * BM + wc * 32 + 8 * fq;
        f32x4 bv[2][2];
#pragma unroll
        for (int bj = 0; bj < 2; ++bj)
#pragma unroll
            for (int n = 0; n < 2; ++n) bv[bj][n] = bias ? *(const f32x4*)(bias + bcol0 + bj * HALF + 4 * n) : (f32x4){0.f, 0.f, 0.f, 0.f};
#pragma unroll
        for (int ai = 0; ai < 2; ++ai)
#pragma unroll
            for (int m = 0; m < 4; ++m) { bf16_t* rowp = base + (size_t)(row0 + ai * HALF + m * 16) * ldc + col0;
#pragma unroll
                for (int bj = 0; bj < 2; ++bj) { f32x4 v0 = acc[ai][bj][m][0] + bv[bj][0], v1 = acc[ai][bj][m][1] + bv[bj][1];
                    if (ACT == 1) { f32x2 a = gelu_pk((f32x2){v0[0], v0[1]}), b = gelu_pk((f32x2){v0[2], v0[3]}), c = gelu_pk((f32x2){v1[0], v1[1]}), d = gelu_pk((f32x2){v1[2], v1[3]});
                        v0 = (f32x4){a.x, a.y, b.x, b.y}; v1 = (f32x4){c.x, c.y, d.x, d.y}; }
                    if (ACT == 2) {
#pragma unroll
                        for (int j = 0; j < 4; ++j) { v0[j] = 0.5f * v0[j] * (1.0f + erff(v0[j] * 0.70710678f)); v1[j] = 0.5f * v1[j] * (1.0f + erff(v1[j] * 0.70710678f)); } }
                    u32x4 w; w.x = cvt_pk_bf16(v0[0], v0[1]); w.y = cvt_pk_bf16(v0[2], v0[3]); w.z = cvt_pk_bf16(v1[0], v1[1]); w.w = cvt_pk_bf16(v1[2], v1[3]);
                    *(u32x4*)(rowp + bj * HALF) = w; } }
    }
};
template <class Epi, class Sched, bool STAMP = false>
__device__ __forceinline__ void gemm_phase(PG8_LAS unsigned char* lds, const Gemm g, const Sched& S, const Epi& E, unsigned long long* stamps) {
    const int tid = otid(), wid = __builtin_amdgcn_readfirstlane(tid >> 6), lane = tid & 63, wr = wid >> 2, wc = wid & 3, fr = lane & 15, fq = lane >> 4;
    const int K = g.K, nt = K / BK;
    int ts_lo = 0, ts_hi = 0, nts = 0; const unsigned long long rt_entry = STAMP ? (unsigned long long)wall_clock64() : 0ull;
#define PG8_STAMP() do { if (STAMP && wid == 0 && nts < 64) { const unsigned long long _c = (unsigned long long)clock64(); \
        ts_lo = (lane == nts) ? (int)(unsigned)_c : ts_lo; ts_hi = (lane == nts) ? (int)(unsigned)(_c >> 32) : ts_hi; ++nts; } } while (0)
    PG8_STAMP();
    unsigned voffA[2], voffB[2];
#pragma unroll
    for (int i = 0; i < 2; ++i) { int R, C; stage_rc(tid * 16 + i * 8192, R, C); const int Rb = Epi::PERM ? ((R & ~31) + perm32(R & 31)) : R;
        voffA[i] = (unsigned)(R * K + C) * 2u; voffB[i] = (unsigned)(Rb * K + C) * 2u; }
    const size_t kstep = (size_t)(BK * 2);
    const size_t hstep = (size_t)HALF * K * 2;
    const size_t tstep = 2 * hstep;
    const unsigned ldsw = (unsigned)wid * 1024u;
    const int aoff = lds_byte(wr * 64 + fr, fq * 8), boff = lds_byte(wc * 32 + fr, fq * 8);
#define PG8_SA(b, h) (((b) * 2 + (h)) * HTB)
#define PG8_SB(b, h) ((4 + (b) * 2 + (h)) * HTB)
#define PG8_STAGE(bufoff, gbase, voff) do { _Pragma("unroll") for (int _i = 0; _i < 2; ++_i) \
        __builtin_amdgcn_global_load_lds((const unsigned*)((const char*)(gbase) + (voff)[_i]), (PG8_LAS unsigned*)(lds + (bufoff) + ldsw + _i * 8192), 16, 0, 0); } while (0)
#define PG8_LDA(dst, b, h) do { _Pragma("unroll") for (int m = 0; m < 4; ++m) _Pragma("unroll") for (int k = 0; k < 2; ++k) dst[m][k] = *(const PG8_LAS bf16x8*)(lds + PG8_SA(b, h) + aoff + m * 2048 + k * 1024); } while (0)
#define PG8_LDB(dst, b, h) do { _Pragma("unroll") for (int n = 0; n < 2; ++n) _Pragma("unroll") for (int k = 0; k < 2; ++k) dst[n][k] = *(const PG8_LAS bf16x8*)(lds + PG8_SB(b, h) + boff + n * 2048 + k * 1024); } while (0)
#define PG8_MMA(ai, bj, At, Bt) do { __builtin_amdgcn_s_setprio(1); _Pragma("unroll") for (int m = 0; m < 4; ++m) _Pragma("unroll") for (int n = 0; n < 2; ++n) _Pragma("unroll") for (int k = 0; k < 2; ++k) \
        acc[ai][bj][m][n] = __builtin_amdgcn_mfma_f32_16x16x32_bf16(Bt[n][k], At[m][k], acc[ai][bj][m][n], 0, 0, 0); __builtin_amdgcn_s_setprio(0); } while (0)
#define PG8_WAIT_V(n) asm volatile("s_waitcnt vmcnt(" #n ")" ::: "memory")
#define PG8_WAIT_L(n) asm volatile("s_waitcnt lgkmcnt(" #n ")" ::: "memory")
#define PG8_BAR __builtin_amdgcn_s_barrier()
#define PG8_SCHED __builtin_amdgcn_sched_barrier(0)
    Unit cur, nxt; int ui = 0;
    if (!S.next(0, cur)) return;
    f32x4 acc[2][2][4][2];
#pragma unroll
    for (int a = 0; a < 2; ++a)
#pragma unroll
        for (int b = 0; b < 2; ++b)
#pragma unroll
            for (int m = 0; m < 4; ++m)
#pragma unroll
                for (int n = 0; n < 2; ++n) acc[a][b][m][n] = (f32x4){0.f, 0.f, 0.f, 0.f};
    bf16x8 At[4][2], B0[2][2], B1[2][2];
    const char* cA = (const char*)g.A + (size_t)cur.pm * tstep; const char* cB = (const char*)g.Bt + (size_t)cur.pn * tstep;
    S.a_ready(cur);
    PG8_STAGE(PG8_SB(0, 0), cB, voffB); PG8_STAGE(PG8_SA(0, 0), cA, voffA); PG8_STAGE(PG8_SB(0, 1), cB + hstep, voffB); PG8_STAGE(PG8_SA(0, 1), cA + hstep, voffA);
    if (wr == 1) PG8_BAR;
    PG8_WAIT_V(4); PG8_BAR;
    PG8_STAGE(PG8_SB(1, 0), cB + kstep, voffB); PG8_STAGE(PG8_SA(1, 0), cA + kstep, voffA); PG8_STAGE(PG8_SB(1, 1), cB + hstep + kstep, voffB);
    PG8_WAIT_V(6); PG8_BAR;
    PG8_STAMP();
    for (;;) {
        const bool has_next = S.next(ui + 1, nxt);
        const char* nA = has_next ? (const char*)g.A + (size_t)nxt.pm * tstep : cA; const char* nB = has_next ? (const char*)g.Bt + (size_t)nxt.pn * tstep : cB;
        for (int t = 0; t < nt; t += 2) {
            const bool last = (t == nt - 2);
            const char* a1 = cA + (size_t)(t + 1) * kstep;
            const char* a2 = last ? nA : cA + (size_t)(t + 2) * kstep; const char* b2 = last ? nB : cB + (size_t)(t + 2) * kstep;
            const char* a3 = a2 + kstep; const char* b3 = b2 + kstep;
            if (last && has_next) S.a_ready(nxt);
            PG8_LDB(B0, 0, 0); PG8_SCHED; PG8_LDA(At, 0, 0); PG8_STAGE(PG8_SA(1, 1), a1 + hstep, voffA);
            PG8_WAIT_L(8); PG8_BAR; PG8_WAIT_L(0); PG8_MMA(0, 0, At, B0); PG8_BAR; PG8_SCHED;
            PG8_LDB(B1, 0, 1); PG8_STAGE(PG8_SB(0, 0), b2, voffB);
            PG8_BAR; PG8_WAIT_L(0); PG8_MMA(0, 1, At, B1); PG8_BAR;
            PG8_LDA(At, 0, 1); PG8_STAGE(PG8_SA(0, 0), a2, voffA);
            PG8_BAR; PG8_WAIT_L(0); PG8_MMA(1, 0, At, B0); PG8_BAR; PG8_SCHED;
            PG8_STAGE(PG8_SB(0, 1), b2 + hstep, voffB);
            PG8_WAIT_V(6); PG8_BAR; PG8_MMA(1, 1, At, B1); PG8_BAR;
            PG8_LDB(B0, 1, 0); PG8_SCHED; PG8_LDA(At, 1, 0); PG8_STAGE(PG8_SA(0, 1), a2 + hstep, voffA);
            PG8_WAIT_L(8); PG8_BAR; PG8_WAIT_L(0); PG8_MMA(0, 0, At, B0); PG8_BAR; PG8_SCHED;
            PG8_LDB(B1, 1, 1); PG8_STAGE(PG8_SB(1, 0), b3, voffB);
            PG8_BAR; PG8_WAIT_L(0); PG8_MMA(0, 1, At, B1); PG8_BAR;
            PG8_LDA(At, 1, 1); PG8_STAGE(PG8_SA(1, 0), a3, voffA);
            PG8_BAR; PG8_WAIT_L(0); PG8_MMA(1, 0, At, B0); PG8_BAR; PG8_SCHED;
            PG8_STAGE(PG8_SB(1, 1), b3 + hstep, voffB);
            PG8_WAIT_V(6); PG8_BAR; PG8_MMA(1, 1, At, B1); PG8_BAR;
        }
        PG8_STAMP();
        if constexpr (!Epi::AFTER_DRAIN) { E(acc, cur, wr, wc, fr, fq); S.done(cur); }
        PG8_STAMP();
        if (!has_next) break;
#pragma unroll
        for (int a = 0; a < 2; ++a)
#pragma unroll
            for (int b = 0; b < 2; ++b)
#pragma unroll
                for (int m = 0; m < 4; ++m)
#pragma unroll
                    for (int n = 0; n < 2; ++n) acc[a][b][m][n] = (f32x4){0.f, 0.f, 0.f, 0.f};
        cur = nxt; cA = nA; cB = nB; ++ui;
    }
    PG8_WAIT_V(0);
    if (wr == 0) PG8_BAR;
    PG8_BAR;
    if constexpr (Epi::AFTER_DRAIN) { E.fused(acc, cur, wr, wc, fr, fq, lds, wid, lane); S.done(cur); }
    PG8_STAMP();
    if (STAMP && wid == 0) { stamps[lane] = lane < nts ? (((unsigned long long)(unsigned)ts_hi << 32) | (unsigned)ts_lo) : 0ull;
        if (lane == 62) stamps[62] = rt_entry; if (lane == 63) stamps[63] = (unsigned long long)wall_clock64(); }
#undef PG8_STAMP
#undef PG8_SA
#undef PG8_SB
#undef PG8_STAGE
#undef PG8_LDA
#undef PG8_LDB
#undef PG8_MMA
#undef PG8_WAIT_V
#undef PG8_WAIT_L
#undef PG8_BAR
#undef PG8_SCHED
}
}
typedef unsigned short bf16_t;
typedef float f32x4 __attribute__((ext_vector_type(4)));
typedef unsigned u32x4 __attribute__((ext_vector_type(4)));
typedef unsigned u32x2 __attribute__((ext_vector_type(2)));
typedef short bf16x8 __attribute__((ext_vector_type(8)));
#define MFMA16(a, b, c) __builtin_amdgcn_mfma_f32_16x16x32_bf16((a), (b), (c), 0, 0, 0)
#define LAS __attribute__((address_space(3)))

constexpr int SEQ = 16384, NBATCH = 2, NTOK = 32768, DM = 2048, DFF = 5632, DIN = 6944, DINP = 7168, NLAYER = 2;
constexpr int C_HQ = 0, C_HF = 512, C_HI = 1024, C_HG = 1536, C_NQ = 2048, C_NKC = 2560, C_NVC = 2688, C_NKS = 2816, C_NVS = 2944,
              C_NKW = 3072, C_NVW = 3200, C_NGATE = 3328, C_SZ = 3352, C_SXBC = 3864, C_SDT = 4888, C_RQ = 4896, C_RK = 5408, C_RV = 5920, C_RG = 6432;
constexpr float ALPHA = 1.41421356237f;
constexpr int LDS_BYTES = 147456;
constexpr int NTHREADS = 512;

constexpr size_t WS_WA = 0;
constexpr size_t WS_WB = WS_WA + (size_t)11264 * 2048 * 2;
constexpr size_t WS_WC = WS_WB + (size_t)2048 * 5632 * 2;
constexpr size_t WS_WD = WS_WC + (size_t)7168 * 2048 * 2;
constexpr size_t WS_XB = WS_WD + (size_t)2048 * 2048 * 2;
constexpr size_t WS_HIN = WS_XB + (size_t)NTOK * 2048 * 2;
constexpr size_t WS_STH = WS_HIN + (size_t)NTOK * DINP * 2;
constexpr size_t WS_STS = WS_STH + (size_t)2048 * 16384 * 2;
constexpr size_t WS_STR = WS_STS + (size_t)4096 * 8192 * 2;
constexpr size_t WS_DECH = WS_STR + (size_t)2048 * 16384 * 2;
constexpr size_t WS_DECS = WS_DECH + (size_t)2048 * 128 * 4;
constexpr size_t WS_KCMP = WS_DECS + (size_t)4096 * 4;
constexpr size_t WS_VCMP = WS_KCMP + (size_t)4 * 1024 * 64 * 4;
constexpr size_t WS_VST = WS_VCMP + (size_t)4 * 1024 * 64 * 4;
constexpr size_t WS_VWT = WS_VST + (size_t)4 * 256 * 4096 * 2;
constexpr size_t WS_KCB = WS_VWT + (size_t)4 * 256 * 4096 * 2;
constexpr size_t WS_VCT = WS_KCB + (size_t)4 * 1024 * 64 * 2;
constexpr size_t WS_XBC = WS_VCT + (size_t)4 * 16 * 4096 * 2;
constexpr size_t WS_KNORM = WS_XBC + (size_t)NTOK * 1024 * 2;
constexpr size_t WS_BAR = WS_KNORM + (size_t)4 * 256 * 4;
constexpr size_t WS_W1T = WS_BAR + 256;
constexpr size_t WS_END = WS_W1T + (size_t)4 * 256 * 2048 * 2;

struct Params {
    const float* in[31];
    float* out;
    unsigned char* ws;
    int ph_lo, ph_hi;
};

__shared__ unsigned long long g_ptab[40];
__device__ __forceinline__ unsigned long long ptab_get(int k) { const unsigned long long v = *(volatile LAS unsigned long long*)((LAS unsigned long long*)g_ptab + k);
    unsigned lo = __builtin_amdgcn_readfirstlane((unsigned)v), hi = __builtin_amdgcn_readfirstlane((unsigned)(v >> 32)); asm volatile("" : "+s"(lo), "+s"(hi)); return ((unsigned long long)hi << 32) | lo; }
#define GAS __attribute__((address_space(1)))
__device__ __forceinline__ const float* pin(int k) { return (const float*)(GAS const float*)ptab_get(k); }
__device__ __forceinline__ float* pout() { return (float*)(GAS float*)ptab_get(31); }
__device__ __forceinline__ unsigned char* pws() { return (unsigned char*)(GAS unsigned char*)ptab_get(32); }
__device__ __forceinline__ float bf2f(bf16_t v) { return __uint_as_float(((unsigned)v) << 16); }
__device__ __forceinline__ float bflo(unsigned w) { return __uint_as_float(w << 16); }
__device__ __forceinline__ float bfhi(unsigned w) { return __uint_as_float(w & 0xffff0000u); }
__device__ __forceinline__ unsigned pk2(float lo, float hi) { return pg8::cvt_pk_bf16(lo, hi); }
__device__ __forceinline__ void ld8(const bf16_t* p, float (&x)[8]) { const u32x4 w = *(const u32x4*)p; x[0] = bflo(w.x); x[1] = bfhi(w.x); x[2] = bflo(w.y); x[3] = bfhi(w.y); x[4] = bflo(w.z); x[5] = bfhi(w.z); x[6] = bflo(w.w); x[7] = bfhi(w.w); }
__device__ __forceinline__ void st8(float* p, const float (&x)[8]) { *(f32x4*)p = (f32x4){x[0], x[1], x[2], x[3]}; *(f32x4*)(p + 4) = (f32x4){x[4], x[5], x[6], x[7]}; }
__device__ __forceinline__ void ldf8(const float* p, float (&x)[8]) { const f32x4 a = *(const f32x4*)p, b = *(const f32x4*)(p + 4); x[0] = a[0]; x[1] = a[1]; x[2] = a[2]; x[3] = a[3]; x[4] = b[0]; x[5] = b[1]; x[6] = b[2]; x[7] = b[3]; }
__device__ __forceinline__ float siluf(float x) { return x * __builtin_amdgcn_rcpf(1.f + __expf(-x)); }
__device__ __forceinline__ float sigmf(float x) { return __builtin_amdgcn_rcpf(1.f + __expf(-x)); }
__device__ __forceinline__ float softplusf(float x) { const float e = __expf(-fabsf(x)); const float l1 = e < 0.01f ? e * (1.f - e * (0.5f - e * (1.f / 3.f))) : __logf(1.f + e); return fmaxf(x, 0.f) + l1; }

__device__ __forceinline__ void cvt_tile(const float* s0, const float* s1, bf16_t* dstp, int K, int N, int mode, int tile, float* tl) {
    const int nkb = K >> 6; const int rb = tile / nkb, kb = tile - rb * nkb;
    const int r0 = rb * 128; const float* src = s0; int col0 = r0;
    if (mode == 1) { const int pn = r0 >> 8, bj = (r0 >> 7) & 1; src = bj ? s1 : s0; col0 = pn * 128; }
    const int tid = otid();
    { const int n = tid & 127, k0 = tid >> 7; const bool ok = (col0 + n) < N; const float* sp = src + (size_t)(kb * 64 + k0) * N + col0 + n;
#pragma unroll
      for (int i = 0; i < 16; ++i) tl[(k0 + 4 * i) * 129 + n] = ok ? __builtin_nontemporal_load(sp + (size_t)(4 * i) * N) : 0.f; }
    __syncthreads();
    { const int k8 = (tid & 7) * 8;
#pragma unroll
      for (int i = 0; i < 2; ++i) { const int n = (tid >> 3) + 64 * i; const float* c = tl + k8 * 129 + n;
          u32x4 w; w.x = pk2(c[0], c[129]); w.y = pk2(c[2 * 129], c[3 * 129]); w.z = pk2(c[4 * 129], c[5 * 129]); w.w = pk2(c[6 * 129], c[7 * 129]);
          *(u32x4*)(dstp + (size_t)(r0 + n) * K + kb * 64 + k8) = w; } }
    __syncthreads();
}
__device__ void cvt_ffn(const Params& p, int l, int which  , float* tl) {
    const float* w1 = pin(which ? 28 : 3) + (size_t)l * DM * DFF; const float* w3 = pin(which ? 29 : 4) + (size_t)l * DM * DFF; const float* w2 = pin(which ? 30 : 5) + (size_t)l * DFF * DM;
    constexpr int n0 = (11264 / 128) * (DM / 64), n1 = (DM / 128) * (DFF / 64);
    for (int g = obid(); g < n0 + n1; g += gridDim.x) { const bool f = g < n0;
        cvt_tile(f ? w1 : w2, w3, (bf16_t*)(pws() + (f ? WS_WA : WS_WB)), f ? DM : DFF, f ? DFF : DM, f ? 1 : 0, f ? g : g - n0, tl); }
}
__device__ void cvt_mix(const Params& p, int l, float* tl) {
    constexpr int n0 = (DINP / 128) * (DM / 64), n1 = (DM / 128) * (DM / 64);
    for (int g = obid(); g < n0 + n1; g += gridDim.x) { const bool f = g < n0;
        cvt_tile(f ? pin(8) + (size_t)l * DM * DIN : pin(9) + (size_t)l * DM * DM, nullptr, (bf16_t*)(pws() + (f ? WS_WC : WS_WD)), DM, f ? DIN : DM, 0, f ? g : g - n0, tl); }
}
__device__ void cvt_w1t(const Params& p, float* tl) {
    for (int g = obid(); g < 256; g += gridDim.x) { const int job = g >> 6, l = job >> 1, which = job & 1;
        cvt_tile(pin(which ? 16 : 13) + (size_t)l * 2048 * 256, nullptr, (bf16_t*)(pws() + WS_W1T) + (size_t)job * 256 * 2048, 2048, 256, 0, g & 63, tl); }
}
__device__ void cvt_x(const Params& p) {
    const f32x4* x = (const f32x4*)pin(0); u32x2* xb = (u32x2*)(pws() + WS_XB);
    for (size_t i = (size_t)obid() * NTHREADS + otid(); i < (size_t)NTOK * DM / 4; i += (size_t)gridDim.x * NTHREADS) {
        const f32x4 v = __builtin_nontemporal_load(x + i); u32x2 w; w.x = pk2(v[0], v[1]); w.y = pk2(v[2], v[3]); xb[i] = w; }
}

struct EpiUp {
    static constexpr bool PERM = true, AFTER_DRAIN = false;
    bf16_t* H;
    __device__ __forceinline__ void operator()(const pg8::f32x4 (&acc)[2][2][4][2], const pg8::Unit& u, int wr, int wc, int fr, int fq) const {
        const int row0 = u.pm * 256 + wr * 64 + fr, col0 = u.pn * 128 + wc * 32 + 8 * fq;
#pragma unroll
        for (int ai = 0; ai < 2; ++ai)
#pragma unroll
            for (int m = 0; m < 4; ++m) { bf16_t* rowp = H + (size_t)(row0 + ai * 128 + m * 16) * DFF + col0;
                const pg8::f32x4 a0 = acc[ai][0][m][0], a1 = acc[ai][0][m][1], b0 = acc[ai][1][m][0], b1 = acc[ai][1][m][1];
                float v0[4], v1[4];
#pragma unroll
                for (int j = 0; j < 4; ++j) { v0[j] = siluf(a0[j]) * b0[j]; v1[j] = siluf(a1[j]) * b1[j]; }
                pg8::u32x4 w; w.x = pk2(v0[0], v0[1]); w.y = pk2(v0[2], v0[3]); w.z = pk2(v1[0], v1[1]); w.w = pk2(v1[2], v1[3]);
                *(pg8::u32x4*)rowp = w; }
    }
};
struct EpiRes {
    static constexpr bool PERM = false, AFTER_DRAIN = false;
    const float* res32; const bf16_t* res16; float* out; float alpha, scale;
    __device__ __forceinline__ void operator()(const pg8::f32x4 (&acc)[2][2][4][2], const pg8::Unit& u, int wr, int wc, int fr, int fq) const {
        const int row0 = u.pm * 256 + wr * 64 + fr, col0 = u.pn * 256 + wc * 32 + 4 * fq;
#pragma unroll
        for (int ai = 0; ai < 2; ++ai)
#pragma unroll
            for (int m = 0; m < 4; ++m) { const size_t off = (size_t)(row0 + ai * 128 + m * 16) * DM + col0;
#pragma unroll
                for (int bj = 0; bj < 2; ++bj)
#pragma unroll
                    for (int n = 0; n < 2; ++n) { pg8::f32x4 r;
                        if (res32) r = *(const pg8::f32x4*)(res32 + off + bj * 128 + n * 16);
                        else { const u32x2 w = *(const u32x2*)(res16 + off + bj * 128 + n * 16); r = (pg8::f32x4){bflo(w.x), bfhi(w.x), bflo(w.y), bfhi(w.y)}; }
                        *(pg8::f32x4*)(out + off + bj * 128 + n * 16) = r * alpha + acc[ai][bj][m][n] * scale; } }
    }
};

__device__ void ln_rows(float* X, bf16_t* xb, const float* g, const float* b, bool write_f32) {
    const int wid = otid() >> 6, lane = otid() & 63;
    for (int row = obid() * 8 + wid; row < NTOK; row += gridDim.x * 8) {
        float* xr = X + (size_t)row * DM; f32x4 v[8]; float s = 0.f;
#pragma unroll
        for (int i = 0; i < 8; ++i) { v[i] = __builtin_nontemporal_load((const f32x4*)(xr + i * 256 + lane * 4)); s += (v[i][0] + v[i][1]) + (v[i][2] + v[i][3]); }
        s = wave_sum(s);
        const float mean = s * (1.f / DM); float q = 0.f;
#pragma unroll
        for (int i = 0; i < 8; ++i) { const f32x4 d = v[i] - mean; q += (d[0] * d[0] + d[1] * d[1]) + (d[2] * d[2] + d[3] * d[3]); }
        q = wave_sum(q);
        const float rstd = rsqrtf(q * (1.f / DM) + 1e-5f);
#pragma unroll
        for (int i = 0; i < 8; ++i) { const int c = i * 256 + lane * 4; const f32x4 gg = *(const f32x4*)(g + c), bb = *(const f32x4*)(b + c);
            const f32x4 o = (v[i] - mean) * rstd * gg + bb; if (write_f32) *(f32x4*)(xr + c) = o;
            u32x2 w; w.x = pk2(o[0], o[1]); w.y = pk2(o[2], o[3]); *(u32x2*)(xb + (size_t)row * DM + c) = w; }
    }
}
#ifndef AREP
#define AREP 0
#endif
#ifndef CREP
#define CREP 0
#endif
constexpr int LP = 132;
__device__ __forceinline__ float hg_lb(const float* lg, int l, int idx) {
    if (l == 0) return 0.f; const float a0 = lg[idx], a1 = lg[512 + idx]; return 1.f / (1.f + __expf(a0 - a1));
}
__device__ __forceinline__ void hg_lb8(const float* lg, int l, int idx, float (&lb)[8]) {
    if (l == 0) {
#pragma unroll
        for (int k = 0; k < 8; ++k) lb[k] = 0.f;
    } else { float a0[8], a1[8]; ldf8(lg + idx, a0); ldf8(lg + 512 + idx, a1);
#pragma unroll
        for (int k = 0; k < 8; ++k) lb[k] = __builtin_amdgcn_rcpf(1.f + __expf(a0[k] - a1[k])); }
}
template <int DV> __device__ __forceinline__ void state_mm(const float* KD, const float* VV, bf16_t* dst) {
    const int tid = otid(), td = tid >> 4, tv = tid & 15;
    constexpr int NV = DV / 64;
    f32x4 acc[4][NV];
#pragma unroll
    for (int a = 0; a < 4; ++a)
#pragma unroll
        for (int n = 0; n < NV; ++n) acc[a][n] = (f32x4){0.f, 0.f, 0.f, 0.f};
    for (int j = 0; j < 64; ++j) {
        f32x4 v[NV];
#pragma unroll
        for (int n = 0; n < NV; ++n) v[n] = *(const f32x4*)(VV + j * LP + n * 64 + tv * 4);
#pragma unroll
        for (int a = 0; a < 4; ++a) { const float kd = KD[j * LP + td + 32 * a];
#pragma unroll
            for (int n = 0; n < NV; ++n) acc[a][n] += v[n] * kd; }
    }
#pragma unroll
    for (int a = 0; a < 4; ++a)
#pragma unroll
        for (int n = 0; n < NV; ++n) { u32x2 w; w.x = pk2(acc[a][n][0], acc[a][n][1]); w.y = pk2(acc[a][n][2], acc[a][n][3]);
            *(u32x2*)(dst + (size_t)(td + 32 * a) * DV + n * 64 + tv * 4) = w; }
}
__device__ __forceinline__ float ssd_act(const bf16_t* xbc, int b, int s, int ch) { return bf2f(xbc[((size_t)b * SEQ + s) * 1024 + ch]); }
__device__ void conv_prepass(const Params& p, int l) {
    const int tid = otid(), cg8 = (tid & 127) * 8, slot = tid >> 7;
    const bf16_t* hin = (const bf16_t*)(pws() + WS_HIN); bf16_t* xbc = (bf16_t*)(pws() + WS_XBC); const float* cw = pin(20) + l * 4096; const float* cb = pin(21) + l * 1024;
    float w[4][8], bias[8];
#pragma unroll
    for (int c = 0; c < 8; ++c) { bias[c] = cb[cg8 + c];
#pragma unroll
        for (int t = 0; t < 4; ++t) w[t][c] = cw[t * 1024 + cg8 + c]; }
    for (int tok = obid() * 4 + slot; tok < NTOK; tok += gridDim.x * 4) {
        const int s = tok & (SEQ - 1); float acc[8];
#pragma unroll
        for (int c = 0; c < 8; ++c) acc[c] = bias[c];
#pragma unroll
        for (int t = 0; t < 4; ++t) { if (s - 3 + t >= 0) { const u32x4 x = *(const u32x4*)(hin + (size_t)(tok - 3 + t) * DINP + C_SXBC + cg8);
            acc[0] += w[t][0] * bflo(x.x); acc[1] += w[t][1] * bfhi(x.x); acc[2] += w[t][2] * bflo(x.y); acc[3] += w[t][3] * bfhi(x.y);
            acc[4] += w[t][4] * bflo(x.z); acc[5] += w[t][5] * bfhi(x.z); acc[6] += w[t][6] * bflo(x.w); acc[7] += w[t][7] * bfhi(x.w); } }
        u32x4 o; o.x = pk2(siluf(acc[0]), siluf(acc[1])); o.y = pk2(siluf(acc[2]), siluf(acc[3])); o.z = pk2(siluf(acc[4]), siluf(acc[5])); o.w = pk2(siluf(acc[6]), siluf(acc[7]));
        *(u32x4*)(xbc + (size_t)tok * 1024 + cg8) = o;
    }
}
__device__ __forceinline__ void load_rotary(const bf16_t* hin, size_t t0, int pos0, int col0, float scale, float* dst, const float* theta) {
    const int tid = otid();
#pragma unroll
    for (int i = 0; i < 2; ++i) { const int e = tid + 512 * i; const int j = e >> 4, p0 = (e & 15) * 4;
        float x[8], y[8]; ld8(hin + (t0 + j) * DINP + col0 + 2 * p0, x);
#pragma unroll
        for (int k = 0; k < 4; ++k) { const float ang = (float)(pos0 + j) * theta[p0 + k];
            const float n = rintf(ang * 0.15915494309189535f); float r = fmaf(-n, 6.28125f, ang); r = fmaf(-n, 1.9353071795864769e-3f, r);
            const float sn = __sinf(r), cs = __cosf(r);
            y[2 * k] = (x[2 * k] * cs - x[2 * k + 1] * sn) * scale; y[2 * k + 1] = (x[2 * k] * sn + x[2 * k + 1] * cs) * scale; }
        st8(dst + j * LP + 2 * p0, y); }
}
__device__ __forceinline__ void fill_theta(float* theta) { if (otid() < 64) theta[otid()] = exp2f(-(float)otid() * (13.287712379549449f / 63.0f)); }

__device__ void hg_state_item(const Params& p, int l, int item, float* lds) {
    const int c = item & 255, h = (item >> 8) & 3, b = item >> 10; const int tid = otid();
    const bf16_t* hin = (const bf16_t*)(pws() + WS_HIN); const size_t t0 = (size_t)b * SEQ + c * 64;
    float* KD = lds; float* VV = lds + 64 * LP; float* BB = lds + 2 * 64 * LP; const float* lbl = pin(10);
#pragma unroll
    for (int i = 0; i < 2; ++i) { const int e = tid + 512 * i, j = e >> 4, d0 = (e & 15) * 8;
        float z[8], v[8], lb[8], bb[8], kk[8]; ld8(hin + (t0 + j) * DINP + C_HF + h * 128 + d0, z); ld8(hin + (t0 + j) * DINP + C_HI + h * 128 + d0, v); hg_lb8(lbl, l, h * 128 + d0, lb);
#pragma unroll
        for (int k = 0; k < 8; ++k) { const float sn = __builtin_amdgcn_rcpf(1.f + __expf(z[k])), sg = 1.f - sn; bb[k] = __logf(lb[k] + (1.f - lb[k]) * sg); kk[k] = (1.f - lb[k]) * sn; }
        st8(BB + j * LP + d0, bb); st8(KD + j * LP + d0, kk); st8(VV + j * LP + d0, v); }
    __syncthreads();
    if (tid < 128) { float a = 0.f; for (int j = 0; j < 64; ++j) { a += BB[j * LP + tid]; BB[j * LP + tid] = a; } }
    __syncthreads();
#pragma unroll
    for (int i = 0; i < 2; ++i) { const int e = tid + 512 * i, j = e >> 4, d0 = (e & 15) * 8; float kk[8], bj[8], bl[8]; ldf8(KD + j * LP + d0, kk); ldf8(BB + j * LP + d0, bj); ldf8(BB + 63 * LP + d0, bl);
#pragma unroll
        for (int k = 0; k < 8; ++k) kk[k] *= __expf(bl[k] - bj[k]);
        st8(KD + j * LP + d0, kk); }
    if (tid < 128) ((float*)(pws() + WS_DECH))[(size_t)item * 128 + tid] = __expf(BB[63 * LP + tid]);
    __syncthreads();
    state_mm<128>(KD, VV, (bf16_t*)(pws() + WS_STH) + (size_t)item * 16384);
    __syncthreads();
}
__device__ void ssd_state_item(const Params& p, int l, int item, float* lds) {
    const int c = item & 255, h = (item >> 8) & 7, b = item >> 11, g = h >> 2; const int tid = otid();
    const bf16_t* hin = (const bf16_t*)(pws() + WS_HIN); const size_t t0 = (size_t)b * SEQ + c * 64;
    const bf16_t* xbc = (const bf16_t*)(pws() + WS_XBC);
    float* KD = lds; float* VV = lds + 64 * LP; float* AUX = lds + 2 * 64 * LP;
    if (tid < 64) { const float dtv = softplusf(bf2f(hin[(t0 + tid) * DINP + C_SDT + h]) + pin(22)[l * 8 + h]);
        AUX[tid] = dtv; AUX[64 + tid] = -dtv * __expf(pin(23)[l * 8 + h]); }
    __syncthreads();
    if (tid < 64) { float a = 0.f; for (int j = 0; j <= tid; ++j) a += AUX[64 + j]; AUX[128 + tid] = a; }
    __syncthreads();
    const float cl = AUX[128 + 63];
#pragma unroll
    for (int i = 0; i < 2; ++i) { const int e = tid + 512 * i, j = e >> 4, n0 = (e & 15) * 8; float x[8]; ld8(xbc + ((size_t)b * SEQ + c * 64 + j) * 1024 + 512 + g * 128 + n0, x); const float f = __expf(cl - AUX[128 + j]);
#pragma unroll
        for (int k = 0; k < 8; ++k) x[k] *= f;
        st8(KD + j * LP + n0, x); }
    { const int j = tid >> 3, pc0 = (tid & 7) * 8; float x[8]; ld8(xbc + ((size_t)b * SEQ + c * 64 + j) * 1024 + h * 64 + pc0, x); const float f = AUX[j];
#pragma unroll
      for (int k = 0; k < 8; ++k) x[k] *= f;
      st8(VV + j * LP + pc0, x); }
    if (tid == 0) ((float*)(pws() + WS_DECS))[item] = __expf(cl);
    __syncthreads();
    state_mm<64>(KD, VV, (bf16_t*)(pws() + WS_STS) + (size_t)item * 8192);
    __syncthreads();
}
__device__ __forceinline__ float ret_lg(int h) { return __logf(1.f - exp2f(-5.f - (float)h)); }
__device__ void ret_state_item(const Params& p, int l, int item, float* lds) {
    const int c = item & 255, h = (item >> 8) & 3, b = item >> 10; const int tid = otid();
    const bf16_t* hin = (const bf16_t*)(pws() + WS_HIN); const size_t t0 = (size_t)b * SEQ + c * 64;
    float* KD = lds; float* VV = lds + 64 * LP; float* TH = lds + 2 * 64 * LP;
    fill_theta(TH);
    __syncthreads();
    load_rotary(hin, t0, c * 64, C_RK + h * 128, 0.08838834764831845f, KD, TH);
#pragma unroll
    for (int i = 0; i < 2; ++i) { const int e = tid + 512 * i, j = e >> 4, d0 = (e & 15) * 8; float v[8]; ld8(hin + (t0 + j) * DINP + C_RV + h * 128 + d0, v); st8(VV + j * LP + d0, v); }
    __syncthreads();
    const float lg = ret_lg(h);
#pragma unroll 4
    for (int i = 0; i < 16; ++i) { const int e = tid + 512 * i, j = e >> 7, d = e & 127; KD[j * LP + d] *= __expf(lg * (float)(63 - j)); }
    __syncthreads();
    state_mm<128>(KD, VV, (bf16_t*)(pws() + WS_STR) + (size_t)item * 16384);
    __syncthreads();
}
__device__ void cmp_item(const Params& p, int l, int item, float* lds) {
    const int mb = item & 63, kv = (item >> 6) & 1, b = (item >> 7) & 1, which = item >> 8; const int tid = otid();
    const bf16_t* hin = (const bf16_t*)(pws() + WS_HIN);
    const float* pe = pin(which ? 15 : 12) + l * 2048; const float* w2 = pin(which ? 17 : 14) + l * 256 * 64;
    float* dst = (float*)(pws() + (which ? WS_VCMP : WS_KCMP)) + (size_t)(b * 2 + kv) * 1024 * 64;
    const int colx = (which ? C_NVC : C_NKC) + kv * 64;
    bf16_t* AF = (bf16_t*)lds; float* HID = lds + 16448;
    const bf16_t* w1t = (const bf16_t*)(pws() + WS_W1T) + (size_t)((l * 2 + which) * 256) * 2048;
    const int tok0 = mb * 256;
#pragma unroll 2
    for (int i = 0; i < 8; ++i) { const int e = tid + 512 * i, r = e >> 8, rem = e & 255, pos = rem >> 3, d8 = (rem & 7) * 8; const int s = tok0 + 16 * r + pos;
        float x[8], pe8[8]; ldf8(pe + pos * 64 + d8, pe8);
        if (s < SEQ) ld8(hin + ((size_t)b * SEQ + s) * DINP + colx + d8, x); else {
#pragma unroll
            for (int k = 0; k < 8; ++k) x[k] = 0.f; }
        u32x4 w; w.x = pk2(x[0] + pe8[0], x[1] + pe8[1]); w.y = pk2(x[2] + pe8[2], x[3] + pe8[3]); w.z = pk2(x[4] + pe8[4], x[5] + pe8[5]); w.w = pk2(x[6] + pe8[6], x[7] + pe8[7]);
        *(u32x4*)(AF + r * 2056 + pos * 64 + d8) = w; }
    __syncthreads();
    { const int wid = tid >> 6, lane = tid & 63, fr = lane & 15, fq = lane >> 4;
      f32x4 acc0 = (f32x4){0.f, 0.f, 0.f, 0.f}, acc1 = acc0;
      const bf16_t* bp0 = w1t + (size_t)((2 * wid) * 16 + fr) * 2048 + fq * 8; const bf16_t* bp1 = bp0 + 16 * 2048; const bf16_t* ap = AF + fr * 2056 + fq * 8;
#pragma unroll 8
      for (int ks = 0; ks < 64; ++ks) { const bf16x8 av = *(const bf16x8*)(ap + ks * 32), b0 = *(const bf16x8*)(bp0 + ks * 32), b1 = *(const bf16x8*)(bp1 + ks * 32);
          acc0 = MFMA16(av, b0, acc0); acc1 = MFMA16(av, b1, acc1); }
#pragma unroll
      for (int j = 0; j < 4; ++j) { HID[(fq * 4 + j) * 256 + (2 * wid) * 16 + fr] = siluf(acc0[j]); HID[(fq * 4 + j) * 256 + (2 * wid + 1) * 16 + fr] = siluf(acc1[j]); } }
    __syncthreads();
    { const int e = tid & 63, r0 = tid >> 6; float o0 = 0.f, o1 = 0.f;
      for (int nn = 0; nn < 256; ++nn) { const float w = w2[nn * 64 + e]; o0 += HID[r0 * 256 + nn] * w; o1 += HID[(r0 + 8) * 256 + nn] * w; }
      const int m0 = mb * 16 + r0; if (m0 < 1023) dst[(size_t)m0 * 64 + e] = o0; if (m0 + 8 < 1023) dst[(size_t)(m0 + 8) * 64 + e] = o1;
      const float z0 = m0 < 1023 ? o0 : 0.f, z1 = m0 + 8 < 1023 ? o1 : 0.f; const int m1 = m0 + 8;
      if (which == 0) { bf16_t* kb = (bf16_t*)(pws() + WS_KCB) + (size_t)(b * 2 + kv) * 1024 * 64; kb[(size_t)m0 * 64 + e] = (bf16_t)(pk2(z0, 0.f) & 0xffffu); kb[(size_t)m1 * 64 + e] = (bf16_t)(pk2(z1, 0.f) & 0xffffu); }
      else { bf16_t* vt = (bf16_t*)(pws() + WS_VCT) + (size_t)(b * 2 + kv) * 16 * 4096; vt[(size_t)(m0 >> 6) * 4096 + e * 64 + (m0 & 63)] = (bf16_t)(pk2(z0, 0.f) & 0xffffu); vt[(size_t)(m1 >> 6) * 4096 + e * 64 + (m1 & 63)] = (bf16_t)(pk2(z1, 0.f) & 0xffffu); } }
    __syncthreads();
}
__device__ void vtr_item(const Params& p, int item, float* lds) {
    const int blk = item & 255, kv = (item >> 8) & 1, b = (item >> 9) & 1, which = item >> 10; const int tid = otid();
    const bf16_t* hin = (const bf16_t*)(pws() + WS_HIN); bf16_t* T = (bf16_t*)lds;
    { const int key = tid >> 3, d8 = (tid & 7) * 8; const u32x4 w = *(const u32x4*)(hin + ((size_t)b * SEQ + blk * 64 + key) * DINP + (which ? C_NVW : C_NVS) + kv * 64 + d8);
      T[(d8 + 0) * 72 + key] = (bf16_t)(w.x & 0xffffu); T[(d8 + 1) * 72 + key] = (bf16_t)(w.x >> 16); T[(d8 + 2) * 72 + key] = (bf16_t)(w.y & 0xffffu); T[(d8 + 3) * 72 + key] = (bf16_t)(w.y >> 16);
      T[(d8 + 4) * 72 + key] = (bf16_t)(w.z & 0xffffu); T[(d8 + 5) * 72 + key] = (bf16_t)(w.z >> 16); T[(d8 + 6) * 72 + key] = (bf16_t)(w.w & 0xffffu); T[(d8 + 7) * 72 + key] = (bf16_t)(w.w >> 16); }
    if (which == 0) {
        const int key = tid >> 3, d8 = (tid & 7) * 8; const u32x4 w = *(const u32x4*)(hin + ((size_t)b * SEQ + blk * 64 + key) * DINP + C_NKS + kv * 64 + d8);
        float a = (bflo(w.x) * bflo(w.x) + bfhi(w.x) * bfhi(w.x)) + (bflo(w.y) * bflo(w.y) + bfhi(w.y) * bfhi(w.y)) + (bflo(w.z) * bflo(w.z) + bfhi(w.z) * bfhi(w.z)) + (bflo(w.w) * bflo(w.w) + bfhi(w.w) * bfhi(w.w));
        a += dppf<0xB1>(a); a += dppf<0x4E>(a); a += dppf<0x141>(a);
        a = wave_maxf(a);
        if ((tid & 63) == 0) lds[4096 + (tid >> 6)] = a;
    }
    __syncthreads();
    if (which == 0 && tid == 0) { float m = 0.f; for (int w8 = 0; w8 < 8; ++w8) m = fmaxf(m, lds[4096 + w8]); ((float*)(pws() + WS_KNORM))[(b * 2 + kv) * 256 + blk] = sqrtf(m); }
    { const int dv = tid >> 3, k8 = (tid & 7) * 8; bf16_t* dst = (bf16_t*)(pws() + (which ? WS_VWT : WS_VST)) + ((size_t)((b * 2 + kv) * 256 + blk)) * 4096;
      *(u32x4*)(dst + dv * 64 + k8) = *(const u32x4*)(T + dv * 72 + k8); }
    __syncthreads();
}
__device__ void mixer_phase_pre(const Params& p, int l, float* lds) {
    for (int it = obid(); it < 512 + 2048; it += gridDim.x) { if (it < 512) cmp_item(p, l, it, lds); else vtr_item(p, it - 512, lds); }
    conv_prepass(p, l);
}
__device__ void mixer_phase_a(const Params& p, int l, float* lds) {
    for (int it = obid() + 512; it < 8704; it += gridDim.x) {
        if (it < 512) { for (int r = 0; r < 1 + (AREP & 1); ++r) cmp_item(p, l, it, lds); }
        else if (it < 2560) { for (int r = 0; r < 1 + ((AREP >> 1) & 1); ++r) hg_state_item(p, l, it - 512, lds); }
        else if (it < 6656) { for (int r = 0; r < 1 + ((AREP >> 2) & 1); ++r) ssd_state_item(p, l, it - 2560, lds); }
        else { for (int r = 0; r < 1 + ((AREP >> 3) & 1); ++r) ret_state_item(p, l, it - 6656, lds); }
    }
}
__device__ void scan_phase(const Params& p) {
    for (int wt = obid() + (int)gridDim.x * (otid() >> 6); wt < 1536; wt += (int)gridDim.x * 8) {
        const int task = wt * 64 + (otid() & 63);
        const int br = task >> 15, r = task & 32767;
        bf16_t* base; size_t cstride; const float* decp = nullptr; int dstride = 0; float dconst = 0.f;
        if (br == 0) { const int bh = r >> 12, e4 = r & 4095; base = (bf16_t*)(pws() + WS_STH) + (size_t)bh * 256 * 16384 + e4 * 4; cstride = 16384;
            decp = (const float*)(pws() + WS_DECH) + (size_t)bh * 256 * 128 + ((e4 * 4) >> 7); dstride = 128; }
        else if (br == 1) { const int bh = r >> 11, e4 = r & 2047; base = (bf16_t*)(pws() + WS_STS) + (size_t)bh * 256 * 8192 + e4 * 4; cstride = 8192;
            decp = (const float*)(pws() + WS_DECS) + (size_t)bh * 256; dstride = 1; }
        else { const int bh = r >> 12, e4 = r & 4095; base = (bf16_t*)(pws() + WS_STR) + (size_t)bh * 256 * 16384 + e4 * 4; cstride = 16384; dconst = __expf(64.f * ret_lg(bh & 3)); }
        float s0 = 0.f, s1 = 0.f, s2 = 0.f, s3 = 0.f;
#pragma unroll 8
        for (int c = 0; c < 256; ++c) {
            u32x2* ptr = (u32x2*)(base + (size_t)c * cstride); const u32x2 w = *ptr; const float dec = decp ? decp[(size_t)c * dstride] : dconst;
            u32x2 o; o.x = pk2(s0, s1); o.y = pk2(s2, s3); *ptr = o;
            s0 = dec * s0 + bflo(w.x); s1 = dec * s1 + bfhi(w.x); s2 = dec * s2 + bflo(w.y); s3 = dec * s3 + bfhi(w.y);
        }
    }
}
constexpr int AP = 68;
__device__ __forceinline__ void scores_plain(const float* QS, const float* KS, float (&acc)[2][4]) {
    const int tid = otid(), ti = tid >> 4, tj = tid & 15;
#pragma unroll
    for (int a = 0; a < 2; ++a)
#pragma unroll
        for (int jj = 0; jj < 4; ++jj) acc[a][jj] = 0.f;
    for (int d = 0; d < 128; d += 4) {
        f32x4 q[2], k[4];
#pragma unroll
        for (int a = 0; a < 2; ++a) q[a] = *(const f32x4*)(QS + (ti + 32 * a) * LP + d);
#pragma unroll
        for (int jj = 0; jj < 4; ++jj) k[jj] = *(const f32x4*)(KS + (tj + 16 * jj) * LP + d);
#pragma unroll
        for (int a = 0; a < 2; ++a)
#pragma unroll
            for (int jj = 0; jj < 4; ++jj) { if (a == 0 && jj >= 2) continue;
                acc[a][jj] += (q[a][0] * k[jj][0] + q[a][1] * k[jj][1]) + (q[a][2] * k[jj][2] + q[a][3] * k[jj][3]); }
    }
}
__device__ __forceinline__ void scores_hg(const float* QS, const float* KS, const float* BB, float (&acc)[2][4]) {
    const int tid = otid(), ti = tid >> 4, tj = tid & 15;
#pragma unroll
    for (int a = 0; a < 2; ++a)
#pragma unroll
        for (int jj = 0; jj < 4; ++jj) acc[a][jj] = 0.f;
    for (int d = 0; d < 128; d += 4) {
        f32x4 q[2], bi[2], k[4], bj[4];
#pragma unroll
        for (int a = 0; a < 2; ++a) { q[a] = *(const f32x4*)(QS + (ti + 32 * a) * LP + d); bi[a] = *(const f32x4*)(BB + (ti + 32 * a) * LP + d); }
#pragma unroll
        for (int jj = 0; jj < 4; ++jj) { k[jj] = *(const f32x4*)(KS + (tj + 16 * jj) * LP + d); bj[jj] = *(const f32x4*)(BB + (tj + 16 * jj) * LP + d); }
#pragma unroll
        for (int a = 0; a < 2; ++a)
#pragma unroll
            for (int jj = 0; jj < 4; ++jj) { if (a == 0 && jj >= 2) continue;
#pragma unroll
                for (int x = 0; x < 4; ++x) acc[a][jj] += q[a][x] * k[jj][x] * __expf(fminf(bi[a][x] - bj[jj][x], 0.f)); }
    }
}
template <int DV> __device__ __forceinline__ void load_sprev(const bf16_t* src, float* SP) {
    const int tid = otid();
    for (int e = tid; e < 128 * DV / 4; e += 512) { const int d = e / (DV / 4), v4 = e % (DV / 4); const u32x2 w = *(const u32x2*)(src + (size_t)d * DV + v4 * 4);
        *(f32x4*)(SP + d * (DV + 4) + v4 * 4) = (f32x4){bflo(w.x), bfhi(w.x), bflo(w.y), bfhi(w.y)}; }
}
template <int DV, bool VBF> __device__ __forceinline__ void out_mm(const float* AA, const void* VVp, const float* QS, const float* SP, f32x4 (&intra)[2][DV / 64], f32x4 (&inter)[2][DV / 64]) {
    const int tid = otid(), ti = tid >> 4, tv = tid & 15; constexpr int NV = DV / 64;
#pragma unroll
    for (int a = 0; a < 2; ++a)
#pragma unroll
        for (int n = 0; n < NV; ++n) { intra[a][n] = (f32x4){0.f, 0.f, 0.f, 0.f}; inter[a][n] = (f32x4){0.f, 0.f, 0.f, 0.f}; }
    for (int j = 0; j < 64; j += 4) {
        f32x4 a4[2];
#pragma unroll
        for (int a = 0; a < 2; ++a) a4[a] = *(const f32x4*)(AA + (ti + 32 * a) * AP + j);
#pragma unroll
        for (int x = 0; x < 4; ++x)
#pragma unroll
            for (int n = 0; n < NV; ++n) { f32x4 v;
                if (VBF) { const u32x2 w = *(const u32x2*)((const bf16_t*)VVp + (j + x) * 136 + n * 64 + tv * 4); v = (f32x4){bflo(w.x), bfhi(w.x), bflo(w.y), bfhi(w.y)}; }
                else v = *(const f32x4*)((const float*)VVp + (j + x) * AP + n * 64 + tv * 4);
#pragma unroll
                for (int a = 0; a < 2; ++a) intra[a][n] += v * a4[a][x]; }
    }
    for (int d = 0; d < 128; d += 4) {
        f32x4 q4[2];
#pragma unroll
        for (int a = 0; a < 2; ++a) q4[a] = *(const f32x4*)(QS + (ti + 32 * a) * LP + d);
#pragma unroll
        for (int x = 0; x < 4; ++x)
#pragma unroll
            for (int n = 0; n < NV; ++n) { const f32x4 s = *(const f32x4*)(SP + (d + x) * (DV + 4) + n * 64 + tv * 4);
#pragma unroll
                for (int a = 0; a < 2; ++a) inter[a][n] += s * q4[a][x]; }
    }
}
__device__ __forceinline__ float red16(float v) { v += dppf<0xB1>(v); v += dppf<0x4E>(v); v += dppf<0x141>(v); v += dppf<0x140>(v); return v; }
__device__ __forceinline__ float max16(float v) { v = fmaxf(v, dppf<0xB1>(v)); v = fmaxf(v, dppf<0x4E>(v)); v = fmaxf(v, dppf<0x141>(v)); v = fmaxf(v, dppf<0x140>(v)); return v; }

__device__ void hg_out_item(const Params& p, int l, int item, float* lds) {
    const int c = item & 255, h = (item >> 8) & 3, b = item >> 10; const int tid = otid(), ti = tid >> 4, tj = tid & 15;
    const bf16_t* hin = (const bf16_t*)(pws() + WS_HIN); const size_t t0 = (size_t)b * SEQ + c * 64;
    float* QS = lds; float* KS = lds + 64 * LP; float* BB = lds + 2 * 64 * LP; float* AA = lds + 3 * 64 * LP; bf16_t* VV = (bf16_t*)(lds + 3 * 64 * LP + 64 * AP); float* SP = KS; const float* lbl = pin(10);
#pragma unroll
    for (int i = 0; i < 2; ++i) { const int e = tid + 512 * i, j = e >> 4, d0 = (e & 15) * 8;
        float z[8], q[8], lb[8], bb[8], kk[8]; ld8(hin + (t0 + j) * DINP + C_HF + h * 128 + d0, z); ld8(hin + (t0 + j) * DINP + C_HQ + h * 128 + d0, q); hg_lb8(lbl, l, h * 128 + d0, lb);
#pragma unroll
        for (int k = 0; k < 8; ++k) { const float sn = __builtin_amdgcn_rcpf(1.f + __expf(z[k])), sg = 1.f - sn; bb[k] = __logf(lb[k] + (1.f - lb[k]) * sg); kk[k] = (1.f - lb[k]) * sn; q[k] = siluf(q[k]); }
        st8(BB + j * LP + d0, bb); st8(KS + j * LP + d0, kk); st8(QS + j * LP + d0, q);
        *(u32x4*)(VV + j * 136 + d0) = *(const u32x4*)(hin + (t0 + j) * DINP + C_HI + h * 128 + d0); }
    __syncthreads();
    if (tid < 128) { float a = 0.f; for (int j = 0; j < 64; ++j) { a += BB[j * LP + tid]; BB[j * LP + tid] = a; } }
    __syncthreads();
    { float acc[2][4]; scores_hg(QS, KS, BB, acc);
#pragma unroll
      for (int a = 0; a < 2; ++a)
#pragma unroll
          for (int jj = 0; jj < 4; ++jj) { const int i = ti + 32 * a, j = tj + 16 * jj; AA[i * AP + j] = (j <= i) ? acc[a][jj] : 0.f; } }
    __syncthreads();
#pragma unroll 4
    for (int i = 0; i < 16; ++i) { const int e = tid + 512 * i, j = e >> 7, d = e & 127; QS[j * LP + d] *= __expf(BB[j * LP + d]); }
    __syncthreads();
    load_sprev<128>((const bf16_t*)(pws() + WS_STH) + (size_t)item * 16384, SP);
    __syncthreads();
    f32x4 intra[2][2], inter[2][2]; out_mm<128, true>(AA, VV, QS, SP, intra, inter);
    const int tv = tj; const float* ng = pin(11) + l * 512 + h * 128; bf16_t* mixed = (bf16_t*)(pws() + WS_XB);
#pragma unroll
    for (int a = 0; a < 2; ++a) { const int i = ti + 32 * a; f32x4 o[2]; float ss = 0.f;
#pragma unroll
        for (int n = 0; n < 2; ++n) { o[n] = intra[a][n] + inter[a][n]; ss += (o[n][0] * o[n][0] + o[n][1] * o[n][1]) + (o[n][2] * o[n][2] + o[n][3] * o[n][3]); }
        ss = red16(ss); const float r = rsqrtf(ss * (1.f / 128.f) + 1e-6f);
#pragma unroll
        for (int n = 0; n < 2; ++n) { const int v = n * 64 + tv * 4; const u32x2 gw = *(const u32x2*)(hin + (t0 + i) * DINP + C_HG + h * 128 + v); const f32x4 g4 = *(const f32x4*)(ng + v);
            const float r0 = o[n][0] * r * g4[0] * siluf(bflo(gw.x)), r1 = o[n][1] * r * g4[1] * siluf(bfhi(gw.x)), r2 = o[n][2] * r * g4[2] * siluf(bflo(gw.y)), r3 = o[n][3] * r * g4[3] * siluf(bfhi(gw.y));
            u32x2 w; w.x = pk2(r0, r1); w.y = pk2(r2, r3); *(u32x2*)(mixed + (t0 + i) * DM + h * 128 + v) = w; } }
    __syncthreads();
}
__device__ void ret_out_item(const Params& p, int l, int item, float* lds) {
    const int c = item & 255, h = (item >> 8) & 3, b = item >> 10; const int tid = otid(), ti = tid >> 4, tj = tid & 15;
    const bf16_t* hin = (const bf16_t*)(pws() + WS_HIN); const size_t t0 = (size_t)b * SEQ + c * 64;
    float* QS = lds; float* KS = lds + 64 * LP; float* AA = lds + 3 * 64 * LP; bf16_t* VV = (bf16_t*)(lds + 3 * 64 * LP + 64 * AP); float* SP = KS; float* TH = lds + 3 * 64 * LP + 64 * AP + 64 * AP;
    fill_theta(TH);
    __syncthreads();
    load_rotary(hin, t0, c * 64, C_RQ + h * 128, 1.0f, QS, TH);
    load_rotary(hin, t0, c * 64, C_RK + h * 128, 0.08838834764831845f, KS, TH);
#pragma unroll
    for (int i = 0; i < 2; ++i) { const int e = tid + 512 * i, j = e >> 4, d0 = (e & 15) * 8; *(u32x4*)(VV + j * 136 + d0) = *(const u32x4*)(hin + (t0 + j) * DINP + C_RV + h * 128 + d0); }
    __syncthreads();
    const float lg = ret_lg(h);
    { float acc[2][4]; scores_plain(QS, KS, acc);
#pragma unroll
      for (int a = 0; a < 2; ++a)
#pragma unroll
          for (int jj = 0; jj < 4; ++jj) { const int i = ti + 32 * a, j = tj + 16 * jj; AA[i * AP + j] = (j <= i) ? acc[a][jj] * __expf(lg * (float)(i - j)) : 0.f; } }
    __syncthreads();
    load_sprev<128>((const bf16_t*)(pws() + WS_STR) + (size_t)item * 16384, SP);
    __syncthreads();
    f32x4 intra[2][2], inter[2][2]; out_mm<128, true>(AA, VV, QS, SP, intra, inter);
    const int tv = tj; bf16_t* mixed = (bf16_t*)(pws() + WS_XB);
#pragma unroll
    for (int a = 0; a < 2; ++a) { const int i = ti + 32 * a; const float sc = __expf(lg * (float)(i + 1)); f32x4 o[2]; float s = 0.f;
#pragma unroll
        for (int n = 0; n < 2; ++n) { o[n] = intra[a][n] + inter[a][n] * sc; s += (o[n][0] + o[n][1]) + (o[n][2] + o[n][3]); }
        s = red16(s); const float mu = s * (1.f / 128.f); float q = 0.f;
#pragma unroll
        for (int n = 0; n < 2; ++n) { const f32x4 d = o[n] - mu; q += (d[0] * d[0] + d[1] * d[1]) + (d[2] * d[2] + d[3] * d[3]); }
        q = red16(q); const float r = rsqrtf(q * (1.f / 128.f) + 1e-5f);
#pragma unroll
        for (int n = 0; n < 2; ++n) { const int v = n * 64 + tv * 4; const u32x2 gw = *(const u32x2*)(hin + (t0 + i) * DINP + C_RG + h * 128 + v);
            const float r0 = (o[n][0] - mu) * r * siluf(bflo(gw.x)), r1 = (o[n][1] - mu) * r * siluf(bfhi(gw.x)), r2 = (o[n][2] - mu) * r * siluf(bflo(gw.y)), r3 = (o[n][3] - mu) * r * siluf(bfhi(gw.y));
            u32x2 w; w.x = pk2(r0, r1); w.y = pk2(r2, r3); *(u32x2*)(mixed + (t0 + i) * DM + 1536 + h * 128 + v) = w; } }
    __syncthreads();
}
__device__ void ssd_out_item(const Params& p, int l, int item, float* lds) {
    const int c = item & 255, g = (item >> 8) & 1, b = item >> 9; const int tid = otid(), ti = tid >> 4, tj = tid & 15, tv = tj;
    const bf16_t* hin = (const bf16_t*)(pws() + WS_HIN); const size_t t0 = (size_t)b * SEQ + c * 64;
    const bf16_t* xbc = (const bf16_t*)(pws() + WS_XBC);
    float* CM = lds; float* BM = lds + 8448; float* SP = BM; float* G = lds + 17152; float* AH = lds + 21504; float* VV = lds + 25856; float* XS = lds + 30208; float* AUX = lds + 34560;
    if (tid < 256) { const int hh = tid >> 6, j = tid & 63, h = g * 4 + hh; const float dtv = softplusf(bf2f(hin[(t0 + j) * DINP + C_SDT + h]) + pin(22)[l * 8 + h]);
        AUX[hh * 64 + j] = dtv; AUX[512 + hh * 64 + j] = -dtv * __expf(pin(23)[l * 8 + h]); }
#pragma unroll
    for (int i = 0; i < 2; ++i) { const int e = tid + 512 * i, j = e >> 4, n0 = (e & 15) * 8; float x[8];
        ld8(xbc + ((size_t)b * SEQ + c * 64 + j) * 1024 + 768 + g * 128 + n0, x); st8(CM + j * LP + n0, x);
        ld8(xbc + ((size_t)b * SEQ + c * 64 + j) * 1024 + 512 + g * 128 + n0, x); st8(BM + j * LP + n0, x); }
    __syncthreads();
    if (tid < 256) { const int hh = tid >> 6, j = tid & 63; float a = 0.f; for (int jj = 0; jj <= j; ++jj) a += AUX[512 + hh * 64 + jj]; AUX[256 + hh * 64 + j] = a; }
    { float acc[2][4]; scores_plain(CM, BM, acc);
#pragma unroll
      for (int a = 0; a < 2; ++a)
#pragma unroll
          for (int jj = 0; jj < 4; ++jj) G[(ti + 32 * a) * AP + tj + 16 * jj] = acc[a][jj]; }
    __syncthreads();
    float ss[2] = {0.f, 0.f}; bf16_t* mixed = (bf16_t*)(pws() + WS_XB);
#pragma unroll 1
    for (int hh = 0; hh < 4; ++hh) {
        const int h = g * 4 + hh; const float* dt = AUX + hh * 64; const float* cb = AUX + 256 + hh * 64;
#pragma unroll 2
        for (int i = 0; i < 8; ++i) { const int e = tid + 512 * i, ii = e >> 6, j = e & 63; AH[ii * AP + j] = (j <= ii) ? G[ii * AP + j] * __expf(cb[ii] - cb[j]) : 0.f; }
        { const int j = tid >> 3, pc0 = (tid & 7) * 8; float x[8]; ld8(xbc + ((size_t)b * SEQ + c * 64 + j) * 1024 + h * 64 + pc0, x); st8(XS + j * AP + pc0, x); const float f = dt[j];
#pragma unroll
          for (int k = 0; k < 8; ++k) x[k] *= f;
          st8(VV + j * AP + pc0, x); }
        load_sprev<64>((const bf16_t*)(pws() + WS_STS) + (size_t)(((b * 8 + h) << 8) + c) * 8192, SP);
        __syncthreads();
        f32x4 intra[2][1], inter[2][1]; out_mm<64, false>(AH, VV, CM, SP, intra, inter);
        const float dsk = pin(24)[l * 8 + h];
#pragma unroll
        for (int a = 0; a < 2; ++a) { const int i = ti + 32 * a; const f32x4 xs = *(const f32x4*)(XS + i * AP + tv * 4); const u32x2 zw = *(const u32x2*)(hin + (t0 + i) * DINP + C_SZ + h * 64 + tv * 4);
            f32x4 o = intra[a][0] + inter[a][0] * __expf(cb[i]) + xs * dsk;
            o[0] *= siluf(bflo(zw.x)); o[1] *= siluf(bfhi(zw.x)); o[2] *= siluf(bflo(zw.y)); o[3] *= siluf(bfhi(zw.y));
            ss[a] += (o[0] * o[0] + o[1] * o[1]) + (o[2] * o[2] + o[3] * o[3]);
            u32x2 w; w.x = pk2(o[0], o[1]); w.y = pk2(o[2], o[3]); *(u32x2*)(mixed + (t0 + i) * DM + 1024 + g * 256 + hh * 64 + tv * 4) = w; }
        __syncthreads();
    }
    const float* ng = pin(25) + l * 512 + g * 256;
#pragma unroll
    for (int a = 0; a < 2; ++a) { const int i = ti + 32 * a; const float r = rsqrtf(red16(ss[a]) * (1.f / 256.f) + 1e-6f);
#pragma unroll 1
        for (int hh = 0; hh < 4; ++hh) { const f32x4 g4 = *(const f32x4*)(ng + hh * 64 + tv * 4); u32x2* ptr = (u32x2*)(mixed + (t0 + i) * DM + 1024 + g * 256 + hh * 64 + tv * 4); const u32x2 yw = *ptr;
            const f32x4 o = (f32x4){bflo(yw.x), bfhi(yw.x), bflo(yw.y), bfhi(yw.y)} * r * g4;
            u32x2 w; w.x = pk2(o[0], o[1]); w.y = pk2(o[2], o[3]); *ptr = w; } }
    __syncthreads();
}
#ifndef WREP
#define WREP 1
#endif
#ifndef TREP
#define TREP 1
#endif
#ifndef SREP
#define SREP 1
#endif
__device__ __forceinline__ int t5_bucket(int dist) {
    if (dist < 16) return dist;
    const int lg = 16 + (int)(__log2f((float)dist * 0.0625f) * 2.2857142857142856f);
    return lg < 31 ? lg : 31;
}
__device__ __forceinline__ float dot64_bf(const float (&q)[64], const bf16_t* kp) {
    float s0 = 0.f, s1 = 0.f;
#pragma unroll
    for (int i = 0; i < 8; ++i) { const u32x4 w = *(const u32x4*)(kp + i * 8);
        s0 += (q[8 * i + 0] * bflo(w.x) + q[8 * i + 2] * bflo(w.y)) + (q[8 * i + 4] * bflo(w.z) + q[8 * i + 6] * bflo(w.w));
        s1 += (q[8 * i + 1] * bfhi(w.x) + q[8 * i + 3] * bfhi(w.y)) + (q[8 * i + 5] * bfhi(w.z) + q[8 * i + 7] * bfhi(w.w)); }
    return s0 + s1;
}
__device__ __forceinline__ float dot64_f(const float (&q)[64], const float* kp) {
    float s0 = 0.f, s1 = 0.f;
#pragma unroll
    for (int i = 0; i < 16; ++i) { const f32x4 w = *(const f32x4*)(kp + i * 4); s0 += q[4 * i] * w[0] + q[4 * i + 2] * w[2]; s1 += q[4 * i + 1] * w[1] + q[4 * i + 3] * w[3]; }
    return s0 + s1;
}
__device__ __forceinline__ float softmax_row(float* scr, int ks, int n, float mx_local) {
    const float mx = max16(mx_local); float sum = 0.f;
    for (int idx = ks; idx < n; idx += 16) { const float e = __expf(scr[idx] - mx); scr[idx] = e; sum += e; }
    sum = red16(sum);
    return n > 0 ? 1.f / sum : 0.f;
}
constexpr float NEG_BIG = -1.0e30f;
__device__ __forceinline__ bf16_t f2bf(float x) { return (bf16_t)(pk2(x, 0.f) & 0xffffu); }
__device__ __forceinline__ void ld_k(const bf16_t* kbase, int kpitch, int fr, int fq, bf16x8 (&kb)[4][2]) {
#pragma unroll
    for (int nt = 0; nt < 4; ++nt)
#pragma unroll
        for (int ks = 0; ks < 2; ++ks) kb[nt][ks] = *(const bf16x8*)(kbase + (nt * 16 + fr) * kpitch + ks * 32 + fq * 8);
}
__device__ __forceinline__ void ld_v(const bf16_t* vt, int fr, int fq, bf16x8 (&vb)[4][2]) {
#pragma unroll
    for (int nt = 0; nt < 4; ++nt)
#pragma unroll
        for (int ks = 0; ks < 2; ++ks) vb[nt][ks] = *(const bf16x8*)(vt + (nt * 16 + fr) * 64 + ks * 32 + fq * 8);
}
__device__ __forceinline__ void mma_qk(const bf16x8 (&qa)[2][2], const bf16x8 (&kb)[4][2], f32x4 (&s)[2][4]) {
#pragma unroll
    for (int mt = 0; mt < 2; ++mt)
#pragma unroll
        for (int nt = 0; nt < 4; ++nt) { f32x4 c = (f32x4){0.f, 0.f, 0.f, 0.f};
#pragma unroll
            for (int ks = 0; ks < 2; ++ks) c = MFMA16(qa[mt][ks], kb[nt][ks], c);
            s[mt][nt] = c; }
}
__device__ __forceinline__ void mma_pv(const bf16_t* Pl, const bf16x8 (&vb)[4][2], int fr, int fq, f32x4 (&o)[2][4]) {
    bf16x8 pa[2][2];
#pragma unroll
    for (int mt = 0; mt < 2; ++mt)
#pragma unroll
        for (int ks = 0; ks < 2; ++ks) pa[mt][ks] = *(const bf16x8*)(Pl + (mt * 16 + fr) * 72 + ks * 32 + fq * 8);
#pragma unroll
    for (int nt = 0; nt < 4; ++nt)
#pragma unroll
        for (int ks = 0; ks < 2; ++ks)
#pragma unroll
            for (int mt = 0; mt < 2; ++mt) o[mt][nt] = MFMA16(pa[mt][ks], vb[nt][ks], o[mt][nt]);
}
__device__ void nsa_unit(const Params& p, int l, int item, float* ldsf) {
    int b = item >> 8, qt = item & 255; if (b) qt = 255 - qt;
    const int tid = otid(), wid = tid >> 6, lane = tid & 63, fr = lane & 15, fq = lane >> 4;
    unsigned char* wb = (unsigned char*)ldsf + wid * 16384;
    bf16_t* Pl = (bf16_t*)wb; float* IMP = (float*)(wb + 4608); float* OSEL = IMP; float* PS = (float*)(wb + 12928); int* SEL = (int*)(wb + 15104); int* NSEL = (int*)(wb + 15616);
    float* RB = ldsf + 32768; float* LSUM = ldsf + 33024; float* BND = ldsf + 33280; unsigned long long* QM = (unsigned long long*)(ldsf + 33536); const unsigned char* BK = (const unsigned char*)(ldsf + 34048);
    if (tid < 256) RB[tid] = pin(19)[tid];
    { unsigned char* BKw = (unsigned char*)(ldsf + 34048);
#pragma unroll
      for (int k = 0; k < 4; ++k) BKw[tid * 4 + k] = (unsigned char)t5_bucket(tid * 4 + k); }
    __syncthreads();
    const bf16_t* hin = (const bf16_t*)(pws() + WS_HIN); bf16_t* mixed = (bf16_t*)(pws() + WS_XB);
    const int q0 = qt * 64 + wid * 8; const int tb = b * SEQ;
    float ss[2] = {0.f, 0.f};
#pragma unroll 1
    for (int kv = 0; kv < 2; ++kv) {
        if (tid < 256) QM[tid] = (unsigned long long)(unsigned)(tid >> 20);
        bf16x8 qa[2][2];
#pragma unroll
        for (int mt = 0; mt < 2; ++mt)
#pragma unroll
            for (int ks = 0; ks < 2; ++ks) qa[mt][ks] = *(const bf16x8*)(hin + (tb + q0 + mt * 4 + (fr >> 2)) * DINP + C_NQ + (kv * 4 + (fr & 3)) * 64 + ks * 32 + fq * 8);
        f32x4 ofin[2][4];
        {
            f32x4 (&o)[2][4] = ofin; float m[2][4], ls[2][4];
#pragma unroll
            for (int mt = 0; mt < 2; ++mt) {
#pragma unroll
                for (int nt = 0; nt < 4; ++nt) o[mt][nt] = (f32x4){0.f, 0.f, 0.f, 0.f};
#pragma unroll
                for (int j = 0; j < 4; ++j) { m[mt][j] = NEG_BIG; ls[mt][j] = 0.f; } }
            bf16x8 kb[4][2]; ld_k(hin + (tb + (qt >= 8 ? qt - 8 : 0) * 64) * DINP + C_NKW + kv * 64, DINP, fr, fq, kb);
#pragma unroll 1
            for (int kt = (qt >= 8 ? qt - 8 : 0); kt <= qt; ++kt) {
                bf16x8 vb[4][2]; ld_v((const bf16_t*)(pws() + WS_VWT) + ((size_t)((b * 2 + kv) * 256 + kt)) * 4096, fr, fq, vb);
                f32x4 s[2][4]; mma_qk(qa, kb, s);
#pragma unroll
                for (int mt = 0; mt < 2; ++mt) {
                    const int qpos = q0 + mt * 4 + fq; bool ok[4]; float tmax[4] = {NEG_BIG, NEG_BIG, NEG_BIG, NEG_BIG};
#pragma unroll
                    for (int nt = 0; nt < 4; ++nt) { const int dist = qpos - (kt * 64 + nt * 16 + fr); ok[nt] = dist >= 0 && dist < 512;
                        const f32x4 bias = *(const f32x4*)(RB + (int)BK[dist < 0 ? 0 : (dist > 2047 ? 2047 : dist)] * 8 + kv * 4);
#pragma unroll
                        for (int j = 0; j < 4; ++j) { const float v = ok[nt] ? s[mt][nt][j] * 0.125f + bias[j] : NEG_BIG; s[mt][nt][j] = v; tmax[j] = fmaxf(tmax[j], v); } }
#pragma unroll
                    for (int j = 0; j < 4; ++j) { const float mn = fmaxf(m[mt][j], max16(tmax[j])); const float alpha = __expf(m[mt][j] - mn); m[mt][j] = mn; float rs = 0.f;
#pragma unroll
                        for (int nt = 0; nt < 4; ++nt) { const float pe = ok[nt] ? __expf(s[mt][nt][j] - mn) : 0.f; rs += pe; Pl[(mt * 16 + fq * 4 + j) * 72 + nt * 16 + fr] = f2bf(pe); o[mt][nt][j] *= alpha; }
                        ls[mt][j] = ls[mt][j] * alpha + red16(rs); }
                }
                __builtin_amdgcn_wave_barrier();
                if (kt < qt) ld_k(hin + (tb + (kt + 1) * 64) * DINP + C_NKW + kv * 64, DINP, fr, fq, kb);
                mma_pv(Pl, vb, fr, fq, o);
                __builtin_amdgcn_wave_barrier();
            }
#pragma unroll
            for (int mt = 0; mt < 2; ++mt)
#pragma unroll
                for (int j = 0; j < 4; ++j) { const float g2 = sigmf(bf2f(hin[(tb + q0 + mt * 4 + fq) * DINP + C_NGATE + (kv * 4 + j) * 3 + 2])); const float sc = ls[mt][j] > 0.f ? g2 / ls[mt][j] : 0.f;
#pragma unroll
                    for (int nt = 0; nt < 4; ++nt) ofin[mt][nt][j] *= sc; }
        }
        {
            const int nct = (4 * qt + 3 + 63) >> 6;
            const bf16_t* kc = (const bf16_t*)(pws() + WS_KCB) + (size_t)(b * 2 + kv) * 1024 * 64; const bf16_t* vct = (const bf16_t*)(pws() + WS_VCT) + (size_t)(b * 2 + kv) * 16 * 4096;
            float m[2][4], ls[2][4];
#pragma unroll
            for (int mt = 0; mt < 2; ++mt)
#pragma unroll
                for (int j = 0; j < 4; ++j) { m[mt][j] = NEG_BIG; ls[mt][j] = 0.f; }
            for (int e = lane; e < 8 * 260; e += 64) IMP[e] = 0.f;
            bf16x8 kb[4][2]; ld_k(kc, 64, fr, fq, kb);
#pragma unroll 1
            for (int ct = 0; ct < nct; ++ct) {
                f32x4 s[2][4]; mma_qk(qa, kb, s);
                ld_k(kc + (size_t)(ct + 1 < nct ? ct + 1 : 0) * 64 * 64, 64, fr, fq, kb);
#pragma unroll
                for (int mt = 0; mt < 2; ++mt) {
                    const int qpos = q0 + mt * 4 + fq; bool ok[4]; float tmax[4] = {NEG_BIG, NEG_BIG, NEG_BIG, NEG_BIG};
#pragma unroll
                    for (int nt = 0; nt < 4; ++nt) { const int dist = qpos - (16 * (ct * 64 + nt * 16 + fr) + 31); ok[nt] = dist >= 0;
                        const f32x4 bias = *(const f32x4*)(RB + (int)BK[dist < 0 ? 0 : (dist > 2047 ? 2047 : dist)] * 8 + kv * 4);
#pragma unroll
                        for (int j = 0; j < 4; ++j) { const float v = ok[nt] ? s[mt][nt][j] * 0.125f + bias[j] : NEG_BIG; s[mt][nt][j] = v; tmax[j] = fmaxf(tmax[j], v); } }
#pragma unroll
                    for (int j = 0; j < 4; ++j) { const float mn = fmaxf(m[mt][j], max16(tmax[j])); const float alpha = __expf(m[mt][j] - mn); m[mt][j] = mn; float rs = 0.f;
#pragma unroll
                        for (int nt = 0; nt < 4; ++nt) rs += ok[nt] ? __expf(s[mt][nt][j] - mn) : 0.f;
                        ls[mt][j] = ls[mt][j] * alpha + red16(rs); }
                }
            }
            float inv[2][4];
#pragma unroll
            for (int mt = 0; mt < 2; ++mt)
#pragma unroll
                for (int j = 0; j < 4; ++j) inv[mt][j] = ls[mt][j] > 0.f ? 1.f / ls[mt][j] : 0.f;
            float g0[2][4];
#pragma unroll
            for (int mt = 0; mt < 2; ++mt)
#pragma unroll
                for (int j = 0; j < 4; ++j) g0[mt][j] = sigmf(bf2f(hin[(tb + q0 + mt * 4 + fq) * DINP + C_NGATE + (kv * 4 + j) * 3 + 0]));
            __builtin_amdgcn_wave_barrier();
#pragma unroll 1
            for (int ct = 0; ct < nct; ++ct) {
                bf16x8 vb[4][2]; ld_v(vct + (size_t)ct * 4096, fr, fq, vb);
                f32x4 s[2][4]; mma_qk(qa, kb, s);
#pragma unroll
                for (int mt = 0; mt < 2; ++mt) {
                    const int qpos = q0 + mt * 4 + fq;
#pragma unroll
                    for (int nt = 0; nt < 4; ++nt) { const int dist = qpos - (16 * (ct * 64 + nt * 16 + fr) + 31); const bool ok = dist >= 0;
                        const f32x4 bias = *(const f32x4*)(RB + (int)BK[dist < 0 ? 0 : (dist > 2047 ? 2047 : dist)] * 8 + kv * 4); float psum = 0.f;
#pragma unroll
                        for (int j = 0; j < 4; ++j) { const float pe = ok ? __expf(s[mt][nt][j] * 0.125f + bias[j] - m[mt][j]) * inv[mt][j] : 0.f; psum += pe; Pl[(mt * 16 + fq * 4 + j) * 72 + nt * 16 + fr] = f2bf(pe * g0[mt][j]); }
                        PS[(mt * 4 + fq) * 68 + nt * 16 + fr] = psum; }
                }
                __builtin_amdgcn_wave_barrier();
                { const int qi = lane >> 3, l8 = lane & 7; const float* pr = PS + qi * 68; float* ir = IMP + qi * 260 + ct * 16;
#pragma unroll
                  for (int x = 0; x < 2; ++x) { const int jb = l8 + 8 * x; const f32x4 v = *(const f32x4*)(pr + 4 * jb); float a = (v[0] + v[1]) + (v[2] + 0.5f * v[3]); if (jb > 0) a += 0.5f * pr[4 * jb - 1]; ir[jb] += a; }
                  if (l8 == 0) ir[16] += 0.5f * pr[63]; }
                if (ct + 1 < nct) ld_k(kc + (size_t)(ct + 1) * 64 * 64, 64, fr, fq, kb);
                mma_pv(Pl, vb, fr, fq, ofin);
                __builtin_amdgcn_wave_barrier();
            }
        }
        __syncthreads();
        float* QN = PS;
        {
            if (lane < 32) { const bf16_t* qp = hin + (tb + q0 + (lane >> 2)) * DINP + C_NQ + (kv * 4 + (lane & 3)) * 64; float a = 0.f;
#pragma unroll
                for (int i = 0; i < 8; ++i) { const u32x4 w = *(const u32x4*)(qp + i * 8);
                    a += (bflo(w.x) * bflo(w.x) + bfhi(w.x) * bfhi(w.x)) + (bflo(w.y) * bflo(w.y) + bfhi(w.y) * bfhi(w.y)) + (bflo(w.z) * bflo(w.z) + bfhi(w.z) * bfhi(w.z)) + (bflo(w.w) * bflo(w.w) + bfhi(w.w) * bfhi(w.w)); }
                QN[lane] = sqrtf(a); }
            if (lane < 4) { float bm = 0.f; for (int bk = 0; bk < 32; ++bk) bm = fmaxf(bm, fabsf(RB[bk * 8 + kv * 4 + lane])); QN[32 + lane] = bm; }
        }
        __builtin_amdgcn_wave_barrier();
        const float* KN = (const float*)(pws() + WS_KNORM) + (b * 2 + kv) * 256;
#pragma unroll 1
        for (int qi = 0; qi < 8; ++qi) {
            const int qpos = q0 + qi, cur = qpos >> 6; unsigned long long key[4];
#pragma unroll
            for (int jj = 0; jj < 4; ++jj) { const int j = lane + 64 * jj; unsigned long long kk = 0ull;
                if (j <= cur) { const float val = (j == 0 || j == cur || j == cur - 1) ? 5.0f : IMP[qi * 260 + j]; kk = ((unsigned long long)(__float_as_uint(val) + 1u) << 32) | (unsigned)(255 - j); }
                key[jj] = kk; }
            float knmax = 0.f;
            for (int it = 0; it < 16; ++it) {
                unsigned long long best = key[0] > key[1] ? key[0] : key[1]; { const unsigned long long b2 = key[2] > key[3] ? key[2] : key[3]; best = b2 > best ? b2 : best; }
                best = wave_max_u64(best);
                if ((best >> 32) == 0ull) break;
                const int jsel = 255 - (int)(unsigned)(best & 0xffffffffull);
                if (lane == it) { lds_or64(QM + jsel, 1ull << (wid * 8 + qi)); knmax = KN[jsel]; }
#pragma unroll
                for (int jj = 0; jj < 4; ++jj) if (key[jj] == best) key[jj] = 0ull;
            }
            const float bq = wave_maxf(knmax);
            if (lane < 4) BND[(wid * 8 + qi) * 4 + lane] = QN[qi * 4 + lane] * bq * (0.125f * 1.002f) + QN[32 + lane] + 1e-3f;
        }
        __builtin_amdgcn_wave_barrier();
        for (int e = lane; e < 2048; e += 64) OSEL[e] = 0.f;
        if (lane < 32) LSUM[wid * 32 + lane] = 0.f;
        __syncthreads();
#pragma unroll 1
        for (int j = wid; j <= qt; j += 8) {
            unsigned long long mask; { const unsigned long long mv = QM[j]; mask = ((unsigned long long)(unsigned)__builtin_amdgcn_readfirstlane((unsigned)(mv >> 32)) << 32) | (unsigned long long)(unsigned)__builtin_amdgcn_readfirstlane((unsigned)mv); }
            if (mask == 0ull) continue;
            bf16x8 kb[4][2], vb[4][2]; ld_k(hin + (tb + j * 64) * DINP + C_NKS + kv * 64, DINP, fr, fq, kb); ld_v((const bf16_t*)(pws() + WS_VST) + ((size_t)((b * 2 + kv) * 256 + j)) * 4096, fr, fq, vb);
            const bool far = (qt * 64 - (j * 64 + 63)) >= 1536;
#pragma unroll 1
            while (mask != 0ull) {
                int q4[4];
#pragma unroll
                for (int g = 0; g < 4; ++g) { if (mask != 0ull) { q4[g] = __builtin_ctzll(mask); mask &= mask - 1ull; } else q4[g] = -1; }
                const int ga = fr >> 2; const int myq = ga == 0 ? q4[0] : ga == 1 ? q4[1] : ga == 2 ? q4[2] : q4[3];
                const int rq = fq == 0 ? q4[0] : fq == 1 ? q4[1] : fq == 2 ? q4[2] : q4[3];
                bf16x8 qs[2];
#pragma unroll
                for (int ks = 0; ks < 2; ++ks) { qs[ks] = (bf16x8){0, 0, 0, 0, 0, 0, 0, 0}; if (myq >= 0) qs[ks] = *(const bf16x8*)(hin + (tb + qt * 64 + myq) * DINP + C_NQ + (kv * 4 + (fr & 3)) * 64 + ks * 32 + fq * 8); }
                f32x4 s[4];
#pragma unroll
                for (int nt = 0; nt < 4; ++nt) { f32x4 c = (f32x4){0.f, 0.f, 0.f, 0.f};
#pragma unroll
                    for (int ks = 0; ks < 2; ++ks) c = MFMA16(qs[ks], kb[nt][ks], c);
                    s[nt] = c; }
                const f32x4 bnd = *(const f32x4*)(BND + (rq >= 0 ? rq : 0) * 4); const int qpos = qt * 64 + rq; float rs[4] = {0.f, 0.f, 0.f, 0.f};
#pragma unroll
                for (int nt = 0; nt < 4; ++nt) { const int dist = qpos - (j * 64 + nt * 16 + fr); const bool ok = rq >= 0 && dist >= 0;
                    const f32x4 bias = *(const f32x4*)(RB + (far ? 31 : (int)BK[dist < 0 ? 0 : (dist > 2047 ? 2047 : dist)]) * 8 + kv * 4);
#pragma unroll
                    for (int jj = 0; jj < 4; ++jj) { const float pe = ok ? __expf(s[nt][jj] * 0.125f + bias[jj] - bnd[jj]) : 0.f; rs[jj] += pe; Pl[(fq * 4 + jj) * 72 + nt * 16 + fr] = f2bf(pe); } }
#pragma unroll
                for (int jj = 0; jj < 4; ++jj) { const float r = red16(rs[jj]); if (fr == 0 && rq >= 0) lds_addf(LSUM + rq * 4 + jj, r); }
                __builtin_amdgcn_wave_barrier();
                bf16x8 pa[2];
#pragma unroll
                for (int ks = 0; ks < 2; ++ks) pa[ks] = *(const bf16x8*)(Pl + fr * 72 + ks * 32 + fq * 8);
                { float* ob = ldsf + ((rq >= 0 ? rq : 0) >> 3) * 4096 + 1152 + ((rq >= 0 ? rq : 0) & 7) * 256;
#pragma unroll
                    for (int nt = 0; nt < 4; ++nt) { f32x4 c = (f32x4){0.f, 0.f, 0.f, 0.f};
#pragma unroll
                        for (int ks = 0; ks < 2; ++ks) c = MFMA16(pa[ks], vb[nt][ks], c);
                        if (rq >= 0) {
#pragma unroll
                            for (int jj = 0; jj < 4; ++jj) lds_addf(ob + jj * 64 + nt * 16 + fr, c[jj]); } } }
                __builtin_amdgcn_wave_barrier();
            }
        }
        __syncthreads();
#pragma unroll
        for (int mt = 0; mt < 2; ++mt) { const int trow = (tb + q0 + mt * 4 + fq) * DM + 512 + kv * 256;
#pragma unroll
            for (int j = 0; j < 4; ++j) { const float g1 = sigmf(bf2f(hin[(tb + q0 + mt * 4 + fq) * DINP + C_NGATE + (kv * 4 + j) * 3 + 1])); const float lsum = LSUM[(wid * 8 + mt * 4 + fq) * 4 + j]; const float scl = lsum > 0.f ? g1 / lsum : 0.f;
#pragma unroll
                for (int nt = 0; nt < 4; ++nt) { const float v = ofin[mt][nt][j] + OSEL[((mt * 4 + fq) * 4 + j) * 64 + nt * 16 + fr] * scl; ss[mt] += v * v; mixed[trow + j * 64 + nt * 16 + fr] = f2bf(v); } } }
        __syncthreads();
    }
    const float* ng = pin(18) + l * 512;
#pragma unroll
    for (int mt = 0; mt < 2; ++mt) { const float r = rsqrtf(red16(ss[mt]) * (1.f / 512.f) + 1e-6f); const int trow = (tb + q0 + mt * 4 + fq) * DM + 512;
#pragma unroll 4
        for (int c = 0; c < 32; ++c) { const int col = c * 16 + fr; mixed[trow + col] = f2bf(bf2f(mixed[trow + col]) * r * ng[col]); } }
    __syncthreads();
}
#ifndef NSA_REP
#define NSA_REP 1
#endif
template <int PCM> __device__ __forceinline__ void mixer_phase_c_item(const Params& p, int l, int it, float* lds);
template <int PCM> __device__ __forceinline__ void mixer_phase_c(const Params& p, int l, float* lds) {
    if (PCM == 15) {
        unsigned* ctr = (unsigned*)(pws() + WS_BAR) + 16 + 16 * l;
        for (;;) {
            if (otid() == 0) ((volatile int*)lds)[36000] = (int)__hip_atomic_fetch_add(ctr, 1u, __ATOMIC_RELAXED, __HIP_MEMORY_SCOPE_AGENT);
            __syncthreads();
            const int it = __builtin_amdgcn_readfirstlane(((volatile int*)lds)[36000]);
            __syncthreads();
            if (it >= 5632) break;
            mixer_phase_c_item<PCM>(p, l, it, lds);
        }
        return;
    }
    for (int it = obid(); it < 5632; it += gridDim.x) mixer_phase_c_item<PCM>(p, l, it, lds);
}
template <int PCM> __device__ __forceinline__ void mixer_phase_c_item(const Params& p, int l, int it, float* lds) {
    {
        if (it < 512) { if (PCM & 1) { const int u = (it & 1) ? 256 + (it >> 1) : 255 - (it >> 1);
            for (int rep = 0; rep < NSA_REP; ++rep) nsa_unit(p, l, u, lds); } }
        else if (it < 1536) { if (PCM & 4) { for (int r = 0; r < 1 + ((CREP >> 1) & 1); ++r) ssd_out_item(p, l, it - 512, lds); } }
        else if (it < 3584) { if (PCM & 2) { for (int r = 0; r < 1 + (CREP & 1); ++r) hg_out_item(p, l, it - 1536, lds); } }
        else { if (PCM & 8) { for (int r = 0; r < 1 + ((CREP >> 2) & 1); ++r) ret_out_item(p, l, it - 3584, lds); } }
    }
}
#ifndef REPEAT_MASK
#define REPEAT_MASK 0
#endif
constexpr int NPHASE = 1 + 13 * NLAYER;
__device__ __forceinline__ void grid_bar(unsigned* ctr, unsigned target) {
    asm volatile("s_waitcnt vmcnt(0) lgkmcnt(0)" ::: "memory");
    __syncthreads();
    if (threadIdx.x == 0) {
        __builtin_amdgcn_fence(__ATOMIC_RELEASE, "agent");
        asm volatile("s_waitcnt vmcnt(0)" ::: "memory");
        __hip_atomic_fetch_add(ctr, 1u, __ATOMIC_RELAXED, __HIP_MEMORY_SCOPE_AGENT);
        unsigned spins = 0;
        while (__hip_atomic_load(ctr, __ATOMIC_RELAXED, __HIP_MEMORY_SCOPE_AGENT) < target) { __builtin_amdgcn_s_sleep(2); if (++spins > (1u << 22)) break; }
        __builtin_amdgcn_fence(__ATOMIC_ACQUIRE, "agent");
        asm volatile("s_waitcnt vmcnt(0)" ::: "memory");
    }
    __syncthreads();
}
template <int PHM> __global__ void __launch_bounds__(NTHREADS, 2) mega_fwd(Params p) {
    extern __shared__ __attribute__((aligned(16))) unsigned char lds_raw[];
    if (threadIdx.x == 0) {
#pragma unroll
        for (int k = 0; k < 31; ++k) g_ptab[k] = (unsigned long long)p.in[k];
        g_ptab[31] = (unsigned long long)p.out; g_ptab[32] = (unsigned long long)p.ws; }
    __syncthreads();
    float* ldsf = (float*)lds_raw; LAS unsigned char* ldsl = (LAS unsigned char*)lds_raw;
        unsigned nbar = 0;
    for (int ph = p.ph_lo; ph < p.ph_hi; ++ph) {
        if (ph == 0 && (PHM & 1)) { cvt_x(p); cvt_ffn(p, 0, 0, ldsf); cvt_mix(p, 0, ldsf); cvt_w1t(p, ldsf); }
        else {
            bf16_t* XB = (bf16_t*)(pws() + WS_XB); bf16_t* HIN = (bf16_t*)(pws() + WS_HIN);
            const int l = (ph - 1) / 13, s = (ph - 1) % 13;
            for (int rep = 0; rep < (((REPEAT_MASK >> s) & 1) ? 2 : 1); ++rep) {
            if ((s == 0 || s == 10) && (PHM & 2)) {
                pg8::Gemm g{XB, (const bf16_t*)(pws() + WS_WA), NTOK, 11264, DM}; pg8::StaticOrder S; S.init(NTOK, 11264, (int)gridDim.x, (int)obid());
                EpiUp E{HIN}; pg8::gemm_phase<EpiUp, pg8::StaticOrder>(ldsl, g, S, E, nullptr);
            } else if ((s == 1 || s == 11 || s == 8) && (PHM & 4)) {
                const bool mix = (s == 8);
                pg8::Gemm g{mix ? XB : HIN, (const bf16_t*)(pws() + (mix ? WS_WD : WS_WB)), NTOK, DM, mix ? DM : DFF}; pg8::StaticOrder S; S.init(NTOK, DM, (int)gridDim.x, (int)obid());
                EpiRes E{(l == 0 && s == 1) ? pin(0) : (mix ? (const float*)pout() : nullptr), XB, pout(), ALPHA, mix ? 1.0f : 0.5f}; pg8::gemm_phase<EpiRes, pg8::StaticOrder>(ldsl, g, S, E, nullptr);
            } else if (s == 3 && (PHM & 8)) {
                pg8::Gemm g{XB, (const bf16_t*)(pws() + WS_WC), NTOK, DINP, DM}; pg8::StaticOrder S; S.init(NTOK, DINP, (int)gridDim.x, (int)obid());
                pg8::EpiBf16<0> E{HIN, DINP, nullptr, 0, 0}; pg8::gemm_phase<pg8::EpiBf16<0>, pg8::StaticOrder>(ldsl, g, S, E, nullptr);
            } else if (s == 2 && (PHM & 16)) { ln_rows(pout(), XB, pin(1) + l * DM, pin(2) + l * DM, true); cvt_ffn(p, l, 1, ldsf); }
            else if (s == 9 && (PHM & 16)) { ln_rows(pout(), XB, pin(6) + l * DM, pin(7) + l * DM, false); }
            else if (s == 12 && (PHM & 16)) { ln_rows(pout(), XB, pin(26) + l * DM, pin(27) + l * DM, l + 1 == NLAYER); if (l + 1 < NLAYER) { cvt_ffn(p, l + 1, 0, ldsf); cvt_mix(p, l + 1, ldsf); } }
            else if (s == 4 && (PHM & 32)) mixer_phase_pre(p, l, ldsf);
            else if (s == 5 && (PHM & 32)) mixer_phase_a(p, l, ldsf);
            else if (s == 6 && (PHM & 64)) scan_phase(p);
            else if (s == 7 && (PHM & 384)) mixer_phase_c<((PHM & 128) ? 1 : 0) | ((PHM & 256) ? 14 : 0)>(p, l, ldsf);
            }
        }
        if (ph + 1 < p.ph_hi) { if (ph == p.ph_lo) cg::this_grid().sync(); else grid_bar((unsigned*)(pws() + WS_BAR), (++nbar) * gridDim.x); }
    }
}

#ifndef HOST_REPEAT
#define HOST_REPEAT 0
#endif
#ifndef MULTI_LAUNCH
#define MULTI_LAUNCH 0
#endif
static int phase_mask(int ph) { if (ph == 0) return 1; const int s = (ph - 1) % 13; return (s == 0 || s == 10) ? 2 : (s == 1 || s == 11 || s == 8) ? 4 : s == 3 ? 8 : (s == 2 || s == 9 || s == 12) ? 16 : (s == 4 || s == 5) ? 32 : s == 6 ? 64 : 128; }
template <int M> static bool setup_one(int* per_cu) {
    if (hipFuncSetAttribute((const void*)mega_fwd<M>, hipFuncAttributeMaxDynamicSharedMemorySize, LDS_BYTES) != hipSuccess) return false;
    int pc = 0; if (hipOccupancyMaxActiveBlocksPerMultiprocessor(&pc, (const void*)mega_fwd<M>, NTHREADS, LDS_BYTES) != hipSuccess) pc = 0; *per_cu = pc; return true;
}
extern "C" void kernel_launch(void* const* d_in, const int* in_sizes, int n_in, void* d_out, int out_size, void* d_ws, size_t ws_size, hipStream_t stream) {
    static int grid = 0;
    if (grid == 0) {
        if (n_in != 31 || out_size != NTOK * DM || ws_size < WS_END) { fprintf(stderr, "kernel_launch: unexpected shapes: n_in %d out %d ws %zu (need %zu)\n", n_in, out_size, ws_size, (size_t)WS_END); grid = -1; return; }
        int dev = 0, cus = 0, per_cu = 0; bool ok = true;
        (void)hipGetDevice(&dev); (void)hipDeviceGetAttribute(&cus, hipDeviceAttributeMultiprocessorCount, dev);
#if MULTI_LAUNCH
        ok = setup_one<1>(&per_cu) && setup_one<2>(&per_cu) && setup_one<4>(&per_cu) && setup_one<8>(&per_cu) && setup_one<16>(&per_cu) && setup_one<32>(&per_cu) && setup_one<64>(&per_cu) && setup_one<128>(&per_cu) && setup_one<256>(&per_cu);
#else
        ok = setup_one<511>(&per_cu);
#endif
        (void)hipGetLastError();
        if (!ok) { fprintf(stderr, "kernel_launch: hipFuncSetAttribute failed\n"); grid = -1; return; }
        grid = cus;
        fprintf(stderr, "kernel_launch: grid %d (cus %d, per_cu %d)\n", grid, cus, per_cu);
    }
    if (grid < 0) return;
    Params p{};
    for (int i = 0; i < 31; ++i) p.in[i] = (const float*)d_in[i];
    p.out = (float*)d_out; p.ws = (unsigned char*)d_ws;
#if MULTI_LAUNCH
    for (int ph = 0; ph < NPHASE; ++ph) { p.ph_lo = ph; p.ph_hi = ph + 1;
      for (int hrep = 0; hrep < ((ph > 0 && ((HOST_REPEAT >> ((ph - 1) % 13)) & 1)) ? 2 : 1); ++hrep)
        switch (phase_mask(ph)) {
            case 1: hipLaunchKernelGGL(mega_fwd<1>, dim3(grid), dim3(NTHREADS), LDS_BYTES, stream, p); break;
            case 2: hipLaunchKernelGGL(mega_fwd<2>, dim3(grid), dim3(NTHREADS), LDS_BYTES, stream, p); break;
            case 4: hipLaunchKernelGGL(mega_fwd<4>, dim3(grid), dim3(NTHREADS), LDS_BYTES, stream, p); break;
            case 8: hipLaunchKernelGGL(mega_fwd<8>, dim3(grid), dim3(NTHREADS), LDS_BYTES, stream, p); break;
            case 16: hipLaunchKernelGGL(mega_fwd<16>, dim3(grid), dim3(NTHREADS), LDS_BYTES, stream, p); break;
            case 32: hipLaunchKernelGGL(mega_fwd<32>, dim3(grid), dim3(NTHREADS), LDS_BYTES, stream, p); break;
            case 64: hipLaunchKernelGGL(mega_fwd<64>, dim3(grid), dim3(NTHREADS), LDS_BYTES, stream, p); break;
            default: hipLaunchKernelGGL(mega_fwd<128>, dim3(grid), dim3(NTHREADS), LDS_BYTES, stream, p); hipLaunchKernelGGL(mega_fwd<256>, dim3(grid), dim3(NTHREADS), LDS_BYTES, stream, p); break;
        }
    }
#else
    p.ph_lo = 0; p.ph_hi = NPHASE;
    (void)hipMemsetAsync((unsigned char*)d_ws + WS_BAR, 0, 256, stream);
    void* args[] = {&p};
    hipError_t e = hipLaunchCooperativeKernel((const void*)mega_fwd<511>, dim3(grid), dim3(NTHREADS), args, LDS_BYTES, stream);
    if (e != hipSuccess) fprintf(stderr, "kernel_launch: cooperative launch failed: %s (grid %d)\n", hipGetErrorString(e), grid);
#endif
}
```

```cpp
#include <hip/hip_runtime.h>
#include <hip/hip_cooperative_groups.h>
#include <cstdio>
namespace cg = cooperative_groups;
__device__ __forceinline__ int otid() { int t = (int)threadIdx.x; asm volatile("" : "+v"(t)); return t; }
__device__ __forceinline__ int obid() { int t = (int)blockIdx.x; asm volatile("" : "+s"(t)); return t; }
template <int CTRL> __device__ __forceinline__ float dppf(float v) { return __int_as_float(__builtin_amdgcn_mov_dpp(__float_as_int(v), CTRL, 0xf, 0xf, true)); }
template <int CTRL> __device__ __forceinline__ unsigned dppu(unsigned v) { return (unsigned)__builtin_amdgcn_mov_dpp((int)v, CTRL, 0xf, 0xf, true); }
template <int CTRL> __device__ __forceinline__ unsigned long long dppu64(unsigned long long v) { return ((unsigned long long)dppu<CTRL>((unsigned)(v >> 32)) << 32) | dppu<CTRL>((unsigned)v); }
template <int K> __device__ __forceinline__ int sxi(int v) {
    if constexpr (K < 32) return __builtin_amdgcn_ds_swizzle(v, (K << 10) | 0x1f);
    else return __builtin_amdgcn_ds_bpermute(((otid() & 63) ^ 32) << 2, v);
}
template <int K> __device__ __forceinline__ float sxf(float v) { return __int_as_float(sxi<K>(__float_as_int(v))); }
__device__ __forceinline__ float wave_sum(float v) { v += sxf<1>(v); v += sxf<2>(v); v += sxf<4>(v); v += sxf<8>(v); v += sxf<16>(v); v += sxf<32>(v); return v; }
template <int K> __device__ __forceinline__ unsigned long long sxu64(unsigned long long v) { const unsigned lo = (unsigned)sxi<K>((int)(unsigned)v), hi = (unsigned)sxi<K>((int)(unsigned)(v >> 32)); return ((unsigned long long)hi << 32) | lo; }
__device__ __forceinline__ unsigned long long wave_max_u64(unsigned long long b) { unsigned long long o;
    o = dppu64<0xB1>(b); b = o > b ? o : b; o = dppu64<0x4E>(b); b = o > b ? o : b; o = dppu64<0x141>(b); b = o > b ? o : b; o = dppu64<0x140>(b); b = o > b ? o : b; o = sxu64<16>(b); b = o > b ? o : b; o = sxu64<32>(b); b = o > b ? o : b; return b; }
__device__ __forceinline__ float wave_maxf(float v) { v = fmaxf(v, dppf<0xB1>(v)); v = fmaxf(v, dppf<0x4E>(v)); v = fmaxf(v, dppf<0x141>(v)); v = fmaxf(v, dppf<0x140>(v)); v = fmaxf(v, sxf<16>(v)); v = fmaxf(v, sxf<32>(v)); return v; }
__device__ __forceinline__ void lds_addf(float* p, float v) { __hip_atomic_fetch_add((__attribute__((address_space(3))) float*)p, v, __ATOMIC_RELAXED, __HIP_MEMORY_SCOPE_WORKGROUP); }
__device__ __forceinline__ void lds_or64(unsigned long long* p, unsigned long long v) { __hip_atomic_fetch_or((__attribute__((address_space(3))) unsigned long long*)p, v, __ATOMIC_RELAXED, __HIP_MEMORY_SCOPE_WORKGROUP); }
namespace pg8 {
#define PG8_LAS __attribute__((address_space(3)))
typedef unsigned short bf16_t;
typedef short bf16x8 __attribute__((ext_vector_type(8)));
typedef float f32x4 __attribute__((ext_vector_type(4)));
typedef unsigned u32x4 __attribute__((ext_vector_type(4)));
constexpr int BM = 256, BK = 64, HALF = 128, HTB = HALF * BK * 2  , STAGE_BYTES = 8 * HTB, NXCD = 8, WGM = 8;

__host__ __device__ __forceinline__ int lds_byte(int r, int c) { const int st = (r >> 4) * 2 + (c >> 5), rr = r & 15, cc = c & 31, ob = rr * 64 + cc * 2; return st * 1024 + (ob ^ (((ob >> 9) & 1) << 5)); }
__host__ __device__ __forceinline__ void stage_rc(int b, int& R, int& C) { const int st = b / 1024, sb = b % 1024, swz = sb ^ (((sb >> 9) & 1) << 5); R = (st >> 1) * 16 + swz / 64; C = (st & 1) * 32 + (swz % 64) / 2; }
__host__ __device__ __forceinline__ int perm32(int rho) { const int n = rho >> 4, i = rho & 15; return 8 * (i >> 2) + 4 * n + (i & 3); }

struct Unit { int pm, pn; };
struct Gemm { const bf16_t* A; const bf16_t* Bt; int M, N, K; };

struct StaticOrder {
    int nM, nN, nwg, G, c;
    __host__ __device__ void init(int M, int N, int G_, int c_) { nM = M / BM; nN = N / BM; nwg = nM * nN; G = G_; c = c_; }
    __host__ __device__ bool next(int i, Unit& u) const {
        const long L = (long)i * G + c; if (L >= nwg) return false;
        int wgid = (int)L; { const int q = nwg / NXCD, r = nwg % NXCD, xcd = wgid % NXCD, off = wgid / NXCD; wgid = (xcd < r ? xcd * (q + 1) : r * (q + 1) + (xcd - r) * q) + off; }
        const int nig = WGM * nN, gid = wgid / nig, fm = gid * WGM, gsz = (nM - fm) < WGM ? (nM - fm) : WGM;
        u.pm = fm + ((wgid % nig) % gsz); u.pn = (wgid % nig) / gsz; return true;
    }
    __device__ __forceinline__ void a_ready(const Unit&) const {}
    __device__ __forceinline__ void done(const Unit&) const {}
};
struct CountedOrder : StaticOrder {
    const unsigned* ready; unsigned need; unsigned* tmo;
    __device__ __forceinline__ void a_ready(const Unit& u) const {
        if (threadIdx.x < 64) {
            const unsigned long long t0 = __builtin_amdgcn_s_memrealtime(); unsigned polls = 0;
            while ((unsigned)__builtin_amdgcn_readfirstlane(__hip_atomic_load(ready + 64 * u.pm, __ATOMIC_RELAXED, __HIP_MEMORY_SCOPE_AGENT)) < need) {
                if ((++polls & 255u) == 0u && __builtin_amdgcn_readfirstlane(__hip_atomic_load(tmo, __ATOMIC_RELAXED, __HIP_MEMORY_SCOPE_AGENT)) != 0u) break;
                if (__builtin_amdgcn_s_memrealtime() - t0 > 2000000ull) {
                    if (threadIdx.x == 0) { unsigned expect = 0u; __hip_atomic_compare_exchange_strong(tmo + 1, &expect, 0x600u | (unsigned)(u.pm & 0xff), __ATOMIC_RELAXED, __ATOMIC_RELAXED, __HIP_MEMORY_SCOPE_AGENT); __hip_atomic_store(tmo, 1u, __ATOMIC_RELAXED, __HIP_MEMORY_SCOPE_AGENT); }
                    break; }
                __builtin_amdgcn_s_sleep(2); }
            __builtin_amdgcn_fence(__ATOMIC_ACQUIRE, "agent");
            asm volatile("s_waitcnt vmcnt(0)" ::: "memory");
        }
#if !defined(BROKEN_HOOK_NO_BARRIER)
        asm volatile("" ::: "memory"); __builtin_amdgcn_s_barrier(); asm volatile("" ::: "memory");
#endif
    }
};

__device__ __forceinline__ unsigned cvt_pk_bf16(float lo, float hi) { unsigned r; asm volatile("v_cvt_pk_bf16_f32 %0, %1, %2" : "=v"(r) : "v"(lo), "v"(hi)); return r; }
typedef float f32x2 __attribute__((ext_vector_type(2)));
__device__ __forceinline__ f32x2 gelu_pk(f32x2 v) {
    const f32x2 av = __builtin_elementwise_abs(v), d = av * 0.2316418882f + 1.0f;
    f32x2 t; t.x = __builtin_amdgcn_rcpf(d.x); t.y = __builtin_amdgcn_rcpf(d.y);
    f32x2 q = t * 0.5307027145f + (-0.7265760135f); q = q * t + 0.7107068705f; q = q * t + (-0.142248368f); q = q * t + 0.127414796f; q = q * t;
    const f32x2 s = (v * v) * (-0.72134752044f);
    f32x2 e; e.x = __builtin_amdgcn_exp2f(s.x); e.y = __builtin_amdgcn_exp2f(s.y);
    const f32x2 m = v * (q * e), r = v - m;
    f32x2 o; o.x = v.x < 0.f ? m.x : r.x; o.y = v.y < 0.f ? m.y : r.y; return o;
}

struct EpiF32 {
    static constexpr bool PERM = false, AFTER_DRAIN = false;
    float* C; int ldc; const float* bias;
    __device__ __forceinline__ void operator()(const f32x4 (&acc)[2][2][4][2], const Unit& u, int wr, int wc, int fr, int fq) const {
        const int row0 = u.pm * BM + wr * 64 + fr, col0 = u.pn * BM + wc * 32 + 4 * fq;
        f32x4 bv[2][2];
#pragma unroll
        for (int bj = 0; bj < 2; ++bj)
#pragma unroll
            for (int n = 0; n < 2; ++n) bv[bj][n] = bias ? *(const f32x4*)(bias + col0 + bj * HALF + n * 16) : (f32x4){0.f, 0.f, 0.f, 0.f};
#pragma unroll
        for (int ai = 0; ai < 2; ++ai)
#pragma unroll
            for (int m = 0; m < 4; ++m) { float* rowp = C + (size_t)(row0 + ai * HALF + m * 16) * ldc + col0;
#pragma unroll
                for (int bj = 0; bj < 2; ++bj)
#pragma unroll
                    for (int n = 0; n < 2; ++n) *(f32x4*)(rowp + bj * HALF + n * 16) = acc[ai][bj][m][n] + bv[bj][n]; }
    }
};
template <int ACT  > struct EpiBf16 {
    static constexpr bool PERM = true, AFTER_DRAIN = false;
    bf16_t* O; int ldc; const float* bias; int split_cols; size_t split_stride;
    __device__ __forceinline__ void operator()(const f32x4 (&acc)[2][2][4][2], const Unit& u, int wr, int wc, int fr, int fq) const {
        const int row0 = u.pm * BM + wr * 64 + fr; int colt = u.pn * BM; bf16_t* base = O;
        if (split_cols) { const int t = colt / split_cols; base += (size_t)t * split_stride; colt -= t * split_cols; }
        const int col0 = colt + wc * 32 + 8 * fq, bcol0 = u.pn * BM + wc * 32 + 8 * fq;
        f32x4 bv[2][2];
#pragma unroll
        for (int bj = 0; bj < 2; ++bj)
#pragma unroll
            for (int n = 0; n < 2; ++n) bv[bj][n] = bias ? *(const f32x4*)(bias + bcol0 + bj * HALF + 4 * n) : (f32x4){0.f, 0.f, 0.f, 0.f};
#pragma unroll
        for (int ai = 0; ai < 2; ++ai)
#pragma unroll
            for (int m = 0; m < 4; ++m) { bf16_t* rowp = base + (size_t)(row0 + ai * HALF + m * 16) * ldc + col0;
#pragma unroll
                for (int bj = 0; bj < 2; ++bj) { f32x4 v0 = acc[ai][bj][m][0] + bv[bj][0], v1 = acc[ai][bj][m][1] + bv[bj][1];
                    if (ACT == 1) { f32x2 a = gelu_pk((f32x2){v0[0], v0[1]}), b = gelu_pk((f32x2){v0[2], v0[3]}), c = gelu_pk((f32x2){v1[0], v1[1]}), d = gelu_pk((f32x2){v1[2], v1[3]});
                        v0 = (f32x4){a.x, a.y, b.x, b.y}; v1 = (f32x4){c.x, c.y, d.x, d.y}; }
                    if (ACT == 2) {
#pragma unroll
                        for (int j = 0; j < 4; ++j) { v0[j] = 0.5f * v0[j] * (1.0f + erff(v0[j] * 0.70710678f)); v1[j] = 0.5f * v1[j] * (1.0f + erff(v1[j] * 0.70710678f)); } }
                    u32x4 w; w.x = cvt_pk_bf16(v0[0], v0[1]); w.y = cvt_pk_bf16(v0[2], v0[3]); w.z = cvt_pk_bf16(v1[0], v1[1]); w.w = cvt_pk_bf16(v1[2], v1[3]);
                    *(u32x4*)(rowp + bj * HALF) = w; } }
    }
};
template <class Epi, class Sched, bool STAMP = false>
__device__ __forceinline__ void gemm_phase(PG8_LAS unsigned char* lds, const Gemm g, const Sched& S, const Epi& E, unsigned long long* stamps) {
    const int tid = otid(), wid = __builtin_amdgcn_readfirstlane(tid >> 6), lane = tid & 63, wr = wid >> 2, wc = wid & 3, fr = lane & 15, fq = lane >> 4;
    const int K = g.K, nt = K / BK;
    int ts_lo = 0, ts_hi = 0, nts = 0; const unsigned long long rt_entry = STAMP ? (unsigned long long)wall_clock64() : 0ull;
#define PG8_STAMP() do { if (STAMP && wid == 0 && nts < 64) { const unsigned long long _c = (unsigned long long)clock64(); \
        ts_lo = (lane == nts) ? (int)(unsigned)_c : ts_lo; ts_hi = (lane == nts) ? (int)(unsigned)(_c >> 32) : ts_hi; ++nts; } } while (0)
    PG8_STAMP();
    unsigned voffA[2], voffB[2];
#pragma unroll
    for (int i = 0; i < 2; ++i) { int R, C; stage_rc(tid * 16 + i * 8192, R, C); const int Rb = Epi::PERM ? ((R & ~31) + perm32(R & 31)) : R;
        voffA[i] = (unsigned)(R * K + C) * 2u; voffB[i] = (unsigned)(Rb * K + C) * 2u; }
    const size_t kstep = (size_t)(BK * 2);
    const size_t hstep = (size_t)HALF * K * 2;
    const size_t tstep = 2 * hstep;
    const unsigned ldsw = (unsigned)wid * 1024u;
    const int aoff = lds_byte(wr * 64 + fr, fq * 8), boff = lds_byte(wc * 32 + fr, fq * 8);
#define PG8_SA(b, h) (((b) * 2 + (h)) * HTB)
#define PG8_SB(b, h) ((4 + (b) * 2 + (h)) * HTB)
#define PG8_STAGE(bufoff, gbase, voff) do { _Pragma("unroll") for (int _i = 0; _i < 2; ++_i) \
        __builtin_amdgcn_global_load_lds((const unsigned*)((const char*)(gbase) + (voff)[_i]), (PG8_LAS unsigned*)(lds + (bufoff) + ldsw + _i * 8192), 16, 0, 0); } while (0)
#define PG8_LDA(dst, b, h) do { _Pragma("unroll") for (int m = 0; m < 4; ++m) _Pragma("unroll") for (int k = 0; k < 2; ++k) dst[m][k] = *(const PG8_LAS bf16x8*)(lds + PG8_SA(b, h) + aoff + m * 2048 + k * 1024); } while (0)
#define PG8_LDB(dst, b, h) do { _Pragma("unroll") for (int n = 0; n < 2; ++n) _Pragma("unroll") for (int k = 0; k < 2; ++k) dst[n][k] = *(const PG8_LAS bf16x8*)(lds + PG8_SB(b, h) + boff + n * 2048 + k * 1024); } while (0)
#define PG8_MMA(ai, bj, At, Bt) do { __builtin_amdgcn_s_setprio(1); _Pragma("unroll") for (int m = 0; m < 4; ++m) _Pragma("unroll") for (int n = 0; n < 2; ++n) _Pragma("unroll") for (int k = 0; k < 2; ++k) \
        acc[ai][bj][m][n] = __builtin_amdgcn_mfma_f32_16x16x32_bf16(Bt[n][k], At[m][k], acc[ai][bj][m][n], 0, 0, 0); __builtin_amdgcn_s_setprio(0); } while (0)
#define PG8_WAIT_V(n) asm volatile("s_waitcnt vmcnt(" #n ")" ::: "memory")
#define PG8_WAIT_L(n) asm volatile("s_waitcnt lgkmcnt(" #n ")" ::: "memory")
#define PG8_BAR __builtin_amdgcn_s_barrier()
#define PG8_SCHED __builtin_amdgcn_sched_barrier(0)
    Unit cur, nxt; int ui = 0;
    if (!S.next(0, cur)) return;
    f32x4 acc[2][2][4][2];
#pragma unroll
    for (int a = 0; a < 2; ++a)
#pragma unroll
        for (int b = 0; b < 2; ++b)
#pragma unroll
            for (int m = 0; m < 4; ++m)
#pragma unroll
                for (int n = 0; n < 2; ++n) acc[a][b][m][n] = (f32x4){0.f, 0.f, 0.f, 0.f};
    bf16x8 At[4][2], B0[2][2], B1[2][2];
    const char* cA = (const char*)g.A + (size_t)cur.pm * tstep; const char* cB = (const char*)g.Bt + (size_t)cur.pn * tstep;
    S.a_ready(cur);
    PG8_STAGE(PG8_SB(0, 0), cB, voffB); PG8_STAGE(PG8_SA(0, 0), cA, voffA); PG8_STAGE(PG8_SB(0, 1), cB + hstep, voffB); PG8_STAGE(PG8_SA(0, 1), cA + hstep, voffA);
    if (wr == 1) PG8_BAR;
    PG8_WAIT_V(4); PG8_BAR;
    PG8_STAGE(PG8_SB(1, 0), cB + kstep, voffB); PG8_STAGE(PG8_SA(1, 0), cA + kstep, voffA); PG8_STAGE(PG8_SB(1, 1), cB + hstep + kstep, voffB);
    PG8_WAIT_V(6); PG8_BAR;
    PG8_STAMP();
    for (;;) {
        const bool has_next = S.next(ui + 1, nxt);
        const char* nA = has_next ? (const char*)g.A + (size_t)nxt.pm * tstep : cA; const char* nB = has_next ? (const char*)g.Bt + (size_t)nxt.pn * tstep : cB;
        for (int t = 0; t < nt; t += 2) {
            const bool last = (t == nt - 2);
            const char* a1 = cA + (size_t)(t + 1) * kstep;
            const char* a2 = last ? nA : cA + (size_t)(t + 2) * kstep; const char* b2 = last ? nB : cB + (size_t)(t + 2) * kstep;
            const char* a3 = a2 + kstep; const char* b3 = b2 + kstep;
            if (last && has_next) S.a_ready(nxt);
            PG8_LDB(B0, 0, 0); PG8_SCHED; PG8_LDA(At, 0, 0); PG8_STAGE(PG8_SA(1, 1), a1 + hstep, voffA);
            PG8_WAIT_L(8); PG8_BAR; PG8_WAIT_L(0); PG8_MMA(0, 0, At, B0); PG8_BAR; PG8_SCHED;
            PG8_LDB(B1, 0, 1); PG8_STAGE(PG8_SB(0, 0), b2, voffB);
            PG8_BAR; PG8_WAIT_L(0); PG8_MMA(0, 1, At, B1); PG8_BAR;
            PG8_LDA(At, 0, 1); PG8_STAGE(PG8_SA(0, 0), a2, voffA);
            PG8_BAR; PG8_WAIT_L(0); PG8_MMA(1, 0, At, B0); PG8_BAR; PG8_SCHED;
            PG8_STAGE(PG8_SB(0, 1), b2 + hstep, voffB);
            PG8_WAIT_V(6); PG8_BAR; PG8_MMA(1, 1, At, B1); PG8_BAR;
            PG8_LDB(B0, 1, 0); PG8_SCHED; PG8_LDA(At, 1, 0); PG8_STAGE(PG8_SA(0, 1), a2 + hstep, voffA);
            PG8_WAIT_L(8); PG8_BAR; PG8_WAIT_L(0); PG8_MMA(0, 0, At, B0); PG8_BAR; PG8_SCHED;
            PG8_LDB(B1, 1, 1); PG8_STAGE(PG8_SB(1, 0), b3, voffB);
            PG8_BAR; PG8_WAIT_L(0); PG8_MMA(0, 1, At, B1); PG8_BAR;
            PG8_LDA(At, 1, 1); PG8_STAGE(PG8_SA(1, 0), a3, voffA);
            PG8_BAR; PG8_WAIT_L(0); PG8_MMA(1, 0, At, B0); PG8_BAR; PG8_SCHED;
            PG8_STAGE(PG8_SB(1, 1), b3 + hstep, voffB);
            PG8_WAIT_V(6); PG8_BAR; PG8_MMA(1, 1, At, B1); PG8_BAR;
        }
        PG8_STAMP();
        if constexpr (!Epi::AFTER_DRAIN) { E(acc, cur, wr, wc, fr, fq); S.done(cur); }
        PG8_STAMP();
        if (!has_next) break;
#pragma unroll
        for (int a = 0; a < 2; ++a)
#pragma unroll
            for (int b = 0; b < 2; ++b)
#pragma unroll
                for (int m = 0; m < 4; ++m)
#pragma unroll
                    for (int n = 0; n < 2; ++n) acc[a][b][m][n] = (f32x4){0.f, 0.f, 0.f, 0.f};
        cur = nxt; cA = nA; cB = nB; ++ui;
    }
    PG8_WAIT_V(0);
    if (wr == 0) PG8_BAR;
    PG8_BAR;
    if constexpr (Epi::AFTER_DRAIN) { E.fused(acc, cur, wr, wc, fr, fq, lds, wid, lane); S.done(cur); }
    PG8_STAMP();
    if (STAMP && wid == 0) { stamps[lane] = lane < nts ? (((unsigned long long)(unsigned)ts_hi << 32) | (unsigned)ts_lo) : 0ull;
        if (lane == 62) stamps[62] = rt_entry; if (lane == 63) stamps[63] = (unsigned long long)wall_clock64(); }
#undef PG8_STAMP
#undef PG8_SA
#undef PG8_SB
#undef PG8_STAGE
#undef PG8_LDA
#undef PG8_LDB
#undef PG8_MMA
#undef PG8_WAIT_V
#undef PG8_WAIT_L
#undef PG8_BAR
#undef PG8_SCHED
}
}
typedef unsigned short bf16_t;
typedef float f32x4 __attribute__((ext_vector_type(4)));
typedef unsigned u32x4 __attribute__((ext_vector_type(4)));
typedef unsigned u32x2 __attribute__((ext_vector_type(2)));
typedef short bf16x8 __attribute__((ext_vector_type(8)));
#define MFMA16(a, b, c) __builtin_amdgcn_mfma_f32_16x16x32_bf16((a), (b), (c), 0, 0, 0)
#define LAS __attribute__((address_space(3)))

constexpr int SEQ = 16384, NBATCH = 2, NTOK = 32768, DM = 2048, DFF = 5632, DIN = 6944, DINP = 7168, NLAYER = 2;
constexpr int C_HQ = 0, C_HF = 512, C_HI = 1024, C_HG = 1536, C_NQ = 2048, C_NKC = 2560, C_NVC = 2688, C_NKS = 2816, C_NVS = 2944,
              C_NKW = 3072, C_NVW = 3200, C_NGATE = 3328, C_SZ = 3352, C_SXBC = 3864, C_SDT = 4888, C_RQ = 4896, C_RK = 5408, C_RV = 5920, C_RG = 6432;
constexpr float ALPHA = 1.41421356237f;
constexpr int LDS_BYTES = 147456;
constexpr int NTHREADS = 512;

constexpr size_t WS_WA = 0;
constexpr size_t WS_WB = WS_WA + (size_t)11264 * 2048 * 2;
constexpr size_t WS_WC = WS_WB + (size_t)2048 * 5632 * 2;
constexpr size_t WS_WD = WS_WC + (size_t)7168 * 2048 * 2;
constexpr size_t WS_XB = WS_WD + (size_t)2048 * 2048 * 2;
constexpr size_t WS_HIN = WS_XB + (size_t)NTOK * 2048 * 2;
constexpr size_t WS_STH = WS_HIN + (size_t)NTOK * DINP * 2;
constexpr size_t WS_STS = WS_STH + (size_t)2048 * 16384 * 2;
constexpr size_t WS_STR = WS_STS + (size_t)4096 * 8192 * 2;
constexpr size_t WS_DECH = WS_STR + (size_t)2048 * 16384 * 2;
constexpr size_t WS_DECS = WS_DECH + (size_t)2048 * 128 * 4;
constexpr size_t WS_KCMP = WS_DECS + (size_t)4096 * 4;
constexpr size_t WS_VCMP = WS_KCMP + (size_t)4 * 1024 * 64 * 4;
constexpr size_t WS_VST = WS_VCMP + (size_t)4 * 1024 * 64 * 4;
constexpr size_t WS_VWT = WS_VST + (size_t)4 * 256 * 4096 * 2;
constexpr size_t WS_KCB = WS_VWT + (size_t)4 * 256 * 4096 * 2;
constexpr size_t WS_VCT = WS_KCB + (size_t)4 * 1024 * 64 * 2;
constexpr size_t WS_XBC = WS_VCT + (size_t)4 * 16 * 4096 * 2;
constexpr size_t WS_KNORM = WS_XBC + (size_t)NTOK * 1024 * 2;
constexpr size_t WS_BAR = WS_KNORM + (size_t)4 * 256 * 4;
constexpr size_t WS_W1T = WS_BAR + 256;
constexpr size_t WS_END = WS_W1T + (size_t)4 * 256 * 2048 * 2;

struct Params {
    const float* in[31];
    float* out;
    unsigned char* ws;
    int ph_lo, ph_hi;
};

__shared__ unsigned long long g_ptab[40];
__device__ __forceinline__ unsigned long long ptab_get(int k) { const unsigned long long v = *(volatile LAS unsigned long long*)((LAS unsigned long long*)g_ptab + k);
    unsigned lo = __builtin_amdgcn_readfirstlane((unsigned)v), hi = __builtin_amdgcn_readfirstlane((unsigned)(v >> 32)); asm volatile("" : "+s"(lo), "+s"(hi)); return ((unsigned long long)hi << 32) | lo; }
#define GAS __attribute__((address_space(1)))
__device__ __forceinline__ const float* pin(int k) { return (const float*)(GAS const float*)ptab_get(k); }
__device__ __forceinline__ float* pout() { return (float*)(GAS float*)ptab_get(31); }
__device__ __forceinline__ unsigned char* pws() { return (unsigned char*)(GAS unsigned char*)ptab_get(32); }
__device__ __forceinline__ float bf2f(bf16_t v) { return __uint_as_float(((unsigned)v) << 16); }
__device__ __forceinline__ float bflo(unsigned w) { return __uint_as_float(w << 16); }
__device__ __forceinline__ float bfhi(unsigned w) { return __uint_as_float(w & 0xffff0000u); }
__device__ __forceinline__ unsigned pk2(float lo, float hi) { return pg8::cvt_pk_bf16(lo, hi); }
__device__ __forceinline__ void ld8(const bf16_t* p, float (&x)[8]) { const u32x4 w = *(const u32x4*)p; x[0] = bflo(w.x); x[1] = bfhi(w.x); x[2] = bflo(w.y); x[3] = bfhi(w.y); x[4] = bflo(w.z); x[5] = bfhi(w.z); x[6] = bflo(w.w); x[7] = bfhi(w.w); }
__device__ __forceinline__ void st8(float* p, const float (&x)[8]) { *(f32x4*)p = (f32x4){x[0], x[1], x[2], x[3]}; *(f32x4*)(p + 4) = (f32x4){x[4], x[5], x[6], x[7]}; }
__device__ __forceinline__ void ldf8(const float* p, float (&x)[8]) { const f32x4 a = *(const f32x4*)p, b = *(const f32x4*)(p + 4); x[0] = a[0]; x[1] = a[1]; x[2] = a[2]; x[3] = a[3]; x[4] = b[0]; x[5] = b[1]; x[6] = b[2]; x[7] = b[3]; }
__device__ __forceinline__ float siluf(float x) { return x * __builtin_amdgcn_rcpf(1.f + __expf(-x)); }
__device__ __forceinline__ float sigmf(float x) { return __builtin_amdgcn_rcpf(1.f + __expf(-x)); }
__device__ __forceinline__ float softplusf(float x) { const float e = __expf(-fabsf(x)); const float l1 = e < 0.01f ? e * (1.f - e * (0.5f - e * (1.f / 3.f))) : __logf(1.f + e); return fmaxf(x, 0.f) + l1; }

__device__ __forceinline__ void cvt_tile(const float* s0, const float* s1, bf16_t* dstp, int K, int N, int mode, int tile, float* tl) {
    const int nkb = K >> 6; const int rb = tile / nkb, kb = tile - rb * nkb;
    const int r0 = rb * 128; const float* src = s0; int col0 = r0;
    if (mode == 1) { const int pn = r0 >> 8, bj = (r0 >> 7) & 1; src = bj ? s1 : s0; col0 = pn * 128; }
    const int tid = otid();
    { const int n = tid & 127, k0 = tid >> 7; const bool ok = (col0 + n) < N; const float* sp = src + (size_t)(kb * 64 + k0) * N + col0 + n;
#pragma unroll
      for (int i = 0; i < 16; ++i) tl[(k0 + 4 * i) * 129 + n] = ok ? __builtin_nontemporal_load(sp + (size_t)(4 * i) * N) : 0.f; }
    __syncthreads();
    { const int k8 = (tid & 7) * 8;
#pragma unroll
      for (int i = 0; i < 2; ++i) { const int n = (tid >> 3) + 64 * i; const float* c = tl + k8 * 129 + n;
          u32x4 w; w.x = pk2(c[0], c[129]); w.y = pk2(c[2 * 129], c[3 * 129]); w.z = pk2(c[4 * 129], c[5 * 129]); w.w = pk2(c[6 * 129], c[7 * 129]);
          *(u32x4*)(dstp + (size_t)(r0 + n) * K + kb * 64 + k8) = w; } }
    __syncthreads();
}
__device__ void cvt_ffn(const Params& p, int l, int which  , float* tl) {
    const float* w1 = pin(which ? 28 : 3) + (size_t)l * DM * DFF; const float* w3 = pin(which ? 29 : 4) + (size_t)l * DM * DFF; const float* w2 = pin(which ? 30 : 5) + (size_t)l * DFF * DM;
    constexpr int n0 = (11264 / 128) * (DM / 64), n1 = (DM / 128) * (DFF / 64);
    for (int g = obid(); g < n0 + n1; g += gridDim.x) { const bool f = g < n0;
        cvt_tile(f ? w1 : w2, w3, (bf16_t*)(pws() + (f ? WS_WA : WS_WB)), f ? DM : DFF, f ? DFF : DM, f ? 1 : 0, f ? g : g - n0, tl); }
}
__device__ void cvt_mix(const Params& p, int l, float* tl) {
    constexpr int n0 = (DINP / 128) * (DM / 64), n1 = (DM / 128) * (DM / 64);
    for (int g = obid(); g < n0 + n1; g += gridDim.x) { const bool f = g < n0;
        cvt_tile(f ? pin(8) + (size_t)l * DM * DIN : pin(9) + (size_t)l * DM * DM, nullptr, (bf16_t*)(pws() + (f ? WS_WC : WS_WD)), DM, f ? DIN : DM, 0, f ? g : g - n0, tl); }
}
__device__ void cvt_w1t(const Params& p, float* tl) {
    for (int g = obid(); g < 256; g += gridDim.x) { const int job = g >> 6, l = job >> 1, which = job & 1;
        cvt_tile(pin(which ? 16 : 13) + (size_t)l * 2048 * 256, nullptr, (bf16_t*)(pws() + WS_W1T) + (size_t)job * 256 * 2048, 2048, 256, 0, g & 63, tl); }
}
__device__ void cvt_x(const Params& p) {
    const f32x4* x = (const f32x4*)pin(0); u32x2* xb = (u32x2*)(pws() + WS_XB);
    for (size_t i = (size_t)obid() * NTHREADS + otid(); i < (size_t)NTOK * DM / 4; i += (size_t)gridDim.x * NTHREADS) {
        const f32x4 v = __builtin_nontemporal_load(x + i); u32x2 w; w.x = pk2(v[0], v[1]); w.y = pk2(v[2], v[3]); xb[i] = w; }
}

struct EpiUp {
    static constexpr bool PERM = true, AFTER_DRAIN = false;
    bf16_t* H;
    __device__ __forceinline__ void operator()(const pg8::f32x4 (&acc)[2][2][4][2], const pg8::Unit& u, int wr, int wc, int fr, int fq) const {
        const int row0 = u.pm * 256 + wr * 64 + fr, col0 = u.pn * 128 + wc * 32 + 8 * fq;
#pragma unroll
        for (int ai = 0; ai < 2; ++ai)
#pragma unroll
            for (int m = 0; m < 4; ++m) { bf16_t* rowp = H + (size_t)(row0 + ai * 128 + m * 16) * DFF + col0;
                const pg8::f32x4 a0 = acc[ai][0][m][0], a1 = acc[ai][0][m][1], b0 = acc[ai][1][m][0], b1 = acc[ai][1][m][1];
                float v0[4], v1[4];
#pragma unroll
                for (int j = 0; j < 4; ++j) { v0[j] = siluf(a0[j]) * b0[j]; v1[j] = siluf(a1[j]) * b1[j]; }
                pg8::u32x4 w; w.x = pk2(v0[0], v0[1]); w.y = pk2(v0[2], v0[3]); w.z = pk2(v1[0], v1[1]); w.w = pk2(v1[2], v1[3]);
                *(pg8::u32x4*)rowp = w; }
    }
};
struct EpiRes {
    static constexpr bool PERM = false, AFTER_DRAIN = false;
    const float* res32; const bf16_t* res16; float* out; float alpha, scale;
    __device__ __forceinline__ void operator()(const pg8::f32x4 (&acc)[2][2][4][2], const pg8::Unit& u, int wr, int wc, int fr, int fq) const {
        const int row0 = u.pm * 256 + wr * 64 + fr, col0 = u.pn * 256 + wc * 32 + 4 * fq;
#pragma unroll
        for (int ai = 0; ai < 2; ++ai)
#pragma unroll
            for (int m = 0; m < 4; ++m) { const size_t off = (size_t)(row0 + ai * 128 + m * 16) * DM + col0;
#pragma unroll
                for (int bj = 0; bj < 2; ++bj)
#pragma unroll
                    for (int n = 0; n < 2; ++n) { pg8::f32x4 r;
                        if (res32) r = *(const pg8::f32x4*)(res32 + off + bj * 128 + n * 16);
                        else { const u32x2 w = *(const u32x2*)(res16 + off + bj * 128 + n * 16); r = (pg8::f32x4){bflo(w.x), bfhi(w.x), bflo(w.y), bfhi(w.y)}; }
                        *(pg8::f32x4*)(out + off + bj * 128 + n * 16) = r * alpha + acc[ai][bj][m][n] * scale; } }
    }
};

__device__ void ln_rows(float* X, bf16_t* xb, const float* g, const float* b, bool write_f32) {
    const int wid = otid() >> 6, lane = otid() & 63;
    for (int row = obid() * 8 + wid; row < NTOK; row += gridDim.x * 8) {
        float* xr = X + (size_t)row * DM; f32x4 v[8]; float s = 0.f;
#pragma unroll
        for (int i = 0; i < 8; ++i) { v[i] = __builtin_nontemporal_load((const f32x4*)(xr + i * 256 + lane * 4)); s += (v[i][0] + v[i][1]) + (v[i][2] + v[i][3]); }
        s = wave_sum(s);
        const float mean = s * (1.f / DM); float q = 0.f;
#pragma unroll
        for (int i = 0; i < 8; ++i) { const f32x4 d = v[i] - mean; q += (d[0] * d[0] + d[1] * d[1]) + (d[2] * d[2] + d[3] * d[3]); }
        q = wave_sum(q);
        const float rstd = rsqrtf(q * (1.f / DM) + 1e-5f);
#pragma unroll
        for (int i = 0; i < 8; ++i) { const int c = i * 256 + lane * 4; const f32x4 gg = *(const f32x4*)(g + c), bb = *(const f32x4*)(b + c);
            const f32x4 o = (v[i] - mean) * rstd * gg + bb; if (write_f32) __builtin_nontemporal_store(o, (f32x4*)(xr + c));
            u32x2 w; w.x = pk2(o[0], o[1]); w.y = pk2(o[2], o[3]); *(u32x2*)(xb + (size_t)row * DM + c) = w; }
    }
}
#ifndef AREP
#define AREP 0
#endif
#ifndef CREP
#define CREP 0
#endif
constexpr int LP = 132;
__device__ __forceinline__ float hg_lb(const float* lg, int l, int idx) {
    if (l == 0) return 0.f; const float a0 = lg[idx], a1 = lg[512 + idx]; return 1.f / (1.f + __expf(a0 - a1));
}
__device__ __forceinline__ void hg_lb8(const float* lg, int l, int idx, float (&lb)[8]) {
    if (l == 0) {
#pragma unroll
        for (int k = 0; k < 8; ++k) lb[k] = 0.f;
    } else { float a0[8], a1[8]; ldf8(lg + idx, a0); ldf8(lg + 512 + idx, a1);
#pragma unroll
        for (int k = 0; k < 8; ++k) lb[k] = __builtin_amdgcn_rcpf(1.f + __expf(a0[k] - a1[k])); }
}
template <int DV> __device__ __forceinline__ void state_mm(const float* KD, const float* VV, bf16_t* dst) {
    const int tid = otid(), td = tid >> 4, tv = tid & 15;
    constexpr int NV = DV / 64;
    f32x4 acc[4][NV];
#pragma unroll
    for (int a = 0; a < 4; ++a)
#pragma unroll
        for (int n = 0; n < NV; ++n) acc[a][n] = (f32x4){0.f, 0.f, 0.f, 0.f};
    for (int j = 0; j < 64; ++j) {
        f32x4 v[NV];
#pragma unroll
        for (int n = 0; n < NV; ++n) v[n] = *(const f32x4*)(VV + j * LP + n * 64 + tv * 4);
#pragma unroll
        for (int a = 0; a < 4; ++a) { const float kd = KD[j * LP + td + 32 * a];
#pragma unroll
            for (int n = 0; n < NV; ++n) acc[a][n] += v[n] * kd; }
    }
#pragma unroll
    for (int a = 0; a < 4; ++a)
#pragma unroll
        for (int n = 0; n < NV; ++n) { u32x2 w; w.x = pk2(acc[a][n][0], acc[a][n][1]); w.y = pk2(acc[a][n][2], acc[a][n][3]);
            *(u32x2*)(dst + (size_t)(td + 32 * a) * DV + n * 64 + tv * 4) = w; }
}
__device__ __forceinline__ float ssd_act(const bf16_t* xbc, int b, int s, int ch) { return bf2f(xbc[((size_t)b * SEQ + s) * 1024 + ch]); }
__device__ void conv_prepass(const Params& p, int l) {
    const int tid = otid(), cg8 = (tid & 127) * 8, slot = tid >> 7;
    const bf16_t* hin = (const bf16_t*)(pws() + WS_HIN); bf16_t* xbc = (bf16_t*)(pws() + WS_XBC); const float* cw = pin(20) + l * 4096; const float* cb = pin(21) + l * 1024;
    float w[4][8], bias[8];
#pragma unroll
    for (int c = 0; c < 8; ++c) { bias[c] = cb[cg8 + c];
#pragma unroll
        for (int t = 0; t < 4; ++t) w[t][c] = cw[t * 1024 + cg8 + c]; }
    for (int tok = obid() * 4 + slot; tok < NTOK; tok += gridDim.x * 4) {
        const int s = tok & (SEQ - 1); float acc[8];
#pragma unroll
        for (int c = 0; c < 8; ++c) acc[c] = bias[c];
#pragma unroll
        for (int t = 0; t < 4; ++t) { if (s - 3 + t >= 0) { const u32x4 x = *(const u32x4*)(hin + (size_t)(tok - 3 + t) * DINP + C_SXBC + cg8);
            acc[0] += w[t][0] * bflo(x.x); acc[1] += w[t][1] * bfhi(x.x); acc[2] += w[t][2] * bflo(x.y); acc[3] += w[t][3] * bfhi(x.y);
            acc[4] += w[t][4] * bflo(x.z); acc[5] += w[t][5] * bfhi(x.z); acc[6] += w[t][6] * bflo(x.w); acc[7] += w[t][7] * bfhi(x.w); } }
        u32x4 o; o.x = pk2(siluf(acc[0]), siluf(acc[1])); o.y = pk2(siluf(acc[2]), siluf(acc[3])); o.z = pk2(siluf(acc[4]), siluf(acc[5])); o.w = pk2(siluf(acc[6]), siluf(acc[7]));
        *(u32x4*)(xbc + (size_t)tok * 1024 + cg8) = o;
    }
}
__device__ __forceinline__ void load_rotary(const bf16_t* hin, size_t t0, int pos0, int col0, float scale, float* dst, const float* theta) {
    const int tid = otid();
#pragma unroll
    for (int i = 0; i < 2; ++i) { const int e = tid + 512 * i; const int j = e >> 4, p0 = (e & 15) * 4;
        float x[8], y[8]; ld8(hin + (t0 + j) * DINP + col0 + 2 * p0, x);
#pragma unroll
        for (int k = 0; k < 4; ++k) { const float ang = (float)(pos0 + j) * theta[p0 + k];
            const float n = rintf(ang * 0.15915494309189535f); float r = fmaf(-n, 6.28125f, ang); r = fmaf(-n, 1.9353071795864769e-3f, r);
            const float sn = __sinf(r), cs = __cosf(r);
            y[2 * k] = (x[2 * k] * cs - x[2 * k + 1] * sn) * scale; y[2 * k + 1] = (x[2 * k] * sn + x[2 * k + 1] * cs) * scale; }
        st8(dst + j * LP + 2 * p0, y); }
}
__device__ __forceinline__ void fill_theta(float* theta) { if (otid() < 64) theta[otid()] = exp2f(-(float)otid() * (13.287712379549449f / 63.0f)); }

__device__ void hg_state_item(const Params& p, int l, int item, float* lds) {
    const int c = item & 255, h = (item >> 8) & 3, b = item >> 10; const int tid = otid();
    const bf16_t* hin = (const bf16_t*)(pws() + WS_HIN); const size_t t0 = (size_t)b * SEQ + c * 64;
    float* KD = lds; float* VV = lds + 64 * LP; float* BB = lds + 2 * 64 * LP; const float* lbl = pin(10);
#pragma unroll
    for (int i = 0; i < 2; ++i) { const int e = tid + 512 * i, j = e >> 4, d0 = (e & 15) * 8;
        float z[8], v[8], lb[8], bb[8], kk[8]; ld8(hin + (t0 + j) * DINP + C_HF + h * 128 + d0, z); ld8(hin + (t0 + j) * DINP + C_HI + h * 128 + d0, v); hg_lb8(lbl, l, h * 128 + d0, lb);
#pragma unroll
        for (int k = 0; k < 8; ++k) { const float sn = __builtin_amdgcn_rcpf(1.f + __expf(z[k])), sg = 1.f - sn; bb[k] = __logf(lb[k] + (1.f - lb[k]) * sg); kk[k] = (1.f - lb[k]) * sn; }
        st8(BB + j * LP + d0, bb); st8(KD + j * LP + d0, kk); st8(VV + j * LP + d0, v); }
    __syncthreads();
    if (tid < 128) { float a = 0.f; for (int j = 0; j < 64; ++j) { a += BB[j * LP + tid]; BB[j * LP + tid] = a; } }
    __syncthreads();
#pragma unroll
    for (int i = 0; i < 2; ++i) { const int e = tid + 512 * i, j = e >> 4, d0 = (e & 15) * 8; float kk[8], bj[8], bl[8]; ldf8(KD + j * LP + d0, kk); ldf8(BB + j * LP + d0, bj); ldf8(BB + 63 * LP + d0, bl);
#pragma unroll
        for (int k = 0; k < 8; ++k) kk[k] *= __expf(bl[k] - bj[k]);
        st8(KD + j * LP + d0, kk); }
    if (tid < 128) ((float*)(pws() + WS_DECH))[(size_t)item * 128 + tid] = __expf(BB[63 * LP + tid]);
    __syncthreads();
    state_mm<128>(KD, VV, (bf16_t*)(pws() + WS_STH) + (size_t)item * 16384);
    __syncthreads();
}
__device__ void ssd_state_item(const Params& p, int l, int item, float* lds) {
    const int c = item & 255, h = (item >> 8) & 7, b = item >> 11, g = h >> 2; const int tid = otid();
    const bf16_t* hin = (const bf16_t*)(pws() + WS_HIN); const size_t t0 = (size_t)b * SEQ + c * 64;
    const bf16_t* xbc = (const bf16_t*)(pws() + WS_XBC);
    float* KD = lds; float* VV = lds + 64 * LP; float* AUX = lds + 2 * 64 * LP;
    if (tid < 64) { const float dtv = softplusf(bf2f(hin[(t0 + tid) * DINP + C_SDT + h]) + pin(22)[l * 8 + h]);
        AUX[tid] = dtv; AUX[64 + tid] = -dtv * __expf(pin(23)[l * 8 + h]); }
    __syncthreads();
    if (tid < 64) { float a = 0.f; for (int j = 0; j <= tid; ++j) a += AUX[64 + j]; AUX[128 + tid] = a; }
    __syncthreads();
    const float cl = AUX[128 + 63];
#pragma unroll
    for (int i = 0; i < 2; ++i) { const int e = tid + 512 * i, j = e >> 4, n0 = (e & 15) * 8; float x[8]; ld8(xbc + ((size_t)b * SEQ + c * 64 + j) * 1024 + 512 + g * 128 + n0, x); const float f = __expf(cl - AUX[128 + j]);
#pragma unroll
        for (int k = 0; k < 8; ++k) x[k] *= f;
        st8(KD + j * LP + n0, x); }
    { const int j = tid >> 3, pc0 = (tid & 7) * 8; float x[8]; ld8(xbc + ((size_t)b * SEQ + c * 64 + j) * 1024 + h * 64 + pc0, x); const float f = AUX[j];
#pragma unroll
      for (int k = 0; k < 8; ++k) x[k] *= f;
      st8(VV + j * LP + pc0, x); }
    if (tid == 0) ((float*)(pws() + WS_DECS))[item] = __expf(cl);
    __syncthreads();
    state_mm<64>(KD, VV, (bf16_t*)(pws() + WS_STS) + (size_t)item * 8192);
    __syncthreads();
}
__device__ __forceinline__ float ret_lg(int h) { return __logf(1.f - exp2f(-5.f - (float)h)); }
__device__ void ret_state_item(const Params& p, int l, int item, float* lds) {
    const int c = item & 255, h = (item >> 8) & 3, b = item >> 10; const int tid = otid();
    const bf16_t* hin = (const bf16_t*)(pws() + WS_HIN); const size_t t0 = (size_t)b * SEQ + c * 64;
    float* KD = lds; float* VV = lds + 64 * LP; float* TH = lds + 2 * 64 * LP;
    fill_theta(TH);
    __syncthreads();
    load_rotary(hin, t0, c * 64, C_RK + h * 128, 0.08838834764831845f, KD, TH);
#pragma unroll
    for (int i = 0; i < 2; ++i) { const int e = tid + 512 * i, j = e >> 4, d0 = (e & 15) * 8; float v[8]; ld8(hin + (t0 + j) * DINP + C_RV + h * 128 + d0, v); st8(VV + j * LP + d0, v); }
    __syncthreads();
    const float lg = ret_lg(h);
#pragma unroll 4
    for (int i = 0; i < 16; ++i) { const int e = tid + 512 * i, j = e >> 7, d = e & 127; KD[j * LP + d] *= __expf(lg * (float)(63 - j)); }
    __syncthreads();
    state_mm<128>(KD, VV, (bf16_t*)(pws() + WS_STR) + (size_t)item * 16384);
    __syncthreads();
}
__device__ void cmp_item(const Params& p, int l, int item, float* lds) {
    const int mb = item & 63, kv = (item >> 6) & 1, b = (item >> 7) & 1, which = item >> 8; const int tid = otid();
    const bf16_t* hin = (const bf16_t*)(pws() + WS_HIN);
    const float* pe = pin(which ? 15 : 12) + l * 2048; const float* w2 = pin(which ? 17 : 14) + l * 256 * 64;
    float* dst = (float*)(pws() + (which ? WS_VCMP : WS_KCMP)) + (size_t)(b * 2 + kv) * 1024 * 64;
    const int colx = (which ? C_NVC : C_NKC) + kv * 64;
    bf16_t* AF = (bf16_t*)lds; float* HID = lds + 16448;
    const bf16_t* w1t = (const bf16_t*)(pws() + WS_W1T) + (size_t)((l * 2 + which) * 256) * 2048;
    const int tok0 = mb * 256;
#pragma unroll 2
    for (int i = 0; i < 8; ++i) { const int e = tid + 512 * i, r = e >> 8, rem = e & 255, pos = rem >> 3, d8 = (rem & 7) * 8; const int s = tok0 + 16 * r + pos;
        float x[8], pe8[8]; ldf8(pe + pos * 64 + d8, pe8);
        if (s < SEQ) ld8(hin + ((size_t)b * SEQ + s) * DINP + colx + d8, x); else {
#pragma unroll
            for (int k = 0; k < 8; ++k) x[k] = 0.f; }
        u32x4 w; w.x = pk2(x[0] + pe8[0], x[1] + pe8[1]); w.y = pk2(x[2] + pe8[2], x[3] + pe8[3]); w.z = pk2(x[4] + pe8[4], x[5] + pe8[5]); w.w = pk2(x[6] + pe8[6], x[7] + pe8[7]);
        *(u32x4*)(AF + r * 2056 + pos * 64 + d8) = w; }
    __syncthreads();
    { const int wid = tid >> 6, lane = tid & 63, fr = lane & 15, fq = lane >> 4;
      f32x4 acc0 = (f32x4){0.f, 0.f, 0.f, 0.f}, acc1 = acc0;
      const bf16_t* bp0 = w1t + (size_t)((2 * wid) * 16 + fr) * 2048 + fq * 8; const bf16_t* bp1 = bp0 + 16 * 2048; const bf16_t* ap = AF + fr * 2056 + fq * 8;
#pragma unroll 8
      for (int ks = 0; ks < 64; ++ks) { const bf16x8 av = *(const bf16x8*)(ap + ks * 32), b0 = *(const bf16x8*)(bp0 + ks * 32), b1 = *(const bf16x8*)(bp1 + ks * 32);
          acc0 = MFMA16(av, b0, acc0); acc1 = MFMA16(av, b1, acc1); }
#pragma unroll
      for (int j = 0; j < 4; ++j) { HID[(fq * 4 + j) * 256 + (2 * wid) * 16 + fr] = siluf(acc0[j]); HID[(fq * 4 + j) * 256 + (2 * wid + 1) * 16 + fr] = siluf(acc1[j]); } }
    __syncthreads();
    { const int e = tid & 63, r0 = tid >> 6; float o0 = 0.f, o1 = 0.f;
      for (int nn = 0; nn < 256; ++nn) { const float w = w2[nn * 64 + e]; o0 += HID[r0 * 256 + nn] * w; o1 += HID[(r0 + 8) * 256 + nn] * w; }
      const int m0 = mb * 16 + r0; if (m0 < 1023) dst[(size_t)m0 * 64 + e] = o0; if (m0 + 8 < 1023) dst[(size_t)(m0 + 8) * 64 + e] = o1;
      const float z0 = m0 < 1023 ? o0 : 0.f, z1 = m0 + 8 < 1023 ? o1 : 0.f; const int m1 = m0 + 8;
      if (which == 0) { bf16_t* kb = (bf16_t*)(pws() + WS_KCB) + (size_t)(b * 2 + kv) * 1024 * 64; kb[(size_t)m0 * 64 + e] = (bf16_t)(pk2(z0, 0.f) & 0xffffu); kb[(size_t)m1 * 64 + e] = (bf16_t)(pk2(z1, 0.f) & 0xffffu); }
      else { bf16_t* vt = (bf16_t*)(pws() + WS_VCT) + (size_t)(b * 2 + kv) * 16 * 4096; vt[(size_t)(m0 >> 6) * 4096 + e * 64 + (m0 & 63)] = (bf16_t)(pk2(z0, 0.f) & 0xffffu); vt[(size_t)(m1 >> 6) * 4096 + e * 64 + (m1 & 63)] = (bf16_t)(pk2(z1, 0.f) & 0xffffu); } }
    __syncthreads();
}
__device__ void vtr_item(const Params& p, int item, float* lds) {
    const int blk = item & 255, kv = (item >> 8) & 1, b = (item >> 9) & 1, which = item >> 10; const int tid = otid();
    const bf16_t* hin = (const bf16_t*)(pws() + WS_HIN); bf16_t* T = (bf16_t*)lds;
    { const int key = tid >> 3, d8 = (tid & 7) * 8; const u32x4 w = *(const u32x4*)(hin + ((size_t)b * SEQ + blk * 64 + key) * DINP + (which ? C_NVW : C_NVS) + kv * 64 + d8);
      T[(d8 + 0) * 72 + key] = (bf16_t)(w.x & 0xffffu); T[(d8 + 1) * 72 + key] = (bf16_t)(w.x >> 16); T[(d8 + 2) * 72 + key] = (bf16_t)(w.y & 0xffffu); T[(d8 + 3) * 72 + key] = (bf16_t)(w.y >> 16);
      T[(d8 + 4) * 72 + key] = (bf16_t)(w.z & 0xffffu); T[(d8 + 5) * 72 + key] = (bf16_t)(w.z >> 16); T[(d8 + 6) * 72 + key] = (bf16_t)(w.w & 0xffffu); T[(d8 + 7) * 72 + key] = (bf16_t)(w.w >> 16); }
    if (which == 0) {
        const int key = tid >> 3, d8 = (tid & 7) * 8; const u32x4 w = *(const u32x4*)(hin + ((size_t)b * SEQ + blk * 64 + key) * DINP + C_NKS + kv * 64 + d8);
        float a = (bflo(w.x) * bflo(w.x) + bfhi(w.x) * bfhi(w.x)) + (bflo(w.y) * bflo(w.y) + bfhi(w.y) * bfhi(w.y)) + (bflo(w.z) * bflo(w.z) + bfhi(w.z) * bfhi(w.z)) + (bflo(w.w) * bflo(w.w) + bfhi(w.w) * bfhi(w.w));
        a += dppf<0xB1>(a); a += dppf<0x4E>(a); a += dppf<0x141>(a);
        a = wave_maxf(a);
        if ((tid & 63) == 0) lds[4096 + (tid >> 6)] = a;
    }
    __syncthreads();
    if (which == 0 && tid == 0) { float m = 0.f; for (int w8 = 0; w8 < 8; ++w8) m = fmaxf(m, lds[4096 + w8]); ((float*)(pws() + WS_KNORM))[(b * 2 + kv) * 256 + blk] = sqrtf(m); }
    { const int dv = tid >> 3, k8 = (tid & 7) * 8; bf16_t* dst = (bf16_t*)(pws() + (which ? WS_VWT : WS_VST)) + ((size_t)((b * 2 + kv) * 256 + blk)) * 4096;
      *(u32x4*)(dst + dv * 64 + k8) = *(const u32x4*)(T + dv * 72 + k8); }
    __syncthreads();
}
__device__ void mixer_phase_pre(const Params& p, int l, float* lds) {
    for (int it = obid(); it < 512 + 2048; it += gridDim.x) { if (it < 512) cmp_item(p, l, it, lds); else vtr_item(p, it - 512, lds); }
    conv_prepass(p, l);
}
__device__ void mixer_phase_a(const Params& p, int l, float* lds) {
    for (int it = obid() + 512; it < 8704; it += gridDim.x) {
        if (it < 512) { for (int r = 0; r < 1 + (AREP & 1); ++r) cmp_item(p, l, it, lds); }
        else if (it < 2560) { for (int r = 0; r < 1 + ((AREP >> 1) & 1); ++r) hg_state_item(p, l, it - 512, lds); }
        else if (it < 6656) { for (int r = 0; r < 1 + ((AREP >> 2) & 1); ++r) ssd_state_item(p, l, it - 2560, lds); }
        else { for (int r = 0; r < 1 + ((AREP >> 3) & 1); ++r) ret_state_item(p, l, it - 6656, lds); }
    }
}
__device__ void scan_phase(const Params& p) {
    for (int wt = obid() + (int)gridDim.x * (otid() >> 6); wt < 1536; wt += (int)gridDim.x * 8) {
        const int task = wt * 64 + (otid() & 63);
        const int br = task >> 15, r = task & 32767;
        bf16_t* base; size_t cstride; const float* decp = nullptr; int dstride = 0; float dconst = 0.f;
        if (br == 0) { const int bh = r >> 12, e4 = r & 4095; base = (bf16_t*)(pws() + WS_STH) + (size_t)bh * 256 * 16384 + e4 * 4; cstride = 16384;
            decp = (const float*)(pws() + WS_DECH) + (size_t)bh * 256 * 128 + ((e4 * 4) >> 7); dstride = 128; }
        else if (br == 1) { const int bh = r >> 11, e4 = r & 2047; base = (bf16_t*)(pws() + WS_STS) + (size_t)bh * 256 * 8192 + e4 * 4; cstride = 8192;
            decp = (const float*)(pws() + WS_DECS) + (size_t)bh * 256; dstride = 1; }
        else { const int bh = r >> 12, e4 = r & 4095; base = (bf16_t*)(pws() + WS_STR) + (size_t)bh * 256 * 16384 + e4 * 4; cstride = 16384; dconst = __expf(64.f * ret_lg(bh & 3)); }
        float s0 = 0.f, s1 = 0.f, s2 = 0.f, s3 = 0.f;
#pragma unroll 8
        for (int c = 0; c < 256; ++c) {
            u32x2* ptr = (u32x2*)(base + (size_t)c * cstride); const u32x2 w = *ptr; const float dec = decp ? decp[(size_t)c * dstride] : dconst;
            u32x2 o; o.x = pk2(s0, s1); o.y = pk2(s2, s3); *ptr = o;
            s0 = dec * s0 + bflo(w.x); s1 = dec * s1 + bfhi(w.x); s2 = dec * s2 + bflo(w.y); s3 = dec * s3 + bfhi(w.y);
        }
    }
}
constexpr int AP = 68;
__device__ __forceinline__ void scores_plain(const float* QS, const float* KS, float (&acc)[2][4]) {
    const int tid = otid(), ti = tid >> 4, tj = tid & 15;
#pragma unroll
    for (int a = 0; a < 2; ++a)
#pragma unroll
        for (int jj = 0; jj < 4; ++jj) acc[a][jj] = 0.f;
    for (int d = 0; d < 128; d += 4) {
        f32x4 q[2], k[4];
#pragma unroll
        for (int a = 0; a < 2; ++a) q[a] = *(const f32x4*)(QS + (ti + 32 * a) * LP + d);
#pragma unroll
        for (int jj = 0; jj < 4; ++jj) k[jj] = *(const f32x4*)(KS + (tj + 16 * jj) * LP + d);
#pragma unroll
        for (int a = 0; a < 2; ++a)
#pragma unroll
            for (int jj = 0; jj < 4; ++jj) { if (a == 0 && jj >= 2) continue;
                acc[a][jj] += (q[a][0] * k[jj][0] + q[a][1] * k[jj][1]) + (q[a][2] * k[jj][2] + q[a][3] * k[jj][3]); }
    }
}
__device__ __forceinline__ void scores_hg(const float* QS, const float* KS, const float* BB, float (&acc)[2][4]) {
    const int tid = otid(), ti = tid >> 4, tj = tid & 15;
#pragma unroll
    for (int a = 0; a < 2; ++a)
#pragma unroll
        for (int jj = 0; jj < 4; ++jj) acc[a][jj] = 0.f;
    for (int d = 0; d < 128; d += 4) {
        f32x4 q[2], bi[2], k[4], bj[4];
#pragma unroll
        for (int a = 0; a < 2; ++a) { q[a] = *(const f32x4*)(QS + (ti + 32 * a) * LP + d); bi[a] = *(const f32x4*)(BB + (ti + 32 * a) * LP + d); }
#pragma unroll
        for (int jj = 0; jj < 4; ++jj) { k[jj] = *(const f32x4*)(KS + (tj + 16 * jj) * LP + d); bj[jj] = *(const f32x4*)(BB + (tj + 16 * jj) * LP + d); }
#pragma unroll
        for (int a = 0; a < 2; ++a)
#pragma unroll
            for (int jj = 0; jj < 4; ++jj) { if (a == 0 && jj >= 2) continue;
#pragma unroll
                for (int x = 0; x < 4; ++x) acc[a][jj] += q[a][x] * k[jj][x] * __expf(fminf(bi[a][x] - bj[jj][x], 0.f)); }
    }
}
template <int DV> __device__ __forceinline__ void load_sprev(const bf16_t* src, float* SP) {
    const int tid = otid();
    for (int e = tid; e < 128 * DV / 4; e += 512) { const int d = e / (DV / 4), v4 = e % (DV / 4); const u32x2 w = *(const u32x2*)(src + (size_t)d * DV + v4 * 4);
        *(f32x4*)(SP + d * (DV + 4) + v4 * 4) = (f32x4){bflo(w.x), bfhi(w.x), bflo(w.y), bfhi(w.y)}; }
}
template <int DV, bool VBF> __device__ __forceinline__ void out_mm(const float* AA, const void* VVp, const float* QS, const float* SP, f32x4 (&intra)[2][DV / 64], f32x4 (&inter)[2][DV / 64]) {
    const int tid = otid(), ti = tid >> 4, tv = tid & 15; constexpr int NV = DV / 64;
#pragma unroll
    for (int a = 0; a < 2; ++a)
#pragma unroll
        for (int n = 0; n < NV; ++n) { intra[a][n] = (f32x4){0.f, 0.f, 0.f, 0.f}; inter[a][n] = (f32x4){0.f, 0.f, 0.f, 0.f}; }
    for (int j = 0; j < 64; j += 4) {
        f32x4 a4[2];
#pragma unroll
        for (int a = 0; a < 2; ++a) a4[a] = *(const f32x4*)(AA + (ti + 32 * a) * AP + j);
#pragma unroll
        for (int x = 0; x < 4; ++x)
#pragma unroll
            for (int n = 0; n < NV; ++n) { f32x4 v;
                if (VBF) { const u32x2 w = *(const u32x2*)((const bf16_t*)VVp + (j + x) * 136 + n * 64 + tv * 4); v = (f32x4){bflo(w.x), bfhi(w.x), bflo(w.y), bfhi(w.y)}; }
                else v = *(const f32x4*)((const float*)VVp + (j + x) * AP + n * 64 + tv * 4);
#pragma unroll
                for (int a = 0; a < 2; ++a) intra[a][n] += v * a4[a][x]; }
    }
    for (int d = 0; d < 128; d += 4) {
        f32x4 q4[2];
#pragma unroll
        for (int a = 0; a < 2; ++a) q4[a] = *(const f32x4*)(QS + (ti + 32 * a) * LP + d);
#pragma unroll
        for (int x = 0; x < 4; ++x)
#pragma unroll
            for (int n = 0; n < NV; ++n) { const f32x4 s = *(const f32x4*)(SP + (d + x) * (DV + 4) + n * 64 + tv * 4);
#pragma unroll
                for (int a = 0; a < 2; ++a) inter[a][n] += s * q4[a][x]; }
    }
}
__device__ __forceinline__ float red16(float v) { v += dppf<0xB1>(v); v += dppf<0x4E>(v); v += dppf<0x141>(v); v += dppf<0x140>(v); return v; }
__device__ __forceinline__ float max16(float v) { v = fmaxf(v, dppf<0xB1>(v)); v = fmaxf(v, dppf<0x4E>(v)); v = fmaxf(v, dppf<0x141>(v)); v = fmaxf(v, dppf<0x140>(v)); return v; }

__device__ void hg_out_item(const Params& p, int l, int item, float* lds) {
    const int c = item & 255, h = (item >> 8) & 3, b = item >> 10; const int tid = otid(), ti = tid >> 4, tj = tid & 15;
    const bf16_t* hin = (const bf16_t*)(pws() + WS_HIN); const size_t t0 = (size_t)b * SEQ + c * 64;
    float* QS = lds; float* KS = lds + 64 * LP; float* BB = lds + 2 * 64 * LP; float* AA = lds + 3 * 64 * LP; bf16_t* VV = (bf16_t*)(lds + 3 * 64 * LP + 64 * AP); float* SP = KS; const float* lbl = pin(10);
#pragma unroll
    for (int i = 0; i < 2; ++i) { const int e = tid + 512 * i, j = e >> 4, d0 = (e & 15) * 8;
        float z[8], q[8], lb[8], bb[8], kk[8]; ld8(hin + (t0 + j) * DINP + C_HF + h * 128 + d0, z); ld8(hin + (t0 + j) * DINP + C_HQ + h * 128 + d0, q); hg_lb8(lbl, l, h * 128 + d0, lb);
#pragma unroll
        for (int k = 0; k < 8; ++k) { const float sn = __builtin_amdgcn_rcpf(1.f + __expf(z[k])), sg = 1.f - sn; bb[k] = __logf(lb[k] + (1.f - lb[k]) * sg); kk[k] = (1.f - lb[k]) * sn; q[k] = siluf(q[k]); }
        st8(BB + j * LP + d0, bb); st8(KS + j * LP + d0, kk); st8(QS + j * LP + d0, q);
        *(u32x4*)(VV + j * 136 + d0) = *(const u32x4*)(hin + (t0 + j) * DINP + C_HI + h * 128 + d0); }
    __syncthreads();
    if (tid < 128) { float a = 0.f; for (int j = 0; j < 64; ++j) { a += BB[j * LP + tid]; BB[j * LP + tid] = a; } }
    __syncthreads();
    { float acc[2][4]; scores_hg(QS, KS, BB, acc);
#pragma unroll
      for (int a = 0; a < 2; ++a)
#pragma unroll
          for (int jj = 0; jj < 4; ++jj) { const int i = ti + 32 * a, j = tj + 16 * jj; AA[i * AP + j] = (j <= i) ? acc[a][jj] : 0.f; } }
    __syncthreads();
#pragma unroll 4
    for (int i = 0; i < 16; ++i) { const int e = tid + 512 * i, j = e >> 7, d = e & 127; QS[j * LP + d] *= __expf(BB[j * LP + d]); }
    __syncthreads();
    load_sprev<128>((const bf16_t*)(pws() + WS_STH) + (size_t)item * 16384, SP);
    __syncthreads();
    f32x4 intra[2][2], inter[2][2]; out_mm<128, true>(AA, VV, QS, SP, intra, inter);
    const int tv = tj; const float* ng = pin(11) + l * 512 + h * 128; bf16_t* mixed = (bf16_t*)(pws() + WS_XB);
#pragma unroll
    for (int a = 0; a < 2; ++a) { const int i = ti + 32 * a; f32x4 o[2]; float ss = 0.f;
#pragma unroll
        for (int n = 0; n < 2; ++n) { o[n] = intra[a][n] + inter[a][n]; ss += (o[n][0] * o[n][0] + o[n][1] * o[n][1]) + (o[n][2] * o[n][2] + o[n][3] * o[n][3]); }
        ss = red16(ss); const float r = rsqrtf(ss * (1.f / 128.f) + 1e-6f);
#pragma unroll
        for (int n = 0; n < 2; ++n) { const int v = n * 64 + tv * 4; const u32x2 gw = *(const u32x2*)(hin + (t0 + i) * DINP + C_HG + h * 128 + v); const f32x4 g4 = *(const f32x4*)(ng + v);
            const float r0 = o[n][0] * r * g4[0] * siluf(bflo(gw.x)), r1 = o[n][1] * r * g4[1] * siluf(bfhi(gw.x)), r2 = o[n][2] * r * g4[2] * siluf(bflo(gw.y)), r3 = o[n][3] * r * g4[3] * siluf(bfhi(gw.y));
            u32x2 w; w.x = pk2(r0, r1); w.y = pk2(r2, r3); *(u32x2*)(mixed + (t0 + i) * DM + h * 128 + v) = w; } }
    __syncthreads();
}
__device__ void ret_out_item(const Params& p, int l, int item, float* lds) {
    const int c = item & 255, h = (item >> 8) & 3, b = item >> 10; const int tid = otid(), ti = tid >> 4, tj = tid & 15;
    const bf16_t* hin = (const bf16_t*)(pws() + WS_HIN); const size_t t0 = (size_t)b * SEQ + c * 64;
    float* QS = lds; float* KS = lds + 64 * LP; float* AA = lds + 3 * 64 * LP; bf16_t* VV = (bf16_t*)(lds + 3 * 64 * LP + 64 * AP); float* SP = KS; float* TH = lds + 3 * 64 * LP + 64 * AP + 64 * AP;
    fill_theta(TH);
    __syncthreads();
    load_rotary(hin, t0, c * 64, C_RQ + h * 128, 1.0f, QS, TH);
    load_rotary(hin, t0, c * 64, C_RK + h * 128, 0.08838834764831845f, KS, TH);
#pragma unroll
    for (int i = 0; i < 2; ++i) { const int e = tid + 512 * i, j = e >> 4, d0 = (e & 15) * 8; *(u32x4*)(VV + j * 136 + d0) = *(const u32x4*)(hin + (t0 + j) * DINP + C_RV + h * 128 + d0); }
    __syncthreads();
    const float lg = ret_lg(h);
    { float acc[2][4]; scores_plain(QS, KS, acc);
#pragma unroll
      for (int a = 0; a < 2; ++a)
#pragma unroll
          for (int jj = 0; jj < 4; ++jj) { const int i = ti + 32 * a, j = tj + 16 * jj; AA[i * AP + j] = (j <= i) ? acc[a][jj] * __expf(lg * (float)(i - j)) : 0.f; } }
    __syncthreads();
    load_sprev<128>((const bf16_t*)(pws() + WS_STR) + (size_t)item * 16384, SP);
    __syncthreads();
    f32x4 intra[2][2], inter[2][2]; out_mm<128, true>(AA, VV, QS, SP, intra, inter);
    const int tv = tj; bf16_t* mixed = (bf16_t*)(pws() + WS_XB);
#pragma unroll
    for (int a = 0; a < 2; ++a) { const int i = ti + 32 * a; const float sc = __expf(lg * (float)(i + 1)); f32x4 o[2]; float s = 0.f;
#pragma unroll
        for (int n = 0; n < 2; ++n) { o[n] = intra[a][n] + inter[a][n] * sc; s += (o[n][0] + o[n][1]) + (o[n][2] + o[n][3]); }
        s = red16(s); const float mu = s * (1.f / 128.f); float q = 0.f;
#pragma unroll
        for (int n = 0; n < 2; ++n) { const f32x4 d = o[n] - mu; q += (d[0] * d[0] + d[1] * d[1]) + (d[2] * d[2] + d[3] * d[3]); }
        q = red16(q); const float r = rsqrtf(q * (1.f / 128.f) + 1e-5f);
#pragma unroll
        for (int n = 0; n < 2; ++n) { const int v = n * 64 + tv * 4; const u32x2 gw = *(const u32x2*)(hin + (t0 + i) * DINP + C_RG + h * 128 + v);
            const float r0 = (o[n][0] - mu) * r * siluf(bflo(gw.x)), r1 = (o[n][1] - mu) * r * siluf(bfhi(gw.x)), r2 = (o[n][2] - mu) * r * siluf(bflo(gw.y)), r3 = (o[n][3] - mu) * r * siluf(bfhi(gw.y));
            u32x2 w; w.x = pk2(r0, r1); w.y = pk2(r2, r3); *(u32x2*)(mixed + (t0 + i) * DM + 1536 + h * 128 + v) = w; } }
    __syncthreads();
}
__device__ void ssd_out_item(const Params& p, int l, int item, float* lds) {
    const int c = item & 255, g = (item >> 8) & 1, b = item >> 9; const int tid = otid(), ti = tid >> 4, tj = tid & 15, tv = tj;
    const bf16_t* hin = (const bf16_t*)(pws() + WS_HIN); const size_t t0 = (size_t)b * SEQ + c * 64;
    const bf16_t* xbc = (const bf16_t*)(pws() + WS_XBC);
    float* CM = lds; float* BM = lds + 8448; float* SP = BM; float* G = lds + 17152; float* AH = lds + 21504; float* VV = lds + 25856; float* XS = lds + 30208; float* AUX = lds + 34560;
    if (tid < 256) { const int hh = tid >> 6, j = tid & 63, h = g * 4 + hh; const float dtv = softplusf(bf2f(hin[(t0 + j) * DINP + C_SDT + h]) + pin(22)[l * 8 + h]);
        AUX[hh * 64 + j] = dtv; AUX[512 + hh * 64 + j] = -dtv * __expf(pin(23)[l * 8 + h]); }
#pragma unroll
    for (int i = 0; i < 2; ++i) { const int e = tid + 512 * i, j = e >> 4, n0 = (e & 15) * 8; float x[8];
        ld8(xbc + ((size_t)b * SEQ + c * 64 + j) * 1024 + 768 + g * 128 + n0, x); st8(CM + j * LP + n0, x);
        ld8(xbc + ((size_t)b * SEQ + c * 64 + j) * 1024 + 512 + g * 128 + n0, x); st8(BM + j * LP + n0, x); }
    __syncthreads();
    if (tid < 256) { const int hh = tid >> 6, j = tid & 63; float a = 0.f; for (int jj = 0; jj <= j; ++jj) a += AUX[512 + hh * 64 + jj]; AUX[256 + hh * 64 + j] = a; }
    { float acc[2][4]; scores_plain(CM, BM, acc);
#pragma unroll
      for (int a = 0; a < 2; ++a)
#pragma unroll
          for (int jj = 0; jj < 4; ++jj) G[(ti + 32 * a) * AP + tj + 16 * jj] = acc[a][jj]; }
    __syncthreads();
    float ss[2] = {0.f, 0.f}; bf16_t* mixed = (bf16_t*)(pws() + WS_XB);
#pragma unroll 1
    for (int hh = 0; hh < 4; ++hh) {
        const int h = g * 4 + hh; const float* dt = AUX + hh * 64; const float* cb = AUX + 256 + hh * 64;
#pragma unroll 2
        for (int i = 0; i < 8; ++i) { const int e = tid + 512 * i, ii = e >> 6, j = e & 63; AH[ii * AP + j] = (j <= ii) ? G[ii * AP + j] * __expf(cb[ii] - cb[j]) : 0.f; }
        { const int j = tid >> 3, pc0 = (tid & 7) * 8; float x[8]; ld8(xbc + ((size_t)b * SEQ + c * 64 + j) * 1024 + h * 64 + pc0, x); st8(XS + j * AP + pc0, x); const float f = dt[j];
#pragma unroll
          for (int k = 0; k < 8; ++k) x[k] *= f;
          st8(VV + j * AP + pc0, x); }
        load_sprev<64>((const bf16_t*)(pws() + WS_STS) + (size_t)(((b * 8 + h) << 8) + c) * 8192, SP);
        __syncthreads();
        f32x4 intra[2][1], inter[2][1]; out_mm<64, false>(AH, VV, CM, SP, intra, inter);
        const float dsk = pin(24)[l * 8 + h];
#pragma unroll
        for (int a = 0; a < 2; ++a) { const int i = ti + 32 * a; const f32x4 xs = *(const f32x4*)(XS + i * AP + tv * 4); const u32x2 zw = *(const u32x2*)(hin + (t0 + i) * DINP + C_SZ + h * 64 + tv * 4);
            f32x4 o = intra[a][0] + inter[a][0] * __expf(cb[i]) + xs * dsk;
            o[0] *= siluf(bflo(zw.x)); o[1] *= siluf(bfhi(zw.x)); o[2] *= siluf(bflo(zw.y)); o[3] *= siluf(bfhi(zw.y));
            ss[a] += (o[0] * o[0] + o[1] * o[1]) + (o[2] * o[2] + o[3] * o[3]);
            u32x2 w; w.x = pk2(o[0], o[1]); w.y = pk2(o[2], o[3]); *(u32x2*)(mixed + (t0 + i) * DM + 1024 + g * 256 + hh * 64 + tv * 4) = w; }
        __syncthreads();
    }
    const float* ng = pin(25) + l * 512 + g * 256;
#pragma unroll
    for (int a = 0; a < 2; ++a) { const int i = ti + 32 * a; const float r = rsqrtf(red16(ss[a]) * (1.f / 256.f) + 1e-6f);
#pragma unroll 1
        for (int hh = 0; hh < 4; ++hh) { const f32x4 g4 = *(const f32x4*)(ng + hh * 64 + tv * 4); u32x2* ptr = (u32x2*)(mixed + (t0 + i) * DM + 1024 + g * 256 + hh * 64 + tv * 4); const u32x2 yw = *ptr;
            const f32x4 o = (f32x4){bflo(yw.x), bfhi(yw.x), bflo(yw.y), bfhi(yw.y)} * r * g4;
            u32x2 w; w.x = pk2(o[0], o[1]); w.y = pk2(o[2], o[3]); *ptr = w; } }
    __syncthreads();
}
#ifndef WREP
#define WREP 1
#endif
#ifndef TREP
#define TREP 1
#endif
#ifndef SREP
#define SREP 1
#endif
__device__ __forceinline__ int t5_bucket(int dist) {
    if (dist < 16) return dist;
    const int lg = 16 + (int)(__log2f((float)dist * 0.0625f) * 2.2857142857142856f);
    return lg < 31 ? lg : 31;
}
__device__ __forceinline__ float dot64_bf(const float (&q)[64], const bf16_t* kp) {
    float s0 = 0.f, s1 = 0.f;
#pragma unroll
    for (int i = 0; i < 8; ++i) { const u32x4 w = *(const u32x4*)(kp + i * 8);
        s0 += (q[8 * i + 0] * bflo(w.x) + q[8 * i + 2] * bflo(w.y)) + (q[8 * i + 4] * bflo(w.z) + q[8 * i + 6] * bflo(w.w));
        s1 += (q[8 * i + 1] * bfhi(w.x) + q[8 * i + 3] * bfhi(w.y)) + (q[8 * i + 5] * bfhi(w.z) + q[8 * i + 7] * bfhi(w.w)); }
    return s0 + s1;
}
__device__ __forceinline__ float dot64_f(const float (&q)[64], const float* kp) {
    float s0 = 0.f, s1 = 0.f;
#pragma unroll
    for (int i = 0; i < 16; ++i) { const f32x4 w = *(const f32x4*)(kp + i * 4); s0 += q[4 * i] * w[0] + q[4 * i + 2] * w[2]; s1 += q[4 * i + 1] * w[1] + q[4 * i + 3] * w[3]; }
    return s0 + s1;
}
__device__ __forceinline__ float softmax_row(float* scr, int ks, int n, float mx_local) {
    const float mx = max16(mx_local); float sum = 0.f;
    for (int idx = ks; idx < n; idx += 16) { const float e = __expf(scr[idx] - mx); scr[idx] = e; sum += e; }
    sum = red16(sum);
    return n > 0 ? 1.f / sum : 0.f;
}
constexpr float NEG_BIG = -1.0e30f;
__device__ __forceinline__ bf16_t f2bf(float x) { return (bf16_t)(pk2(x, 0.f) & 0xffffu); }
__device__ __forceinline__ void ld_k(const bf16_t* kbase, int kpitch, int fr, int fq, bf16x8 (&kb)[4][2]) {
#pragma unroll
    for (int nt = 0; nt < 4; ++nt)
#pragma unroll
        for (int ks = 0; ks < 2; ++ks) kb[nt][ks] = *(const bf16x8*)(kbase + (nt * 16 + fr) * kpitch + ks * 32 + fq * 8);
}
__device__ __forceinline__ void ld_v(const bf16_t* vt, int fr, int fq, bf16x8 (&vb)[4][2]) {
#pragma unroll
    for (int nt = 0; nt < 4; ++nt)
#pragma unroll
        for (int ks = 0; ks < 2; ++ks) vb[nt][ks] = *(const bf16x8*)(vt + (nt * 16 + fr) * 64 + ks * 32 + fq * 8);
}
__device__ __forceinline__ void mma_qk(const bf16x8 (&qa)[2][2], const bf16x8 (&kb)[4][2], f32x4 (&s)[2][4]) {
#pragma unroll
    for (int mt = 0; mt < 2; ++mt)
#pragma unroll
        for (int nt = 0; nt < 4; ++nt) { f32x4 c = (f32x4){0.f, 0.f, 0.f, 0.f};
#pragma unroll
            for (int ks = 0; ks < 2; ++ks) c = MFMA16(qa[mt][ks], kb[nt][ks], c);
            s[mt][nt] = c; }
}
__device__ __forceinline__ void mma_pv(const bf16_t* Pl, const bf16x8 (&vb)[4][2], int fr, int fq, f32x4 (&o)[2][4]) {
    bf16x8 pa[2][2];
#pragma unroll
    for (int mt = 0; mt < 2; ++mt)
#pragma unroll
        for (int ks = 0; ks < 2; ++ks) pa[mt][ks] = *(const bf16x8*)(Pl + (mt * 16 + fr) * 72 + ks * 32 + fq * 8);
#pragma unroll
    for (int nt = 0; nt < 4; ++nt)
#pragma unroll
        for (int ks = 0; ks < 2; ++ks)
#pragma unroll
            for (int mt = 0; mt < 2; ++mt) o[mt][nt] = MFMA16(pa[mt][ks], vb[nt][ks], o[mt][nt]);
}
__device__ void nsa_unit(const Params& p, int l, int item, float* ldsf) {
    int b = item >> 8, qt = item & 255; if (b) qt = 255 - qt;
    const int tid = otid(), wid = tid >> 6, lane = tid & 63, fr = lane & 15, fq = lane >> 4;
    unsigned char* wb = (unsigned char*)ldsf + wid * 16384;
    bf16_t* Pl = (bf16_t*)wb; float* IMP = (float*)(wb + 4608); float* OSEL = IMP; float* PS = (float*)(wb + 12928); int* SEL = (int*)(wb + 15104); int* NSEL = (int*)(wb + 15616);
    float* RB = ldsf + 32768; float* LSUM = ldsf + 33024; float* BND = ldsf + 33280; unsigned long long* QM = (unsigned long long*)(ldsf + 33536); const unsigned char* BK = (const unsigned char*)(ldsf + 34048);
    if (tid < 256) RB[tid] = pin(19)[tid];
    { unsigned char* BKw = (unsigned char*)(ldsf + 34048);
#pragma unroll
      for (int k = 0; k < 4; ++k) BKw[tid * 4 + k] = (unsigned char)t5_bucket(tid * 4 + k); }
    __syncthreads();
    const bf16_t* hin = (const bf16_t*)(pws() + WS_HIN); bf16_t* mixed = (bf16_t*)(pws() + WS_XB);
    const int q0 = qt * 64 + wid * 8; const int tb = b * SEQ;
    float ss[2] = {0.f, 0.f};
#pragma unroll 1
    for (int kv = 0; kv < 2; ++kv) {
        if (tid < 256) QM[tid] = (unsigned long long)(unsigned)(tid >> 20);
        bf16x8 qa[2][2];
#pragma unroll
        for (int mt = 0; mt < 2; ++mt)
#pragma unroll
            for (int ks = 0; ks < 2; ++ks) qa[mt][ks] = *(const bf16x8*)(hin + (tb + q0 + mt * 4 + (fr >> 2)) * DINP + C_NQ + (kv * 4 + (fr & 3)) * 64 + ks * 32 + fq * 8);
        f32x4 ofin[2][4];
        {
            f32x4 (&o)[2][4] = ofin; float m[2][4], ls[2][4];
#pragma unroll
            for (int mt = 0; mt < 2; ++mt) {
#pragma unroll
                for (int nt = 0; nt < 4; ++nt) o[mt][nt] = (f32x4){0.f, 0.f, 0.f, 0.f};
#pragma unroll
                for (int j = 0; j < 4; ++j) { m[mt][j] = NEG_BIG; ls[mt][j] = 0.f; } }
            bf16x8 kb[4][2]; ld_k(hin + (tb + (qt >= 8 ? qt - 8 : 0) * 64) * DINP + C_NKW + kv * 64, DINP, fr, fq, kb);
#pragma unroll 1
            for (int kt = (qt >= 8 ? qt - 8 : 0); kt <= qt; ++kt) {
                bf16x8 vb[4][2]; ld_v((const bf16_t*)(pws() + WS_VWT) + ((size_t)((b * 2 + kv) * 256 + kt)) * 4096, fr, fq, vb);
                f32x4 s[2][4]; mma_qk(qa, kb, s);
#pragma unroll
                for (int mt = 0; mt < 2; ++mt) {
                    const int qpos = q0 + mt * 4 + fq; bool ok[4]; float tmax[4] = {NEG_BIG, NEG_BIG, NEG_BIG, NEG_BIG};
#pragma unroll
                    for (int nt = 0; nt < 4; ++nt) { const int dist = qpos - (kt * 64 + nt * 16 + fr); ok[nt] = dist >= 0 && dist < 512;
                        const f32x4 bias = *(const f32x4*)(RB + (int)BK[dist < 0 ? 0 : (dist > 2047 ? 2047 : dist)] * 8 + kv * 4);
#pragma unroll
                        for (int j = 0; j < 4; ++j) { const float v = ok[nt] ? s[mt][nt][j] * 0.125f + bias[j] : NEG_BIG; s[mt][nt][j] = v; tmax[j] = fmaxf(tmax[j], v); } }
#pragma unroll
                    for (int j = 0; j < 4; ++j) { const float mn = fmaxf(m[mt][j], max16(tmax[j])); const float alpha = __expf(m[mt][j] - mn); m[mt][j] = mn; float rs = 0.f;
#pragma unroll
                        for (int nt = 0; nt < 4; ++nt) { const float pe = ok[nt] ? __expf(s[mt][nt][j] - mn) : 0.f; rs += pe; Pl[(mt * 16 + fq * 4 + j) * 72 + nt * 16 + fr] = f2bf(pe); o[mt][nt][j] *= alpha; }
                        ls[mt][j] = ls[mt][j] * alpha + red16(rs); }
                }
                __builtin_amdgcn_wave_barrier();
                if (kt < qt) ld_k(hin + (tb + (kt + 1) * 64) * DINP + C_NKW + kv * 64, DINP, fr, fq, kb);
                mma_pv(Pl, vb, fr, fq, o);
                __builtin_amdgcn_wave_barrier();
            }
#pragma unroll
            for (int mt = 0; mt < 2; ++mt)
#pragma unroll
                for (int j = 0; j < 4; ++j) { const float g2 = sigmf(bf2f(hin[(tb + q0 + mt * 4 + fq) * DINP + C_NGATE + (kv * 4 + j) * 3 + 2])); const float sc = ls[mt][j] > 0.f ? g2 / ls[mt][j] : 0.f;
#pragma unroll
                    for (int nt = 0; nt < 4; ++nt) ofin[mt][nt][j] *= sc; }
        }
        {
            const int nct = (4 * qt + 3 + 63) >> 6;
            const bf16_t* kc = (const bf16_t*)(pws() + WS_KCB) + (size_t)(b * 2 + kv) * 1024 * 64; const bf16_t* vct = (const bf16_t*)(pws() + WS_VCT) + (size_t)(b * 2 + kv) * 16 * 4096;
            float m[2][4], ls[2][4];
#pragma unroll
            for (int mt = 0; mt < 2; ++mt)
#pragma unroll
                for (int j = 0; j < 4; ++j) { m[mt][j] = NEG_BIG; ls[mt][j] = 0.f; }
            for (int e = lane; e < 8 * 260; e += 64) IMP[e] = 0.f;
            bf16x8 kb[4][2]; ld_k(kc, 64, fr, fq, kb);
#pragma unroll 1
            for (int ct = 0; ct < nct; ++ct) {
                f32x4 s[2][4]; mma_qk(qa, kb, s);
                ld_k(kc + (size_t)(ct + 1 < nct ? ct + 1 : 0) * 64 * 64, 64, fr, fq, kb);
#pragma unroll
                for (int mt = 0; mt < 2; ++mt) {
                    const int qpos = q0 + mt * 4 + fq; bool ok[4]; float tmax[4] = {NEG_BIG, NEG_BIG, NEG_BIG, NEG_BIG};
#pragma unroll
                    for (int nt = 0; nt < 4; ++nt) { const int dist = qpos - (16 * (ct * 64 + nt * 16 + fr) + 31); ok[nt] = dist >= 0;
                        const f32x4 bias = *(const f32x4*)(RB + (int)BK[dist < 0 ? 0 : (dist > 2047 ? 2047 : dist)] * 8 + kv * 4);
#pragma unroll
                        for (int j = 0; j < 4; ++j) { const float v = ok[nt] ? s[mt][nt][j] * 0.125f + bias[j] : NEG_BIG; s[mt][nt][j] = v; tmax[j] = fmaxf(tmax[j], v); } }
#pragma unroll
                    for (int j = 0; j < 4; ++j) { const float mn = fmaxf(m[mt][j], max16(tmax[j])); const float alpha = __expf(m[mt][j] - mn); m[mt][j] = mn; float rs = 0.f;
#pragma unroll
                        for (int nt = 0; nt < 4; ++nt) rs += ok[nt] ? __expf(s[mt][nt][j] - mn) : 0.f;
                        ls[mt][j] = ls[mt][j] * alpha + red16(rs); }
                }
            }
            float inv[2][4];
#pragma unroll
            for (int mt = 0; mt < 2; ++mt)
#pragma unroll
                for (int j = 0; j < 4; ++j) inv[mt][j] = ls[mt][j] > 0.f ? 1.f / ls[mt][j] : 0.f;
            float g0[2][4];
#pragma unroll
            for (int mt = 0; mt < 2; ++mt)
#pragma unroll
                for (int j = 0; j < 4; ++j) g0[mt][j] = sigmf(bf2f(hin[(tb + q0 + mt * 4 + fq) * DINP + C_NGATE + (kv * 4 + j) * 3 + 0]));
            __builtin_amdgcn_wave_barrier();
#pragma unroll 1
            for (int ct = 0; ct < nct; ++ct) {
                bf16x8 vb[4][2]; ld_v(vct + (size_t)ct * 4096, fr, fq, vb);
                f32x4 s[2][4]; mma_qk(qa, kb, s);
#pragma unroll
                for (int mt = 0; mt < 2; ++mt) {
                    const int qpos = q0 + mt * 4 + fq;
#pragma unroll
                    for (int nt = 0; nt < 4; ++nt) { const int dist = qpos - (16 * (ct * 64 + nt * 16 + fr) + 31); const bool ok = dist >= 0;
                        const f32x4 bias = *(const f32x4*)(RB + (int)BK[dist < 0 ? 0 : (dist > 2047 ? 2047 : dist)] * 8 + kv * 4); float psum = 0.f;
#pragma unroll
                        for (int j = 0; j < 4; ++j) { const float pe = ok ? __expf(s[mt][nt][j] * 0.125f + bias[j] - m[mt][j]) * inv[mt][j] : 0.f; psum += pe; Pl[(mt * 16 + fq * 4 + j) * 72 + nt * 16 + fr] = f2bf(pe * g0[mt][j]); }
                        PS[(mt * 4 + fq) * 68 + nt * 16 + fr] = psum; }
                }
                __builtin_amdgcn_wave_barrier();
                { const int qi = lane >> 3, l8 = lane & 7; const float* pr = PS + qi * 68; float* ir = IMP + qi * 260 + ct * 16;
#pragma unroll
                  for (int x = 0; x < 2; ++x) { const int jb = l8 + 8 * x; const f32x4 v = *(const f32x4*)(pr + 4 * jb); float a = (v[0] + v[1]) + (v[2] + 0.5f * v[3]); if (jb > 0) a += 0.5f * pr[4 * jb - 1]; ir[jb] += a; }
                  if (l8 == 0) ir[16] += 0.5f * pr[63]; }
                if (ct + 1 < nct) ld_k(kc + (size_t)(ct + 1) * 64 * 64, 64, fr, fq, kb);
                mma_pv(Pl, vb, fr, fq, ofin);
                __builtin_amdgcn_wave_barrier();
            }
        }
        __syncthreads();
        float* QN = PS;
        {
            if (lane < 32) { const bf16_t* qp = hin + (tb + q0 + (lane >> 2)) * DINP + C_NQ + (kv * 4 + (lane & 3)) * 64; float a = 0.f;
#pragma unroll
                for (int i = 0; i < 8; ++i) { const u32x4 w = *(const u32x4*)(qp + i * 8);
                    a += (bflo(w.x) * bflo(w.x) + bfhi(w.x) * bfhi(w.x)) + (bflo(w.y) * bflo(w.y) + bfhi(w.y) * bfhi(w.y)) + (bflo(w.z) * bflo(w.z) + bfhi(w.z) * bfhi(w.z)) + (bflo(w.w) * bflo(w.w) + bfhi(w.w) * bfhi(w.w)); }
                QN[lane] = sqrtf(a); }
            if (lane < 4) { float bm = 0.f; for (int bk = 0; bk < 32; ++bk) bm = fmaxf(bm, fabsf(RB[bk * 8 + kv * 4 + lane])); QN[32 + lane] = bm; }
        }
        __builtin_amdgcn_wave_barrier();
        const float* KN = (const float*)(pws() + WS_KNORM) + (b * 2 + kv) * 256;
#pragma unroll 1
        for (int qi = 0; qi < 8; ++qi) {
            const int qpos = q0 + qi, cur = qpos >> 6; unsigned long long key[4];
#pragma unroll
            for (int jj = 0; jj < 4; ++jj) { const int j = lane + 64 * jj; unsigned long long kk = 0ull;
                if (j <= cur) { const float val = (j == 0 || j == cur || j == cur - 1) ? 5.0f : IMP[qi * 260 + j]; kk = ((unsigned long long)(__float_as_uint(val) + 1u) << 32) | (unsigned)(255 - j); }
                key[jj] = kk; }
            float knmax = 0.f;
            for (int it = 0; it < 16; ++it) {
                unsigned long long best = key[0] > key[1] ? key[0] : key[1]; { const unsigned long long b2 = key[2] > key[3] ? key[2] : key[3]; best = b2 > best ? b2 : best; }
                best = wave_max_u64(best);
                if ((best >> 32) == 0ull) break;
                const int jsel = 255 - (int)(unsigned)(best & 0xffffffffull);
                if (lane == it) { lds_or64(QM + jsel, 1ull << (wid * 8 + qi)); knmax = KN[jsel]; }
#pragma unroll
                for (int jj = 0; jj < 4; ++jj) if (key[jj] == best) key[jj] = 0ull;
            }
            const float bq = wave_maxf(knmax);
            if (lane < 4) BND[(wid * 8 + qi) * 4 + lane] = QN[qi * 4 + lane] * bq * (0.125f * 1.002f) + QN[32 + lane] + 1e-3f;
        }
        __builtin_amdgcn_wave_barrier();
        for (int e = lane; e < 2048; e += 64) OSEL[e] = 0.f;
        if (lane < 32) LSUM[wid * 32 + lane] = 0.f;
        __syncthreads();
#pragma unroll 1
        for (int j = wid; j <= qt; j += 8) {
            unsigned long long mask; { const unsigned long long mv = QM[j]; mask = ((unsigned long long)(unsigned)__builtin_amdgcn_readfirstlane((unsigned)(mv >> 32)) << 32) | (unsigned long long)(unsigned)__builtin_amdgcn_readfirstlane((unsigned)mv); }
            if (mask == 0ull) continue;
            bf16x8 kb[4][2], vb[4][2]; ld_k(hin + (tb + j * 64) * DINP + C_NKS + kv * 64, DINP, fr, fq, kb); ld_v((const bf16_t*)(pws() + WS_VST) + ((size_t)((b * 2 + kv) * 256 + j)) * 4096, fr, fq, vb);
            const bool far = (qt * 64 - (j * 64 + 63)) >= 1536;
#pragma unroll 1
            while (mask != 0ull) {
                int q4[4];
#pragma unroll
                for (int g = 0; g < 4; ++g) { if (mask != 0ull) { q4[g] = __builtin_ctzll(mask); mask &= mask - 1ull; } else q4[g] = -1; }
                const int ga = fr >> 2; const int myq = ga == 0 ? q4[0] : ga == 1 ? q4[1] : ga == 2 ? q4[2] : q4[3];
                const int rq = fq == 0 ? q4[0] : fq == 1 ? q4[1] : fq == 2 ? q4[2] : q4[3];
                bf16x8 qs[2];
#pragma unroll
                for (int ks = 0; ks < 2; ++ks) { qs[ks] = (bf16x8){0, 0, 0, 0, 0, 0, 0, 0}; if (myq >= 0) qs[ks] = *(const bf16x8*)(hin + (tb + qt * 64 + myq) * DINP + C_NQ + (kv * 4 + (fr & 3)) * 64 + ks * 32 + fq * 8); }
                f32x4 s[4];
#pragma unroll
                for (int nt = 0; nt < 4; ++nt) { f32x4 c = (f32x4){0.f, 0.f, 0.f, 0.f};
#pragma unroll
                    for (int ks = 0; ks < 2; ++ks) c = MFMA16(qs[ks], kb[nt][ks], c);
                    s[nt] = c; }
                const f32x4 bnd = *(const f32x4*)(BND + (rq >= 0 ? rq : 0) * 4); const int qpos = qt * 64 + rq; float rs[4] = {0.f, 0.f, 0.f, 0.f};
#pragma unroll
                for (int nt = 0; nt < 4; ++nt) { const int dist = qpos - (j * 64 + nt * 16 + fr); const bool ok = rq >= 0 && dist >= 0;
                    const f32x4 bias = *(const f32x4*)(RB + (far ? 31 : (int)BK[dist < 0 ? 0 : (dist > 2047 ? 2047 : dist)]) * 8 + kv * 4);
#pragma unroll
                    for (int jj = 0; jj < 4; ++jj) { const float pe = ok ? __expf(s[nt][jj] * 0.125f + bias[jj] - bnd[jj]) : 0.f; rs[jj] += pe; Pl[(fq * 4 + jj) * 72 + nt * 16 + fr] = f2bf(pe); } }
#pragma unroll
                for (int jj = 0; jj < 4; ++jj) { const float r = red16(rs[jj]); if (fr == 0 && rq >= 0) lds_addf(LSUM + rq * 4 + jj, r); }
                __builtin_amdgcn_wave_barrier();
                bf16x8 pa[2];
#pragma unroll
                for (int ks = 0; ks < 2; ++ks) pa[ks] = *(const bf16x8*)(Pl + fr * 72 + ks * 32 + fq * 8);
                { float* ob = ldsf + ((rq >= 0 ? rq : 0) >> 3) * 4096 + 1152 + ((rq >= 0 ? rq : 0) & 7) * 256;
#pragma unroll
                    for (int nt = 0; nt < 4; ++nt) { f32x4 c = (f32x4){0.f, 0.f, 0.f, 0.f};
#pragma unroll
                        for (int ks = 0; ks < 2; ++ks) c = MFMA16(pa[ks], vb[nt][ks], c);
                        if (rq >= 0) {
#pragma unroll
                            for (int jj = 0; jj < 4; ++jj) lds_addf(ob + jj * 64 + nt * 16 + fr, c[jj]); } } }
                __builtin_amdgcn_wave_barrier();
            }
        }
        __syncthreads();
#pragma unroll
        for (int mt = 0; mt < 2; ++mt) { const int trow = (tb + q0 + mt * 4 + fq) * DM + 512 + kv * 256;
#pragma unroll
            for (int j = 0; j < 4; ++j) { const float g1 = sigmf(bf2f(hin[(tb + q0 + mt * 4 + fq) * DINP + C_NGATE + (kv * 4 + j) * 3 + 1])); const float lsum = LSUM[(wid * 8 + mt * 4 + fq) * 4 + j]; const float scl = lsum > 0.f ? g1 / lsum : 0.f;
#pragma unroll
                for (int nt = 0; nt < 4; ++nt) { const float v = ofin[mt][nt][j] + OSEL[((mt * 4 + fq) * 4 + j) * 64 + nt * 16 + fr] * scl; ss[mt] += v * v; mixed[trow + j * 64 + nt * 16 + fr] = f2bf(v); } } }
        __syncthreads();
    }
    const float* ng = pin(18) + l * 512;
#pragma unroll
    for (int mt = 0; mt < 2; ++mt) { const float r = rsqrtf(red16(ss[mt]) * (1.f / 512.f) + 1e-6f); const int trow = (tb + q0 + mt * 4 + fq) * DM + 512;
#pragma unroll 4
        for (int c = 0; c < 32; ++c) { const int col = c * 16 + fr; mixed[trow + col] = f2bf(bf2f(mixed[trow + col]) * r * ng[col]); } }
    __syncthreads();
}
#ifndef NSA_REP
#define NSA_REP 1
#endif
template <int PCM> __device__ __forceinline__ void mixer_phase_c_item(const Params& p, int l, int it, float* lds);
template <int PCM> __device__ __forceinline__ void mixer_phase_c(const Params& p, int l, float* lds) {
    if (PCM == 15) {
        unsigned* ctr = (unsigned*)(pws() + WS_BAR) + 16 + 16 * l;
        for (;;) {
            if (otid() == 0) ((volatile int*)lds)[36000] = (int)__hip_atomic_fetch_add(ctr, 1u, __ATOMIC_RELAXED, __HIP_MEMORY_SCOPE_AGENT);
            __syncthreads();
            const int it = __builtin_amdgcn_readfirstlane(((volatile int*)lds)[36000]);
            __syncthreads();
            if (it >= 5632) break;
            mixer_phase_c_item<PCM>(p, l, it, lds);
        }
        return;
    }
    for (int it = obid(); it < 5632; it += gridDim.x) mixer_phase_c_item<PCM>(p, l, it, lds);
}
template <int PCM> __device__ __forceinline__ void mixer_phase_c_item(const Params& p, int l, int it, float* lds) {
    {
        if (it < 512) { if (PCM & 1) { const int u = (it & 1) ? 256 + (it >> 1) : 255 - (it >> 1);
            for (int rep = 0; rep < NSA_REP; ++rep) nsa_unit(p, l, u, lds); } }
        else if (it < 1536) { if (PCM & 4) { for (int r = 0; r < 1 + ((CREP >> 1) & 1); ++r) ssd_out_item(p, l, it - 512, lds); } }
        else if (it < 3584) { if (PCM & 2) { for (int r = 0; r < 1 + (CREP & 1); ++r) hg_out_item(p, l, it - 1536, lds); } }
        else { if (PCM & 8) { for (int r = 0; r < 1 + ((CREP >> 2) & 1); ++r) ret_out_item(p, l, it - 3584, lds); } }
    }
}
#ifndef REPEAT_MASK
#define REPEAT_MASK 0
#endif
constexpr int NPHASE = 1 + 13 * NLAYER;
__device__ __forceinline__ void grid_bar(unsigned* ctr, unsigned target) {
    asm volatile("s_waitcnt vmcnt(0) lgkmcnt(0)" ::: "memory");
    __syncthreads();
    if (threadIdx.x == 0) {
        __builtin_amdgcn_fence(__ATOMIC_RELEASE, "agent");
        asm volatile("s_waitcnt vmcnt(0)" ::: "memory");
        __hip_atomic_fetch_add(ctr, 1u, __ATOMIC_RELAXED, __HIP_MEMORY_SCOPE_AGENT);
        unsigned spins = 0;
        while (__hip_atomic_load(ctr, __ATOMIC_RELAXED, __HIP_MEMORY_SCOPE_AGENT) < target) { __builtin_amdgcn_s_sleep(2); if (++spins > (1u << 22)) break; }
        __builtin_amdgcn_fence(__ATOMIC_ACQUIRE, "agent");
        asm volatile("s_waitcnt vmcnt(0)" ::: "memory");
    }
    __syncthreads();
}
template <int PHM> __global__ void __launch_bounds__(NTHREADS, 2) mega_fwd(Params p) {
    extern __shared__ __attribute__((aligned(16))) unsigned char lds_raw[];
    if (threadIdx.x == 0) {
#pragma unroll
        for (int k = 0; k < 31; ++k) g_ptab[k] = (unsigned long long)p.in[k];
        g_ptab[31] = (unsigned long long)p.out; g_ptab[32] = (unsigned long long)p.ws; }
    __syncthreads();
    float* ldsf = (float*)lds_raw; LAS unsigned char* ldsl = (LAS unsigned char*)lds_raw;
        unsigned nbar = 0;
    for (int ph = p.ph_lo; ph < p.ph_hi; ++ph) {
        if (ph == 0 && (PHM & 1)) { cvt_x(p); cvt_ffn(p, 0, 0, ldsf); cvt_mix(p, 0, ldsf); cvt_w1t(p, ldsf); }
        else {
            bf16_t* XB = (bf16_t*)(pws() + WS_XB); bf16_t* HIN = (bf16_t*)(pws() + WS_HIN);
            const int l = (ph - 1) / 13, s = (ph - 1) % 13;
            for (int rep = 0; rep < (((REPEAT_MASK >> s) & 1) ? 2 : 1); ++rep) {
            if ((s == 0 || s == 10) && (PHM & 2)) {
                pg8::Gemm g{XB, (const bf16_t*)(pws() + WS_WA), NTOK, 11264, DM}; pg8::StaticOrder S; S.init(NTOK, 11264, (int)gridDim.x, (int)obid());
                EpiUp E{HIN}; pg8::gemm_phase<EpiUp, pg8::StaticOrder>(ldsl, g, S, E, nullptr);
            } else if ((s == 1 || s == 11 || s == 8) && (PHM & 4)) {
                const bool mix = (s == 8);
                pg8::Gemm g{mix ? XB : HIN, (const bf16_t*)(pws() + (mix ? WS_WD : WS_WB)), NTOK, DM, mix ? DM : DFF}; pg8::StaticOrder S; S.init(NTOK, DM, (int)gridDim.x, (int)obid());
                EpiRes E{(l == 0 && s == 1) ? pin(0) : (mix ? (const float*)pout() : nullptr), XB, pout(), ALPHA, mix ? 1.0f : 0.5f}; pg8::gemm_phase<EpiRes, pg8::StaticOrder>(ldsl, g, S, E, nullptr);
            } else if (s == 3 && (PHM & 8)) {
                pg8::Gemm g{XB, (const bf16_t*)(pws() + WS_WC), NTOK, DINP, DM}; pg8::StaticOrder S; S.init(NTOK, DINP, (int)gridDim.x, (int)obid());
                pg8::EpiBf16<0> E{HIN, DINP, nullptr, 0, 0}; pg8::gemm_phase<pg8::EpiBf16<0>, pg8::StaticOrder>(ldsl, g, S, E, nullptr);
            } else if (s == 2 && (PHM & 16)) { ln_rows(pout(), XB, pin(1) + l * DM, pin(2) + l * DM, true); cvt_ffn(p, l, 1, ldsf); }
            else if (s == 9 && (PHM & 16)) { ln_rows(pout(), XB, pin(6) + l * DM, pin(7) + l * DM, false); }
            else if (s == 12 && (PHM & 16)) { ln_rows(pout(), XB, pin(26) + l * DM, pin(27) + l * DM, l + 1 == NLAYER); if (l + 1 < NLAYER) { cvt_ffn(p, l + 1, 0, ldsf); cvt_mix(p, l + 1, ldsf); } }
            else if (s == 4 && (PHM & 32)) mixer_phase_pre(p, l, ldsf);
            else if (s == 5 && (PHM & 32)) mixer_phase_a(p, l, ldsf);
            else if (s == 6 && (PHM & 64)) scan_phase(p);
            else if (s == 7 && (PHM & 384)) mixer_phase_c<((PHM & 128) ? 1 : 0) | ((PHM & 256) ? 14 : 0)>(p, l, ldsf);
            }
        }
        if (ph + 1 < p.ph_hi) { if (ph == p.ph_lo) cg::this_grid().sync(); else grid_bar((unsigned*)(pws() + WS_BAR), (++nbar) * gridDim.x); }
    }
}

#ifndef HOST_REPEAT
#define HOST_REPEAT 0
#endif
#ifndef MULTI_LAUNCH
#define MULTI_LAUNCH 0
#endif
static int phase_mask(int ph) { if (ph == 0) return 1; const int s = (ph - 1) % 13; return (s == 0 || s == 10) ? 2 : (s == 1 || s == 11 || s == 8) ? 4 : s == 3 ? 8 : (s == 2 || s == 9 || s == 12) ? 16 : (s == 4 || s == 5) ? 32 : s == 6 ? 64 : 128; }
template <int M> static bool setup_one(int* per_cu) {
    if (hipFuncSetAttribute((const void*)mega_fwd<M>, hipFuncAttributeMaxDynamicSharedMemorySize, LDS_BYTES) != hipSuccess) return false;
    int pc = 0; if (hipOccupancyMaxActiveBlocksPerMultiprocessor(&pc, (const void*)mega_fwd<M>, NTHREADS, LDS_BYTES) != hipSuccess) pc = 0; *per_cu = pc; return true;
}
extern "C" void kernel_launch(void* const* d_in, const int* in_sizes, int n_in, void* d_out, int out_size, void* d_ws, size_t ws_size, hipStream_t stream) {
    static int grid = 0;
    if (grid == 0) {
        if (n_in != 31 || out_size != NTOK * DM || ws_size < WS_END) { fprintf(stderr, "kernel_launch: unexpected shapes: n_in %d out %d ws %zu (need %zu)\n", n_in, out_size, ws_size, (size_t)WS_END); grid = -1; return; }
        int dev = 0, cus = 0, per_cu = 0; bool ok = true;
        (void)hipGetDevice(&dev); (void)hipDeviceGetAttribute(&cus, hipDeviceAttributeMultiprocessorCount, dev);
#if MULTI_LAUNCH
        ok = setup_one<1>(&per_cu) && setup_one<2>(&per_cu) && setup_one<4>(&per_cu) && setup_one<8>(&per_cu) && setup_one<16>(&per_cu) && setup_one<32>(&per_cu) && setup_one<64>(&per_cu) && setup_one<128>(&per_cu) && setup_one<256>(&per_cu);
#else
        ok = setup_one<511>(&per_cu);
#endif
        (void)hipGetLastError();
        if (!ok) { fprintf(stderr, "kernel_launch: hipFuncSetAttribute failed\n"); grid = -1; return; }
        grid = cus;
        fprintf(stderr, "kernel_launch: grid %d (cus %d, per_cu %d)\n", grid, cus, per_cu);
    }
    if (grid < 0) return;
    Params p{};
    for (int i = 0; i < 31; ++i) p.in[i] = (const float*)d_in[i];
    p.out = (float*)d_out; p.ws = (unsigned char*)d_ws;
#if MULTI_LAUNCH
    for (int ph = 0; ph < NPHASE; ++ph) { p.ph_lo = ph; p.ph_hi = ph + 1;
      for (int hrep = 0; hrep < ((ph > 0 && ((HOST_REPEAT >> ((ph - 1) % 13)) & 1)) ? 2 : 1); ++hrep)
        switch (phase_mask(ph)) {
            case 1: hipLaunchKernelGGL(mega_fwd<1>, dim3(grid), dim3(NTHREADS), LDS_BYTES, stream, p); break;
            case 2: hipLaunchKernelGGL(mega_fwd<2>, dim3(grid), dim3(NTHREADS), LDS_BYTES, stream, p); break;
            case 4: hipLaunchKernelGGL(mega_fwd<4>, dim3(grid), dim3(NTHREADS), LDS_BYTES, stream, p); break;
            case 8: hipLaunchKernelGGL(mega_fwd<8>, dim3(grid), dim3(NTHREADS), LDS_BYTES, stream, p); break;
            case 16: hipLaunchKernelGGL(mega_fwd<16>, dim3(grid), dim3(NTHREADS), LDS_BYTES, stream, p); break;
            case 32: hipLaunchKernelGGL(mega_fwd<32>, dim3(grid), dim3(NTHREADS), LDS_BYTES, stream, p); break;
            case 64: hipLaunchKernelGGL(mega_fwd<64>, dim3(grid), dim3(NTHREADS), LDS_BYTES, stream, p); break;
            default: hipLaunchKernelGGL(mega_fwd<128>, dim3(grid), dim3(NTHREADS), LDS_BYTES, stream, p); hipLaunchKernelGGL(mega_fwd<256>, dim3(grid), dim3(NTHREADS), LDS_BYTES, stream, p); break;
        }
    }
#else
    p.ph_lo = 0; p.ph_hi = NPHASE;
    (void)hipMemsetAsync((unsigned char*)d_ws + WS_BAR, 0, 256, stream);
    void* args[] = {&p};
    hipError_t e = hipLaunchCooperativeKernel((const void*)mega_fwd<511>, dim3(grid), dim3(NTHREADS), args, LDS_BYTES, stream);
    if (e != hipSuccess) fprintf(stderr, "kernel_launch: cooperative launch failed: %s (grid %d)\n", hipGetErrorString(e), grid);
#endif
}
```
